# Optimizing an MI355X kernel written in HIP

```python
import jax, jax.numpy as jnp
from jax import lax
import numpy as np

D_MODEL = 1024
BATCH = 2
SEQ = 8192
DEPTH = 2

HEAD_DIM = 64
BLOCK_Q = 128
ROPE_THETA = 10000.0
RMS_EPS = 1e-6
NEG_INF = -1e30
D_FF = 2816

NSA_HEADS = 8
NSA_KV_HEADS = 2
CMP_BLOCK = 32
CMP_STRIDE = 16
CMP_HIDDEN = 256
SLC_BLOCK = 64
N_SELECT = 16
NSA_WINDOW = 512
FORCE_SCORE = 1e9
SWA_HEADS = 8
SWA_KV_HEADS = 2
SWA_WINDOW = 128
FOX_HEADS = 8
MLA_HEADS = 8
MLA_Q_RANK = 256
MLA_KV_RANK = 128
MLA_NOPE_DIM = 64
MLA_ROPE_DIM = 32
MLA_V_DIM = 64

NSA_Q_COLS = NSA_HEADS * HEAD_DIM
NSA_KV_COLS = NSA_KV_HEADS * HEAD_DIM
NSA_GATE_COLS = 3 * NSA_HEADS
SWA_Q_COLS = SWA_HEADS * HEAD_DIM
SWA_KV_COLS = SWA_KV_HEADS * HEAD_DIM
EVEN_SPLITS = (NSA_Q_COLS,) + (NSA_KV_COLS,) * 6 + (NSA_GATE_COLS, SWA_Q_COLS, SWA_KV_COLS, SWA_KV_COLS)
EVEN_IN_COLS = sum(EVEN_SPLITS)
EVEN_OUT_COLS = NSA_Q_COLS + SWA_Q_COLS
FOX_COLS = FOX_HEADS * HEAD_DIM
ODD_SPLITS = (FOX_COLS, FOX_COLS, FOX_COLS, FOX_HEADS, MLA_Q_RANK, MLA_KV_RANK, MLA_ROPE_DIM)
ODD_IN_COLS = sum(ODD_SPLITS)
ODD_OUT_COLS = FOX_COLS + MLA_HEADS * MLA_V_DIM

kernel_name = 'hybrid_nsa_swa_fox_mla_macaron'


def rms_norm(x, g):
    xf = x.astype(jnp.float32)
    y = xf * lax.rsqrt(jnp.mean(xf * xf, axis=-1, keepdims=True) + RMS_EPS)
    return (y * g.astype(jnp.float32)).astype(x.dtype)


def rope_tables(seq, dim):
    inv_freq = 1.0 / (ROPE_THETA ** (jnp.arange(0, dim, 2, dtype=jnp.float32) / dim))
    ang = jnp.arange(seq, dtype=jnp.float32)[:, None] * inv_freq[None, :]
    return jnp.cos(ang), jnp.sin(ang)


def apply_rope(t, cos, sin):
    half = t.shape[-1] // 2
    t1, t2 = t[..., :half], t[..., half:]
    c = cos.astype(t.dtype)
    s = sin.astype(t.dtype)
    return jnp.concatenate([t1 * c - t2 * s, t2 * c + t1 * s], axis=-1)


def rope_tail(t, cos, sin):
    return jnp.concatenate([t[..., :-MLA_ROPE_DIM], apply_rope(t[..., -MLA_ROPE_DIM:], cos, sin)], axis=-1)


def masked_softmax(logits, mask):
    logits = jnp.where(mask, logits, NEG_INF)
    m = jnp.max(logits, axis=-1, keepdims=True)
    e = jnp.where(mask, jnp.exp(logits - m), 0.0)
    return e / jnp.maximum(jnp.sum(e, axis=-1, keepdims=True), 1e-30)


def swiglu(h, w_gate, w_up, w_down):
    return (jax.nn.silu(h @ w_gate) * (h @ w_up)) @ w_down


def split_cols(t, sizes):
    return jnp.split(t, np.cumsum(sizes)[:-1].tolist(), axis=-1)


def to_heads(t, n):
    B, S, C = t.shape
    return t.reshape(B, S, n, C // n).transpose(0, 2, 1, 3)


def merge_heads(t):
    B, H, S, D = t.shape
    return t.transpose(0, 2, 1, 3).reshape(B, S, H * D)


def banded_attention(q, k, v, window, sinks=None):
    B, Hk, G, S, D = q.shape
    Q = BLOCK_Q
    nb = -(-window // Q)
    nq = S // Q
    pad = ((0, 0), (0, 0), (nb * Q, 0), (0, 0))
    kp = jnp.pad(k, pad).reshape(B, Hk, nq + nb, Q, D)
    vp = jnp.pad(v, pad).reshape(B, Hk, nq + nb, Q, v.shape[-1])
    kb = jnp.concatenate([kp[:, :, j:j + nq] for j in range(nb + 1)], axis=3)
    vb = jnp.concatenate([vp[:, :, j:j + nq] for j in range(nb + 1)], axis=3)
    qb = q.reshape(B, Hk, G, nq, Q, D)
    logits = jnp.einsum('bhgnqd,bhnkd->bhgnqk', qb, kb).astype(jnp.float32) * (D ** -0.5)
    blk = jnp.arange(nq)[:, None, None] * Q
    t = blk + jnp.arange(Q)[None, :, None]
    s = blk - nb * Q + jnp.arange((nb + 1) * Q)[None, None, :]
    mask = (s >= 0) & (s <= t) & (t - s < window)
    logits = jnp.where(mask, logits, NEG_INF)
    m = jnp.max(logits, axis=-1, keepdims=True)
    if sinks is not None:
        sk = sinks.astype(jnp.float32).reshape(1, Hk, G, 1, 1, 1)
        m = jnp.maximum(m, sk)
    e = jnp.where(mask, jnp.exp(logits - m), 0.0)
    denom = jnp.sum(e, axis=-1, keepdims=True)
    if sinks is not None:
        denom = denom + jnp.exp(sk - m)
    p = (e / denom).astype(v.dtype)
    o = jnp.einsum('bhgnqk,bhnkd->bhgnqd', p, vb)
    return o.reshape(B, Hk, G, S, v.shape[-1])


def compress_blocks(t, pos_emb, w1, w2):
    B, Hk, S, D = t.shape
    ch = t.reshape(B, Hk, S // CMP_STRIDE, CMP_STRIDE, D)
    blocks = jnp.concatenate([ch[:, :, :-1], ch[:, :, 1:]], axis=3) + pos_emb
    flat = blocks.reshape(B, Hk, blocks.shape[2], CMP_BLOCK * D)
    return jax.nn.silu(flat @ w1) @ w2


def nsa_compressed_selected(q_cmp, q_slc, k_cmp, v_cmp, k_slc, v_slc):
    B, Hk, G, S, D = q_cmp.shape
    Q = BLOCK_Q
    nq = S // Q
    nc = k_cmp.shape[2]
    ns = S // SLC_BLOCK
    n_sel = min(N_SELECT, ns)
    scale = D ** -0.5
    c_start = jnp.arange(nc)[:, None] * CMP_STRIDE
    s_start = jnp.arange(ns)[None, :] * SLC_BLOCK
    overlap = jnp.maximum(jnp.minimum(c_start + CMP_BLOCK, s_start + SLC_BLOCK) - jnp.maximum(c_start, s_start), 0).astype(jnp.float32)
    cmp_end = jnp.arange(nc) * CMP_STRIDE + CMP_BLOCK - 1
    k_blocks = k_slc.reshape(B, Hk, ns, SLC_BLOCK * D)
    v_blocks = v_slc.reshape(B, Hk, ns, SLC_BLOCK * D)
    b_idx = jnp.arange(B)[:, None, None]
    h_idx = jnp.arange(Hk)[None, :, None]
    blk_ids = jnp.arange(ns)
    n_keys = n_sel * SLC_BLOCK

    def one_block(args):
        n, qc, qs = args
        t = n * Q + jnp.arange(Q)
        lc = jnp.einsum('bhgqd,bhcd->bhgqc', qc, k_cmp).astype(jnp.float32) * scale
        pc = masked_softmax(lc, cmp_end[None, :] <= t[:, None])
        o_c = jnp.einsum('bhgqc,bhcd->bhgqd', pc.astype(v_cmp.dtype), v_cmp)
        imp = jnp.einsum('bhgqc,cs->bhqs', pc, overlap)
        cur = (t // SLC_BLOCK)[:, None]
        forced = (blk_ids == 0) | (blk_ids == cur) | (blk_ids == cur - 1)
        score = jnp.where(forced, FORCE_SCORE, jnp.where(blk_ids <= cur, imp, NEG_INF))
        _, idx = lax.top_k(score, n_sel)
        flat = idx.reshape(B, Hk, Q * n_sel)
        ks = k_blocks[b_idx, h_idx, flat].reshape(B, Hk, Q, n_keys, D)
        vs = v_blocks[b_idx, h_idx, flat].reshape(B, Hk, Q, n_keys, D)
        kpos = (idx[..., None] * SLC_BLOCK + jnp.arange(SLC_BLOCK)).reshape(B, Hk, Q, n_keys)
        ls = jnp.einsum('bhgqd,bhqkd->bhgqk', qs, ks).astype(jnp.float32) * scale
        ps = masked_softmax(ls, (kpos <= t[:, None])[:, :, None])
        o_s = jnp.einsum('bhgqk,bhqkd->bhgqd', ps.astype(vs.dtype), vs)
        return o_c, o_s

    def to_blocks(a):
        return jnp.moveaxis(a.reshape(B, Hk, G, nq, Q, D), 3, 0)

    def from_blocks(a):
        return jnp.moveaxis(a, 0, 3).reshape(B, Hk, G, S, D)

    o_c, o_s = lax.map(one_block, (jnp.arange(nq), to_blocks(q_cmp), to_blocks(q_slc)))
    return from_blocks(o_c), from_blocks(o_s)


def causal_block_attention(q, k, v, decay_cum=None):
    B, H, S, Dk = q.shape
    Q = BLOCK_Q
    nq = S // Q
    scale = Dk ** -0.5
    key_pos = jnp.arange(S)
    qb = jnp.moveaxis(q.reshape(B, H, nq, Q, Dk), 2, 0)
    if decay_cum is None:
        xs = (jnp.arange(nq), qb)
    else:
        xs = (jnp.arange(nq), qb, jnp.moveaxis(decay_cum.reshape(B, H, nq, Q), 2, 0))

    def one_block(args):
        n, qi = args[0], args[1]
        t = n * Q + jnp.arange(Q)
        logits = jnp.einsum('bhqd,bhkd->bhqk', qi, k).astype(jnp.float32) * scale
        if decay_cum is not None:
            logits = logits + args[2][..., :, None] - decay_cum[:, :, None, :]
        p = masked_softmax(logits, key_pos[None, :] <= t[:, None])
        return jnp.einsum('bhqk,bhkd->bhqd', p.astype(v.dtype), v)

    o = lax.map(one_block, xs)
    return jnp.moveaxis(o, 0, 2).reshape(B, H, S, v.shape[-1])


def nsa_swa_mixer(h, w_in, nsa_gate_b, nsa_q_norm, nsa_kc_norm, nsa_ks_norm, nsa_kw_norm,
                  cmp_pos_k, cmp_pos_v, cmpk_w1, cmpk_w2, cmpv_w1, cmpv_w2,
                  swa_q_norm, swa_k_norm, swa_sinks, w_out):
    B, S, _ = h.shape
    (q_a, kc, vc, ks, vs, kw, vw, gate_logits, q_b, k_b, v_b) = split_cols(h @ w_in, EVEN_SPLITS)
    cos, sin = rope_tables(S, HEAD_DIM)
    ga = NSA_HEADS // NSA_KV_HEADS
    gb = SWA_HEADS // SWA_KV_HEADS
    qa = rms_norm(to_heads(q_a, NSA_HEADS), nsa_q_norm)
    qa_rot = apply_rope(qa, cos, sin)

    def grp(t):
        return t.reshape(B, NSA_KV_HEADS, ga, S, HEAD_DIM)

    k_cmp = rms_norm(compress_blocks(to_heads(kc, NSA_KV_HEADS), cmp_pos_k, cmpk_w1, cmpk_w2), nsa_kc_norm)
    v_cmp = compress_blocks(to_heads(vc, NSA_KV_HEADS), cmp_pos_v, cmpv_w1, cmpv_w2)
    k_slc = apply_rope(rms_norm(to_heads(ks, NSA_KV_HEADS), nsa_ks_norm), cos, sin)
    v_slc = to_heads(vs, NSA_KV_HEADS)
    k_win = apply_rope(rms_norm(to_heads(kw, NSA_KV_HEADS), nsa_kw_norm), cos, sin)
    v_win = to_heads(vw, NSA_KV_HEADS)
    o_cmp, o_slc = nsa_compressed_selected(grp(qa), grp(qa_rot), k_cmp, v_cmp, k_slc, v_slc)
    o_win = banded_attention(grp(qa_rot), k_win, v_win, NSA_WINDOW)
    gates = jax.nn.sigmoid(gate_logits + nsa_gate_b).reshape(B, S, NSA_HEADS, 3).transpose(0, 2, 1, 3)
    gates = gates.reshape(B, NSA_KV_HEADS, ga, S, 3)
    o_a = gates[..., 0:1] * o_cmp + gates[..., 1:2] * o_slc + gates[..., 2:3] * o_win
    o_a = o_a.reshape(B, NSA_HEADS, S, HEAD_DIM)
    qb = apply_rope(rms_norm(to_heads(q_b, SWA_HEADS), swa_q_norm), cos, sin)
    kb = apply_rope(rms_norm(to_heads(k_b, SWA_KV_HEADS), swa_k_norm), cos, sin)
    vb = to_heads(v_b, SWA_KV_HEADS)
    o_b = banded_attention(qb.reshape(B, SWA_KV_HEADS, gb, S, HEAD_DIM), kb, vb, SWA_WINDOW,
                           swa_sinks.reshape(SWA_KV_HEADS, gb))
    o_b = o_b.reshape(B, SWA_HEADS, S, HEAD_DIM)
    o = jnp.concatenate([merge_heads(o_a), merge_heads(o_b)], axis=-1)
    return o @ w_out


def fox_mla_mixer(h, w_in, fox_f_bias, fox_q_norm, fox_k_norm, mla_q_a_norm, mla_w_q_b,
                  mla_kv_a_norm, mla_w_kv_b, mla_q_norm, mla_k_norm, w_out):
    B, S, _ = h.shape
    q_c, k_c, v_c, f_c, c_q, c_kv, k_r = split_cols(h @ w_in, ODD_SPLITS)
    qf = rms_norm(to_heads(q_c, FOX_HEADS), fox_q_norm)
    kf = rms_norm(to_heads(k_c, FOX_HEADS), fox_k_norm)
    vf = to_heads(v_c, FOX_HEADS)
    log_f = jax.nn.log_sigmoid((f_c + fox_f_bias).astype(jnp.float32))
    decay_cum = jnp.cumsum(log_f, axis=1).transpose(0, 2, 1)
    o_fox = causal_block_attention(qf, kf, vf, decay_cum)
    qk_dim = MLA_NOPE_DIM + MLA_ROPE_DIM
    q = (rms_norm(c_q, mla_q_a_norm) @ mla_w_q_b).reshape(B, S, MLA_HEADS, qk_dim)
    kv = (rms_norm(c_kv, mla_kv_a_norm) @ mla_w_kv_b).reshape(B, S, MLA_HEADS, MLA_NOPE_DIM + MLA_V_DIM)
    k_nope, v_m = kv[..., :MLA_NOPE_DIM], kv[..., MLA_NOPE_DIM:]
    k_rope = jnp.broadcast_to(k_r[:, :, None, :], (B, S, MLA_HEADS, MLA_ROPE_DIM))
    k = jnp.concatenate([k_nope, k_rope], axis=-1)
    cos, sin = rope_tables(S, MLA_ROPE_DIM)
    q = rope_tail(rms_norm(q, mla_q_norm).transpose(0, 2, 1, 3), cos, sin)
    k = rope_tail(rms_norm(k, mla_k_norm).transpose(0, 2, 1, 3), cos, sin)
    o_mla = causal_block_attention(q, k, v_m.transpose(0, 2, 1, 3))
    o = jnp.concatenate([merge_heads(o_fox), merge_heads(o_mla)], axis=-1)
    return o @ w_out


def setup_inputs(seed: int = 0) -> dict:
    key = jax.random.key(seed)
    D, F, hd = D_MODEL, D_FF, HEAD_DIM

    def ffn(p):
        return [(p + 'norm', (D,), 'gain'), (p + 'w_gate', (D, F), 'w'),
                (p + 'w_up', (D, F), 'w'), (p + 'w_down', (F, D), 'w')]

    specs = [('x', (BATCH, SEQ, D), 'act')]
    specs += ffn('l0_ffn1_')
    specs += [('l0_mix_norm', (D,), 'gain'), ('l0_w_in', (D, EVEN_IN_COLS), 'w'),
              ('l0_nsa_gate_b', (NSA_GATE_COLS,), 'bias'),
              ('l0_nsa_q_norm', (hd,), 'gain'), ('l0_nsa_kc_norm', (hd,), 'gain'),
              ('l0_nsa_ks_norm', (hd,), 'gain'), ('l0_nsa_kw_norm', (hd,), 'gain'),
              ('l0_cmp_pos_k', (CMP_BLOCK, hd), 'bias'), ('l0_cmp_pos_v', (CMP_BLOCK, hd), 'bias'),
              ('l0_cmpk_w1', (CMP_BLOCK * hd, CMP_HIDDEN), 'w'), ('l0_cmpk_w2', (CMP_HIDDEN, hd), 'w'),
              ('l0_cmpv_w1', (CMP_BLOCK * hd, CMP_HIDDEN), 'w'), ('l0_cmpv_w2', (CMP_HIDDEN, hd), 'w'),
              ('l0_swa_q_norm', (hd,), 'gain'), ('l0_swa_k_norm', (hd,), 'gain'),
              ('l0_swa_sinks', (SWA_HEADS,), 'sink'), ('l0_w_out', (EVEN_OUT_COLS, D), 'w')]
    specs += ffn('l0_ffn2_')
    specs += ffn('l1_ffn1_')
    specs += [('l1_mix_norm', (D,), 'gain'), ('l1_w_in', (D, ODD_IN_COLS), 'w'),
              ('l1_fox_f_bias', (FOX_HEADS,), 'forget'),
              ('l1_fox_q_norm', (hd,), 'gain'), ('l1_fox_k_norm', (hd,), 'gain'),
              ('l1_mla_q_a_norm', (MLA_Q_RANK,), 'gain'),
              ('l1_mla_w_q_b', (MLA_Q_RANK, MLA_HEADS * (MLA_NOPE_DIM + MLA_ROPE_DIM)), 'w'),
              ('l1_mla_kv_a_norm', (MLA_KV_RANK,), 'gain'),
              ('l1_mla_w_kv_b', (MLA_KV_RANK, MLA_HEADS * (MLA_NOPE_DIM + MLA_V_DIM)), 'w'),
              ('l1_mla_q_norm', (MLA_NOPE_DIM + MLA_ROPE_DIM,), 'gain'),
              ('l1_mla_k_norm', (MLA_NOPE_DIM + MLA_ROPE_DIM,), 'gain'),
              ('l1_w_out', (ODD_OUT_COLS, D), 'w')]
    specs += ffn('l1_ffn2_')
    keys = jax.random.split(key, len(specs))
    out = {}
    for k, (name, shape, kind) in zip(keys, specs):
        if kind == 'act':
            val = jax.random.normal(k, shape, jnp.float32)
        elif kind == 'w':
            val = jax.random.normal(k, shape, jnp.float32) * (shape[0] ** -0.5)
        elif kind == 'gain':
            val = 1.0 + 0.02 * jax.random.normal(k, shape, jnp.float32)
        elif kind == 'bias':
            val = 0.02 * jax.random.normal(k, shape, jnp.float32)
        elif kind == 'sink':
            val = 0.5 * jax.random.normal(k, shape, jnp.float32)
        else:
            val = jax.random.uniform(k, shape, jnp.float32, minval=1.0, maxval=4.0)
        out[name] = val
    return out


def reference(x,
              l0_ffn1_norm, l0_ffn1_w_gate, l0_ffn1_w_up, l0_ffn1_w_down,
              l0_mix_norm, l0_w_in, l0_nsa_gate_b,
              l0_nsa_q_norm, l0_nsa_kc_norm, l0_nsa_ks_norm, l0_nsa_kw_norm,
              l0_cmp_pos_k, l0_cmp_pos_v, l0_cmpk_w1, l0_cmpk_w2, l0_cmpv_w1, l0_cmpv_w2,
              l0_swa_q_norm, l0_swa_k_norm, l0_swa_sinks, l0_w_out,
              l0_ffn2_norm, l0_ffn2_w_gate, l0_ffn2_w_up, l0_ffn2_w_down,
              l1_ffn1_norm, l1_ffn1_w_gate, l1_ffn1_w_up, l1_ffn1_w_down,
              l1_mix_norm, l1_w_in, l1_fox_f_bias, l1_fox_q_norm, l1_fox_k_norm,
              l1_mla_q_a_norm, l1_mla_w_q_b, l1_mla_kv_a_norm, l1_mla_w_kv_b,
              l1_mla_q_norm, l1_mla_k_norm, l1_w_out,
              l1_ffn2_norm, l1_ffn2_w_gate, l1_ffn2_w_up, l1_ffn2_w_down):
    ffn1 = [(l0_ffn1_norm, l0_ffn1_w_gate, l0_ffn1_w_up, l0_ffn1_w_down),
            (l1_ffn1_norm, l1_ffn1_w_gate, l1_ffn1_w_up, l1_ffn1_w_down)]
    ffn2 = [(l0_ffn2_norm, l0_ffn2_w_gate, l0_ffn2_w_up, l0_ffn2_w_down),
            (l1_ffn2_norm, l1_ffn2_w_gate, l1_ffn2_w_up, l1_ffn2_w_down)]
    mix_norms = [l0_mix_norm, l1_mix_norm]
    mix_params = [
        (l0_w_in, l0_nsa_gate_b, l0_nsa_q_norm, l0_nsa_kc_norm, l0_nsa_ks_norm, l0_nsa_kw_norm,
         l0_cmp_pos_k, l0_cmp_pos_v, l0_cmpk_w1, l0_cmpk_w2, l0_cmpv_w1, l0_cmpv_w2,
         l0_swa_q_norm, l0_swa_k_norm, l0_swa_sinks, l0_w_out),
        (l1_w_in, l1_fox_f_bias, l1_fox_q_norm, l1_fox_k_norm, l1_mla_q_a_norm, l1_mla_w_q_b,
         l1_mla_kv_a_norm, l1_mla_w_kv_b, l1_mla_q_norm, l1_mla_k_norm, l1_w_out)]
    mix_fns = (nsa_swa_mixer, fox_mla_mixer)
    for l in range(DEPTH):
        n1, g1, u1, d1 = ffn1[l]
        x = x + 0.5 * swiglu(rms_norm(x, n1), g1, u1, d1)
        x = x + mix_fns[l % 2](rms_norm(x, mix_norms[l]), *mix_params[l])
        n2, g2, u2, d2 = ffn2[l]
        x = x + 0.5 * swiglu(rms_norm(x, n2), g2, u2, d2)
    return x
```

```cpp
#include <hip/hip_runtime.h>
#include <hip/hip_cooperative_groups.h>
#include <cstdio>
#include <cstdint>
namespace cg = cooperative_groups;

#define GAS __attribute__((address_space(1)))
#define LAS __attribute__((address_space(3)))
typedef unsigned short bf16;
typedef unsigned v4u __attribute__((ext_vector_type(4)));
typedef unsigned v2u __attribute__((ext_vector_type(2)));
typedef float f32x4 __attribute__((ext_vector_type(4)));
typedef float f32x2 __attribute__((ext_vector_type(2)));
typedef short bf16x8 __attribute__((ext_vector_type(8)));
typedef __bf16 bf16x2_t __attribute__((ext_vector_type(2)));

constexpr int NTOK = 16384, SEQ = 8192, DM = 1024, FF = 2816;
constexpr float EPS = 1e-6f;
constexpr float LOG2E = 1.4426950408889634f;
constexpr float C2_64 = 0.125f * LOG2E;
constexpr float C2_96 = 0.10206207261596575f * LOG2E;
constexpr int NWAVES = 8;

constexpr size_t MiB = 1u << 20, KiB = 1u << 10;
constexpr size_t OFF_CTL = 0, CTL_BYTES = 64 * KiB;
constexpr size_t OFF_SSQ = 1 * MiB;
constexpr size_t OFF_ROPE64C = 2 * MiB, OFF_ROPE64S = 3 * MiB;
constexpr size_t OFF_ROPE32C = 4 * MiB, OFF_ROPE32S = 4 * MiB + 512 * KiB;
constexpr size_t OFF_GATES = 5 * MiB;
constexpr size_t OFF_CBIAS = 6 * MiB + 512 * KiB;
constexpr size_t OFF_SSQCQ = 7 * MiB, OFF_SSQCKV = 7 * MiB + 256 * KiB;
constexpr size_t OFF_SSQKR = 6 * MiB + 768 * KiB;
constexpr size_t OFF_DC2 = 7 * MiB + 512 * KiB;
constexpr size_t OFF_FRAW = 8 * MiB;
constexpr size_t OFF_KR = 8 * MiB + 512 * KiB;
constexpr size_t OFF_WG = 9 * MiB + 512 * KiB;
constexpr size_t OFF_W2K = OFF_WG + 64 * KiB, OFF_W2V = OFF_W2K + 32 * KiB;
constexpr size_t OFF_KCMP = 10 * MiB, OFF_VCMP = 10 * MiB + 256 * KiB;
constexpr size_t OFF_HID = 11 * MiB;
constexpr size_t OFF_WGU = 13 * MiB;
constexpr size_t OFF_WD = 57 * MiB;
constexpr size_t SZ_WGU = 11 * MiB, SZ_WD = 5 * MiB + 512 * KiB;
constexpr size_t OFF_WIN0 = 79 * MiB, OFF_WIN1 = 83 * MiB, OFF_WOUT0 = 87 * MiB, OFF_WOUT1 = 89 * MiB;
constexpr size_t OFF_WQB = 91 * MiB, OFF_WKVB = 91 * MiB + 512 * KiB;
constexpr size_t OFF_W1K = 92 * MiB, OFF_W1V = 93 * MiB;
constexpr size_t OFF_XBA = 94 * MiB, OFF_ACTA = 126 * MiB;
constexpr size_t OFF_XBB = 126 * MiB, OFF_ACTB = 158 * MiB;
constexpr size_t OFF_QO = 126 * MiB;
constexpr size_t OFF_QC = 158 * MiB;
constexpr size_t OFF_OACC = 208 * MiB;
constexpr size_t OFF_KV8 = 174 * MiB;
constexpr size_t SZ_KV = 4 * MiB;
constexpr size_t OFF_QF = 126 * MiB;
constexpr size_t OFF_KF = 146 * MiB;
constexpr size_t OFF_VF = 166 * MiB;
constexpr size_t OFF_QM = 182 * MiB;
constexpr size_t OFF_VM = 206 * MiB;
constexpr size_t OFF_KM = 222 * MiB;
constexpr size_t OFF_CQ = 13 * MiB;
constexpr size_t OFF_CKV = 24 * MiB;
constexpr size_t OFF_O1 = 13 * MiB;
constexpr size_t OFF_QAUG = 246 * MiB;
constexpr size_t WS_END = 256 * MiB;

__device__ __forceinline__ unsigned f2bf(float f) { unsigned u = __builtin_bit_cast(unsigned, f); return (u + 0x7fffu + ((u >> 16) & 1u)) >> 16; }
__device__ __forceinline__ unsigned pk2(float lo, float hi) { f32x2 v = {lo, hi}; bf16x2_t b = __builtin_convertvector(v, bf16x2_t); return __builtin_bit_cast(unsigned, b); }
__device__ __forceinline__ float bflo(unsigned w) { return __builtin_bit_cast(float, w << 16); }
__device__ __forceinline__ float bfhi(unsigned w) { return __builtin_bit_cast(float, w & 0xffff0000u); }
__device__ __forceinline__ float bf2f(bf16 h) { return __builtin_bit_cast(float, (unsigned)h << 16); }
__device__ __forceinline__ float ex2(float x) { return __builtin_amdgcn_exp2f(x); }
__device__ __forceinline__ float rsq(float x) { return __builtin_amdgcn_rsqf(x); }
#define LDS_WAIT() asm volatile("s_waitcnt lgkmcnt(0)" ::: "memory")
#define VM_WAIT() asm volatile("s_waitcnt vmcnt(0)" ::: "memory")

template <int DQK> __device__ __forceinline__ size_t ktile_off(int t, int c) { return (size_t)(t >> 6) * (64 * DQK) + c * 512 + (t & 63) * 8; }
__device__ __forceinline__ size_t vtile_off(int t, int d) { return (size_t)(t >> 6) * 4096 + (d >> 5) * 2048 + (t & 63) * 32 + (d & 31); }
namespace pg8 {
constexpr int BM = 256, BK = 64, HALF = 128, HTB = HALF * BK * 2, STAGE_BYTES = 8 * HTB, NXCD = 8, WGM = 8;
__device__ __forceinline__ int lds_byte(int r, int c) { const int st = (r >> 4) * 2 + (c >> 5), rr = r & 15, cc = c & 31, ob = rr * 64 + cc * 2; return st * 1024 + (ob ^ (((ob >> 9) & 1) << 5)); }
__device__ __forceinline__ void stage_rc(int b, int& R, int& C) { const int st = b / 1024, sb = b % 1024, swz = sb ^ (((sb >> 9) & 1) << 5); R = (st >> 1) * 16 + swz / 64; C = (st & 1) * 32 + (swz % 64) / 2; }
__device__ __forceinline__ int perm32(int rho) { const int n = rho >> 4, i = rho & 15; return 8 * (i >> 2) + 4 * n + (i & 3); }
struct Unit { int pm, pn; };
struct StaticOrder {
    int nM, nN, nwg, G, c;
    __device__ __forceinline__ void init(int M, int N, int G_, int c_) { nM = M / BM; nN = N / BM; nwg = nM * nN; G = G_; c = c_; }
    __device__ __forceinline__ bool next(int i, Unit& u) const {
        const int L = i * G + c; if (L >= nwg) return false;
        int wgid = L; { const int q = nwg / NXCD, r = nwg % NXCD, xcd = wgid % NXCD, off = wgid / NXCD; wgid = (xcd < r ? xcd * (q + 1) : r * (q + 1) + (xcd - r) * q) + off; }
        const int nig = WGM * nN, gid = wgid / nig, fm = gid * WGM, gsz = (nM - fm) < WGM ? (nM - fm) : WGM;
        u.pm = fm + ((wgid % nig) % gsz); u.pn = (wgid % nig) / gsz; return true;
    }
};
}

typedef const float* fptr_t;
typedef LAS fptr_t* InTab;
enum { EPI_GATEUP = 0, EPI_RESID = 1, EPI_L0IN = 2, EPI_L1IN = 3, EPI_QB = 4, EPI_KVB = 5, EPI_CMP1 = 6 };
struct GemmDesc {
    const bf16* A; const bf16* Bt; int M, N, K, lda;
    int ep;
    float* out;
    InTab in;
    unsigned char* ws;
};

__device__ __forceinline__ float row_rstd16(const GAS float* ssq, int r, float inv_n) {
    const f32x4 a = *(const GAS f32x4*)(ssq + (size_t)r * 4);
    return rsq(((a[0] + a[1]) + (a[2] + a[3])) * inv_n + EPS);
}
__device__ __forceinline__ float row_rstd4(const GAS float* ssq, int r, float inv_n) {
    const f32x4 a = *(const GAS f32x4*)(ssq + (size_t)r * 4);
    return rsq(((a[0] + a[1]) + (a[2] + a[3])) * inv_n + EPS);
}
__device__ __forceinline__ float silu_f(float g) { return g * __builtin_amdgcn_rcpf(1.0f + ex2(-g * LOG2E)); }
__device__ __forceinline__ v4u pack8(const f32x4 a, const f32x4 b) { v4u w; w.x = pk2(a[0], a[1]); w.y = pk2(a[2], a[3]); w.z = pk2(b[0], b[1]); w.w = pk2(b[2], b[3]); return w; }

__device__ __forceinline__ void head_norm_rope(f32x4 (&v)[2][2], f32x4 (&w)[2][2], int mode, const GAS float* gain, const GAS float* cosT, const GAS float* sinT, int t, int fq) {
    if (mode == 0) return;
    float ss = 0.f;
#pragma unroll
    for (int bj = 0; bj < 2; ++bj)
#pragma unroll
        for (int n = 0; n < 2; ++n) ss += (v[bj][n][0] * v[bj][n][0] + v[bj][n][1] * v[bj][n][1]) + (v[bj][n][2] * v[bj][n][2] + v[bj][n][3] * v[bj][n][3]);
    ss += __shfl_xor(ss, 16); ss += __shfl_xor(ss, 32);
    const float r = rsq(ss * (1.0f / 64.0f) + EPS);
#pragma unroll
    for (int bj = 0; bj < 2; ++bj)
#pragma unroll
        for (int n = 0; n < 2; ++n) { const f32x4 g = *(const GAS f32x4*)(gain + 32 * bj + 8 * fq + 4 * n); v[bj][n] = v[bj][n] * r * g; }
    if (mode == 2) {
#pragma unroll
        for (int n = 0; n < 2; ++n) {
            const f32x4 c = *(const GAS f32x4*)(cosT + (size_t)t * 32 + 8 * fq + 4 * n), s = *(const GAS f32x4*)(sinT + (size_t)t * 32 + 8 * fq + 4 * n);
            w[0][n] = v[0][n] * c - v[1][n] * s; w[1][n] = v[1][n] * c + v[0][n] * s;
        }
    }
}

template <int EPI> __device__ __forceinline__ void gemm_epilogue(const GemmDesc& g_, const f32x4 (&acc)[2][2][4][2], const pg8::Unit& u, int wr, int wc, int fr, int fq) {
    asm volatile("" : "+v"(fr), "+v"(fq));
    GemmDesc g = g_;
    { unsigned long long w_ = (unsigned long long)g.ws; asm volatile("" : "+s"(w_)); g.ws = (unsigned char*)w_; }
    { unsigned t_ = (unsigned)(uintptr_t)g.in; asm volatile("" : "+s"(t_)); g.in = (InTab)(uintptr_t)t_; }
    const int rbase = u.pm * 256 + wr * 64 + fr;
    if constexpr (EPI == EPI_GATEUP) {
        const int col0 = u.pn * 128 + wc * 32 + 8 * fq;
#pragma unroll
        for (int ai = 0; ai < 2; ++ai)
#pragma unroll
            for (int m = 0; m < 4; ++m) {
                const int r = rbase + ai * 128 + m * 16; const float rs = row_rstd16((const GAS float*)(g.ws + OFF_SSQ), r, 1.0f / 1024.0f);
                const float k1 = -rs * LOG2E, rs2 = rs * rs;
                f32x4 a[2];
#pragma unroll
                for (int n = 0; n < 2; ++n) { const f32x4 ga = acc[ai][0][m][n], ua = acc[ai][1][m][n]; const f32x4 x = ga * k1, gu = ga * ua;
                    const f32x4 rc = {__builtin_amdgcn_rcpf(1.0f + ex2(x[0])), __builtin_amdgcn_rcpf(1.0f + ex2(x[1])), __builtin_amdgcn_rcpf(1.0f + ex2(x[2])), __builtin_amdgcn_rcpf(1.0f + ex2(x[3]))};
                    a[n] = gu * (rc * rs2); }
                *(GAS v4u*)((GAS bf16*)(g.ws + ((g.ep & 1) ? OFF_ACTB : OFF_ACTA)) + (size_t)r * FF + col0) = pack8(a[0], a[1]);
            }
    } else if constexpr (EPI == EPI_RESID) {
        const GAS float* xin32 = (const GAS float*)g.in[0]; GAS float* xout = (GAS float*)g.out;
        const GAS bf16* xsrc = (const GAS bf16*)(g.ws + ((g.ep & 16) ? OFF_XBB : OFF_XBA)); GAS bf16* xb = (GAS bf16*)(g.ws + ((g.ep & 2) ? OFF_XBB : OFF_XBA)); GAS float* ssq_out = (GAS float*)(g.ws + OFF_SSQ);
        const float alpha = (g.ep & 4) ? 1.0f : 0.5f; const bool first = (g.ep & 1) != 0, last = (g.ep & 32) != 0;
        LAS float* red = (LAS float*)((LAS unsigned char*)g.in - 1024 + 2048);
#pragma unroll
        for (int ai = 0; ai < 2; ++ai)
#pragma unroll
            for (int m = 0; m < 4; ++m) {
                const int r = rbase + ai * 128 + m * 16; float ss = 0.f;
#pragma unroll
                for (int bj = 0; bj < 2; ++bj)
#pragma unroll
                    for (int n = 0; n < 2; ++n) {
                        const size_t off = (size_t)r * DM + u.pn * 256 + bj * 128 + wc * 32 + n * 16 + 4 * fq;
                        f32x4 xo;
                        if (first) xo = *(const GAS f32x4*)(xin32 + off);
                        else { const v2u w = *(const GAS v2u*)(xsrc + off); xo = (f32x4){bflo(w.x), bfhi(w.x), bflo(w.y), bfhi(w.y)}; }
                        const f32x4 xn = xo + acc[ai][bj][m][n] * alpha;
                        if (last) *(GAS f32x4*)(xout + off) = xn;
                        else { v2u w; w.x = pk2(xn[0], xn[1]); w.y = pk2(xn[2], xn[3]); *(GAS v2u*)(xb + off) = w;
                            const f32x4 xq = {bflo(w.x), bfhi(w.x), bflo(w.y), bfhi(w.y)};
                            ss += (xq[0] * xq[0] + xq[1] * xq[1]) + (xq[2] * xq[2] + xq[3] * xq[3]); }
                    }
                ss += __shfl_xor(ss, 16); ss += __shfl_xor(ss, 32);
                if (!last && fq == 0) red[(wr * 128 + ai * 64 + m * 16 + fr) * 4 + wc] = ss;
            }
        if (!last) {
            asm volatile("s_waitcnt lgkmcnt(0)\n\ts_barrier" ::: "memory");
            const int tid_ = wr * 256 + wc * 64 + (fq * 16 + fr);
            if (tid_ < 256) { const int rr = tid_; const int wr2 = rr >> 7, rem = rr & 127, ai2 = rem >> 6, m2 = (rem >> 4) & 3, fr2 = rem & 15;
                const f32x4 p = *(const LAS f32x4*)(red + rr * 4);
                ssq_out[(size_t)(u.pm * 256 + wr2 * 64 + ai2 * 128 + m2 * 16 + fr2) * 4 + u.pn] = (p[0] + p[1]) + (p[2] + p[3]); }
            asm volatile("s_waitcnt lgkmcnt(0)\n\ts_barrier" ::: "memory");
        }
    } else if constexpr (EPI == EPI_L0IN) {
        const int pn = u.pn, hh = wc; int mode; const GAS float* gain = nullptr; GAS bf16* dst; GAS bf16* dst2 = nullptr; int tokmajor, pitch, colofs, isv_ = 0; float sc = 1.f;
        GAS unsigned char* ws = (GAS unsigned char*)g.ws;
        if (pn < 2) { mode = 2; gain = (const GAS float*)g.in[8]; dst = (GAS bf16*)(ws + OFF_QO); dst2 = (GAS bf16*)(ws + OFF_QC); tokmajor = 1; pitch = 1024; colofs = (pn * 4 + hh) * 64; sc = C2_64; }
        else if (pn < 4) { mode = 2; gain = (const GAS float*)g.in[18]; dst = (GAS bf16*)(ws + OFF_QO); tokmajor = 1; pitch = 1024; colofs = 512 + ((pn - 2) * 4 + hh) * 64; sc = C2_64; }
        else { const int isv = hh >> 1, hk = hh & 1; const int tens = (pn - 4) * 2 + isv; isv_ = isv;
            dst = (GAS bf16*)(ws + OFF_KV8 + (size_t)tens * SZ_KV) + (size_t)hk * SEQ * 64; tokmajor = 0; pitch = 64; colofs = 0;
            if (isv || pn == 4) mode = 0; else { mode = 2; gain = (const GAS float*)((pn == 5) ? g.in[10] : (pn == 6) ? g.in[11] : g.in[19]); } }
        const GAS float* cosT = (const GAS float*)(ws + OFF_ROPE64C); const GAS float* sinT = (const GAS float*)(ws + OFF_ROPE64S);
#pragma unroll
        for (int ai = 0; ai < 2; ++ai)
#pragma unroll
            for (int m = 0; m < 4; ++m) {
                const int r = rbase + ai * 128 + m * 16; const float rs = row_rstd16((const GAS float*)(g.ws + OFF_SSQ), r, 1.0f / 1024.0f);
                const int t = r & (SEQ - 1), b = r >> 13;
                f32x4 v[2][2], w[2][2];
#pragma unroll
                for (int bj = 0; bj < 2; ++bj)
#pragma unroll
                    for (int n = 0; n < 2; ++n) v[bj][n] = acc[ai][bj][m][n] * rs;
                head_norm_rope(v, w, mode, gain, cosT, sinT, t, fq);
                GAS bf16 *plo, *phi;
                if (tokmajor) { plo = dst + (size_t)r * pitch + colofs + 8 * fq; phi = plo + 32; }
                else if (pn == 4) { plo = dst + ((size_t)b * 2 * SEQ + t) * 64 + 8 * fq; phi = plo + 32; }
                else if (isv_) { GAS bf16* sl = dst + (size_t)b * 2 * SEQ * 64; plo = sl + vtile_off(t, 8 * fq); phi = sl + vtile_off(t, 32 + 8 * fq); }
                else { GAS bf16* sl = dst + (size_t)b * 2 * SEQ * 64; plo = sl + ktile_off<64>(t, fq); phi = sl + ktile_off<64>(t, 4 + fq); }
                if (mode == 2) {
                    *(GAS v4u*)(plo) = pack8(w[0][0] * sc, w[0][1] * sc); *(GAS v4u*)(phi) = pack8(w[1][0] * sc, w[1][1] * sc);
                    if (dst2) { GAS bf16* rp2 = dst2 + (size_t)r * 512 + colofs; *(GAS v4u*)(rp2 + 8 * fq) = pack8(v[0][0] * sc, v[0][1] * sc); *(GAS v4u*)(rp2 + 32 + 8 * fq) = pack8(v[1][0] * sc, v[1][1] * sc); }
                } else {
                    *(GAS v4u*)(plo) = pack8(v[0][0], v[0][1]); *(GAS v4u*)(phi) = pack8(v[1][0], v[1][1]);
                }
            }
    } else if constexpr (EPI == EPI_L1IN) {
        const int pn = u.pn; GAS unsigned char* ws = (GAS unsigned char*)g.ws;
        if (pn < 6) {
            const int hh = wc, h = (pn & 1) * 4 + hh; const int which = pn >> 1;
            const GAS float* gain = (const GAS float*)(which == 0 ? g.in[33] : g.in[34]); const int mode = which == 2 ? 0 : 1; const float sc = which == 0 ? C2_64 : 1.f;
#pragma unroll
            for (int ai = 0; ai < 2; ++ai)
#pragma unroll
                for (int m = 0; m < 4; ++m) {
                    const int r = rbase + ai * 128 + m * 16; const float rs = row_rstd16((const GAS float*)(g.ws + OFF_SSQ), r, 1.0f / 1024.0f);
                    const int t = r & (SEQ - 1), b = r >> 13;
                    f32x4 v[2][2], w[2][2];
#pragma unroll
                    for (int bj = 0; bj < 2; ++bj)
#pragma unroll
                        for (int n = 0; n < 2; ++n) v[bj][n] = acc[ai][bj][m][n] * rs;
                    head_norm_rope(v, w, mode, gain, nullptr, nullptr, t, fq);
                    GAS bf16 *plo, *phi;
                    if (which == 0) { plo = (GAS bf16*)(ws + OFF_QF) + ((size_t)r * 8 + h) * 80 + 8 * fq; phi = plo + 32; }
                    else if (which == 1) { GAS bf16* sl = (GAS bf16*)(ws + OFF_KF) + ((size_t)b * 8 + h) * SEQ * 80; plo = sl + ktile_off<80>(t, fq); phi = sl + ktile_off<80>(t, 4 + fq); }
                    else { GAS bf16* sl = (GAS bf16*)(ws + OFF_VF) + ((size_t)b * 8 + h) * SEQ * 64; plo = sl + vtile_off(t, 8 * fq); phi = sl + vtile_off(t, 32 + 8 * fq); }
                    *(GAS v4u*)(plo) = pack8(v[0][0] * sc, v[0][1] * sc); *(GAS v4u*)(phi) = pack8(v[1][0] * sc, v[1][1] * sc);
                }
        } else {
#pragma unroll
            for (int ai = 0; ai < 2; ++ai)
#pragma unroll
                for (int m = 0; m < 4; ++m) {
                    const int r = rbase + ai * 128 + m * 16; const float rs = row_rstd16((const GAS float*)(g.ws + OFF_SSQ), r, 1.0f / 1024.0f);
                    f32x4 v[2][2];
#pragma unroll
                    for (int bj = 0; bj < 2; ++bj)
#pragma unroll
                        for (int n = 0; n < 2; ++n) v[bj][n] = acc[ai][bj][m][n] * rs;
                    float s0 = 0.f, s1 = 0.f;
#pragma unroll
                    for (int n = 0; n < 2; ++n) { s0 += (v[0][n][0] * v[0][n][0] + v[0][n][1] * v[0][n][1]) + (v[0][n][2] * v[0][n][2] + v[0][n][3] * v[0][n][3]);
                                                  s1 += (v[1][n][0] * v[1][n][0] + v[1][n][1] * v[1][n][1]) + (v[1][n][2] * v[1][n][2] + v[1][n][3] * v[1][n][3]); }
                    if (pn == 6) {
                        GAS bf16* rowp = (GAS bf16*)(ws + OFF_CQ) + (size_t)r * 256 + wc * 32 + 8 * fq;
                        *(GAS v4u*)(rowp) = pack8(v[0][0], v[0][1]); *(GAS v4u*)(rowp + 128) = pack8(v[1][0], v[1][1]);
                        float ss = s0 + s1; ss += __shfl_xor(ss, 16); ss += __shfl_xor(ss, 32);
                        if (fq == 0) ((GAS float*)(ws + OFF_SSQCQ))[(size_t)r * 4 + wc] = ss;
                    } else {
                        GAS bf16* rowp = (GAS bf16*)(ws + OFF_CKV) + (size_t)r * 128 + wc * 32 + 8 * fq;
                        *(GAS v4u*)(rowp) = pack8(v[0][0], v[0][1]);
                        float ss = s0; ss += __shfl_xor(ss, 16); ss += __shfl_xor(ss, 32);
                        if (fq == 0) ((GAS float*)(ws + OFF_SSQCKV))[(size_t)r * 4 + wc] = ss;
                        if (wc == 0) { *(GAS v4u*)((GAS bf16*)(ws + OFF_KR) + (size_t)r * 32 + 8 * fq) = pack8(v[1][0], v[1][1]);
                            float sr = s1; sr += __shfl_xor(sr, 16); sr += __shfl_xor(sr, 32); if (fq == 0) ((GAS float*)(ws + OFF_SSQKR))[r] = sr; }
                        if (wc == 1 && fq == 0) { GAS float* fp = (GAS float*)(ws + OFF_FRAW) + (size_t)(r >> 13) * 8 * SEQ + (r & (SEQ - 1));
#pragma unroll
                            for (int hh2 = 0; hh2 < 4; ++hh2) { fp[(size_t)hh2 * SEQ] = v[1][0][hh2]; fp[(size_t)(4 + hh2) * SEQ] = v[1][1][hh2]; } }
                    }
                }
        }
    } else if constexpr (EPI == EPI_QB) {
        GAS unsigned char* ws = (GAS unsigned char*)g.ws;
#pragma unroll
        for (int ai = 0; ai < 2; ++ai)
#pragma unroll
            for (int m = 0; m < 4; ++m) {
                const int r = rbase + ai * 128 + m * 16; const float rs = row_rstd4((const GAS float*)(ws + OFF_SSQCQ), r, 1.0f / 256.0f);
                GAS bf16* rowp = (GAS bf16*)(ws + OFF_QM) + (size_t)r * 768 + u.pn * 256 + wc * 32 + 8 * fq;
                *(GAS v4u*)(rowp) = pack8(acc[ai][0][m][0] * rs, acc[ai][0][m][1] * rs); *(GAS v4u*)(rowp + 128) = pack8(acc[ai][1][m][0] * rs, acc[ai][1][m][1] * rs);
            }
    } else if constexpr (EPI == EPI_KVB) {
        GAS unsigned char* ws = (GAS unsigned char*)g.ws; const int h = u.pn * 2 + (wc & 1); const bool isv = wc >= 2;
        const GAS float* gk = (const GAS float*)g.in[40]; const GAS float* c32 = (const GAS float*)(ws + OFF_ROPE32C); const GAS float* s32 = (const GAS float*)(ws + OFF_ROPE32S);
#pragma unroll
        for (int ai = 0; ai < 2; ++ai)
#pragma unroll
            for (int m = 0; m < 4; ++m) {
                const int r = rbase + ai * 128 + m * 16; const float rs = row_rstd4((const GAS float*)(ws + OFF_SSQCKV), r, 1.0f / 128.0f);
                const int t = r & (SEQ - 1), b = r >> 13;
                f32x4 v[2][2];
#pragma unroll
                for (int bj = 0; bj < 2; ++bj)
#pragma unroll
                    for (int n = 0; n < 2; ++n) v[bj][n] = acc[ai][bj][m][n] * rs;
                if (isv) {
                    GAS bf16* sl = (GAS bf16*)(ws + OFF_VM) + ((size_t)b * 8 + h) * SEQ * 64;
                    *(GAS v4u*)(sl + vtile_off(t, 8 * fq)) = pack8(v[0][0], v[0][1]); *(GAS v4u*)(sl + vtile_off(t, 32 + 8 * fq)) = pack8(v[1][0], v[1][1]);
                } else {
                    float ss = 0.f;
#pragma unroll
                    for (int bj = 0; bj < 2; ++bj)
#pragma unroll
                        for (int n = 0; n < 2; ++n) ss += (v[bj][n][0] * v[bj][n][0] + v[bj][n][1] * v[bj][n][1]) + (v[bj][n][2] * v[bj][n][2] + v[bj][n][3] * v[bj][n][3]);
                    ss += __shfl_xor(ss, 16); ss += __shfl_xor(ss, 32);
                    const float rn = rsq((ss + ((const GAS float*)(ws + OFF_SSQKR))[r]) * (1.0f / 96.0f) + EPS);
                    GAS bf16* sl = (GAS bf16*)(ws + OFF_KM) + ((size_t)b * 8 + h) * SEQ * 96;
#pragma unroll
                    for (int bj = 0; bj < 2; ++bj) { const f32x4 g0 = *(const GAS f32x4*)(gk + 32 * bj + 8 * fq), g1 = *(const GAS f32x4*)(gk + 32 * bj + 8 * fq + 4);
                        *(GAS v4u*)(sl + ktile_off<96>(t, 4 * bj + fq)) = pack8(v[bj][0] * rn * g0, v[bj][1] * rn * g1); }
                    if (fq < 2) {
                        const GAS bf16* kr = (const GAS bf16*)(ws + OFF_KR) + (size_t)r * 32; const v4u wa = *(const GAS v4u*)(kr + 8 * fq), wb = *(const GAS v4u*)(kr + 16 + 8 * fq);
                        const f32x4 a0 = {bflo(wa.x), bfhi(wa.x), bflo(wa.y), bfhi(wa.y)}, a1 = {bflo(wa.z), bfhi(wa.z), bflo(wa.w), bfhi(wa.w)};
                        const f32x4 b0 = {bflo(wb.x), bfhi(wb.x), bflo(wb.y), bfhi(wb.y)}, b1 = {bflo(wb.z), bfhi(wb.z), bflo(wb.w), bfhi(wb.w)};
                        const f32x4 ga0 = *(const GAS f32x4*)(gk + 64 + 8 * fq), ga1 = *(const GAS f32x4*)(gk + 68 + 8 * fq), gb0 = *(const GAS f32x4*)(gk + 80 + 8 * fq), gb1 = *(const GAS f32x4*)(gk + 84 + 8 * fq);
                        const f32x4 c0 = *(const GAS f32x4*)(c32 + (size_t)t * 16 + 8 * fq), c1 = *(const GAS f32x4*)(c32 + (size_t)t * 16 + 8 * fq + 4), s0 = *(const GAS f32x4*)(s32 + (size_t)t * 16 + 8 * fq), s1 = *(const GAS f32x4*)(s32 + (size_t)t * 16 + 8 * fq + 4);
                        const f32x4 xa0 = a0 * rn * ga0, xa1 = a1 * rn * ga1, xb0 = b0 * rn * gb0, xb1 = b1 * rn * gb1;
                        *(GAS v4u*)(sl + ktile_off<96>(t, 8 + fq)) = pack8(xa0 * c0 - xb0 * s0, xa1 * c1 - xb1 * s1);
                        *(GAS v4u*)(sl + ktile_off<96>(t, 10 + fq)) = pack8(xb0 * c0 + xa0 * s0, xb1 * c1 + xa1 * s1);
                    }
                }
            }
    } else {
        const GAS float* bias = (const GAS float*)(g.ws + OFF_CBIAS) + g.ep * 256; GAS bf16* o0 = (GAS bf16*)(g.ws + OFF_HID) + (size_t)g.ep * 2048 * 256;
#pragma unroll
        for (int bj = 0; bj < 2; ++bj) {
            const int col0 = bj * 128 + wc * 32 + 8 * fq; const f32x4 b0 = *(const GAS f32x4*)(bias + col0), b1 = *(const GAS f32x4*)(bias + col0 + 4);
#pragma unroll
            for (int ai = 0; ai < 2; ++ai)
#pragma unroll
                for (int m = 0; m < 4; ++m) {
                    const int r = rbase + ai * 128 + m * 16; const f32x4 x0 = acc[ai][bj][m][0] + b0, x1 = acc[ai][bj][m][1] + b1;
                    const f32x4 y0 = {silu_f(x0[0]), silu_f(x0[1]), silu_f(x0[2]), silu_f(x0[3])}, y1 = {silu_f(x1[0]), silu_f(x1[1]), silu_f(x1[2]), silu_f(x1[3])};
                    *(GAS v4u*)(o0 + (size_t)r * 256 + col0) = pack8(y0, y1);
                }
        }
    }
}

template <int EPI> __device__ __forceinline__ void gemm_phase(LAS unsigned char* lds, const GemmDesc& g, int G, int cblk) {
    constexpr bool PERM = (EPI != EPI_RESID);
    using namespace pg8;
    int tid = threadIdx.x; asm volatile("" : "+v"(tid));
    const int wid = __builtin_amdgcn_readfirstlane(tid >> 6), lane = tid & 63, wr = wid >> 2, wc = wid & 3, fr = lane & 15, fq = lane >> 4;
    const int K = g.K, nt = K / BK, lda = g.lda;
    StaticOrder S; S.init(g.M, g.N, G, cblk);
    unsigned voffA[2], voffB[2];
#pragma unroll
    for (int i = 0; i < 2; ++i) { int R, C; stage_rc(tid * 16 + i * 8192, R, C); const int Rb = PERM ? ((R & ~31) + perm32(R & 31)) : R;
        voffA[i] = (unsigned)(R * lda + C) * 2u; voffB[i] = (unsigned)(Rb * K + C) * 2u; }
    const size_t kstep = (size_t)(BK * 2);
    const size_t hstepA = (size_t)HALF * lda * 2, hstepB = (size_t)HALF * K * 2;
    const size_t tstepA = 2 * hstepA, tstepB = 2 * hstepB;
    const unsigned ldsw = (unsigned)wid * 1024u;
    const int aoff = lds_byte(wr * 64 + fr, fq * 8), boff = lds_byte(wc * 32 + fr, fq * 8);
#define PG8_SA(b, h) (((b) * 2 + (h)) * HTB)
#define PG8_SB(b, h) ((4 + (b) * 2 + (h)) * HTB)
#define PG8_STAGE(bufoff, gbase, voff) do { _Pragma("unroll") for (int _i = 0; _i < 2; ++_i) \
        __builtin_amdgcn_global_load_lds((const unsigned*)((const char*)(gbase) + (voff)[_i]), (LAS unsigned*)(lds + (bufoff) + ldsw + _i * 8192), 16, 0, 0); } while (0)
#define PG8_LDA(dst, b, h) do { _Pragma("unroll") for (int m = 0; m < 4; ++m) _Pragma("unroll") for (int k = 0; k < 2; ++k) dst[m][k] = *(const LAS bf16x8*)(lds + PG8_SA(b, h) + aoff + m * 2048 + k * 1024); } while (0)
#define PG8_LDB(dst, b, h) do { _Pragma("unroll") for (int n = 0; n < 2; ++n) _Pragma("unroll") for (int k = 0; k < 2; ++k) dst[n][k] = *(const LAS bf16x8*)(lds + PG8_SB(b, h) + boff + n * 2048 + k * 1024); } while (0)
#define PG8_MMA(ai, bj, At, Bt) do { __builtin_amdgcn_s_setprio(1); _Pragma("unroll") for (int m = 0; m < 4; ++m) _Pragma("unroll") for (int n = 0; n < 2; ++n) _Pragma("unroll") for (int k = 0; k < 2; ++k) \
        acc[ai][bj][m][n] = __builtin_amdgcn_mfma_f32_16x16x32_bf16(Bt[n][k], At[m][k], acc[ai][bj][m][n], 0, 0, 0); __builtin_amdgcn_s_setprio(0); } while (0)
#define PG8_WAIT_V(n) asm volatile("s_waitcnt vmcnt(" #n ")" ::: "memory")
#define PG8_WAIT_L(n) asm volatile("s_waitcnt lgkmcnt(" #n ")" ::: "memory")
#define PG8_BAR __builtin_amdgcn_s_barrier()
#define PG8_SCHED __builtin_amdgcn_sched_barrier(0)
    Unit cur, nxt; int ui = 0;
    if (!S.next(0, cur)) return;
    f32x4 acc[2][2][4][2];
#pragma unroll
    for (int a = 0; a < 2; ++a)
#pragma unroll
        for (int b = 0; b < 2; ++b)
#pragma unroll
            for (int m = 0; m < 4; ++m)
#pragma unroll
                for (int n = 0; n < 2; ++n) acc[a][b][m][n] = (f32x4){0.f, 0.f, 0.f, 0.f};
    bf16x8 At[4][2], B0[2][2], B1[2][2];
    const char* cA = (const char*)g.A + (size_t)cur.pm * tstepA; const char* cB = (const char*)g.Bt + (size_t)cur.pn * tstepB;
    PG8_STAGE(PG8_SB(0, 0), cB, voffB); PG8_STAGE(PG8_SB(0, 1), cB + hstepB, voffB); PG8_STAGE(PG8_SA(0, 0), cA, voffA); PG8_STAGE(PG8_SA(0, 1), cA + hstepA, voffA);
    if (wr == 1) PG8_BAR;
    PG8_WAIT_V(2); PG8_BAR;
    PG8_STAGE(PG8_SB(1, 0), cB + kstep, voffB); PG8_STAGE(PG8_SA(1, 0), cA + kstep, voffA); PG8_STAGE(PG8_SB(1, 1), cB + hstepB + kstep, voffB);
    PG8_WAIT_V(6); PG8_BAR;
    for (;;) {
        const bool has_next = S.next(ui + 1, nxt);
        const char* nA = has_next ? (const char*)g.A + (size_t)nxt.pm * tstepA : cA; const char* nB = has_next ? (const char*)g.Bt + (size_t)nxt.pn * tstepB : cB;
        for (int t = 0; t < nt; t += 2) {
            const bool last = (t == nt - 2);
            const char* a1 = cA + (size_t)(t + 1) * kstep;
            const char* a2 = last ? nA : cA + (size_t)(t + 2) * kstep; const char* b2 = last ? nB : cB + (size_t)(t + 2) * kstep;
            const char* a3 = a2 + kstep; const char* b3 = b2 + kstep;
            PG8_LDB(B0, 0, 0); PG8_LDB(B1, 0, 1); PG8_SCHED; PG8_LDA(At, 0, 0); PG8_STAGE(PG8_SA(1, 1), a1 + hstepA, voffA);
            PG8_WAIT_V(8); PG8_WAIT_L(0); PG8_BAR; PG8_MMA(0, 0, At, B0); PG8_MMA(0, 1, At, B1); PG8_BAR; PG8_SCHED;
            PG8_LDA(At, 0, 1); PG8_STAGE(PG8_SB(0, 0), b2, voffB); PG8_STAGE(PG8_SB(0, 1), b2 + hstepB, voffB); PG8_STAGE(PG8_SA(0, 0), a2, voffA);
            PG8_WAIT_V(8); PG8_WAIT_L(0); PG8_BAR; PG8_MMA(1, 0, At, B0); PG8_MMA(1, 1, At, B1); PG8_BAR; PG8_SCHED;
            PG8_LDB(B0, 1, 0); PG8_LDB(B1, 1, 1); PG8_SCHED; PG8_LDA(At, 1, 0); PG8_STAGE(PG8_SA(0, 1), a2 + hstepA, voffA);
            PG8_WAIT_V(8); PG8_WAIT_L(0); PG8_BAR; PG8_MMA(0, 0, At, B0); PG8_MMA(0, 1, At, B1); PG8_BAR; PG8_SCHED;
            PG8_LDA(At, 1, 1); PG8_STAGE(PG8_SB(1, 0), b3, voffB); PG8_STAGE(PG8_SB(1, 1), b3 + hstepB, voffB); PG8_STAGE(PG8_SA(1, 0), a3, voffA);
            PG8_WAIT_V(8); PG8_WAIT_L(0); PG8_BAR; PG8_MMA(1, 0, At, B0); PG8_MMA(1, 1, At, B1); PG8_BAR; PG8_SCHED;
        }
        if (wr == 0) PG8_BAR;
        gemm_epilogue<EPI>(g, acc, cur, wr, wc, fr, fq);
        if (!has_next) break;
#pragma unroll
        for (int a = 0; a < 2; ++a)
#pragma unroll
            for (int b = 0; b < 2; ++b)
#pragma unroll
                for (int m = 0; m < 4; ++m)
#pragma unroll
                    for (int n = 0; n < 2; ++n) acc[a][b][m][n] = (f32x4){0.f, 0.f, 0.f, 0.f};
        cur = nxt; cA = nA; cB = nB; ++ui;
        if (wr == 1) PG8_BAR;
    }
    PG8_WAIT_V(0);
    PG8_BAR;
#undef PG8_SA
#undef PG8_SB
#undef PG8_STAGE
#undef PG8_LDA
#undef PG8_LDB
#undef PG8_MMA
#undef PG8_WAIT_V
#undef PG8_WAIT_L
#undef PG8_BAR
#undef PG8_SCHED
}

#define XB_TMO      128
#define XB_XCNT(j)  (256  + 64 * (j))
#define XB_XSUB(j)  (1280 + 64 * (j))
#define XB_XGEN(j)  (2304 + 64 * (j))
#define XB_TOP      3328
#define XB_TOPGEN   3392
#define XCD_BAR_WORDS 3456
#define XB_SPIN_CAP (1u << 23)
__device__ __forceinline__ unsigned xb_ld(unsigned* p)              { return __hip_atomic_load(p, __ATOMIC_RELAXED, __HIP_MEMORY_SCOPE_AGENT); }
__device__ __forceinline__ unsigned xb_add(unsigned* p, unsigned v) { return __hip_atomic_fetch_add(p, v, __ATOMIC_RELAXED, __HIP_MEMORY_SCOPE_AGENT); }
__device__ __forceinline__ unsigned xb_xcc_id() { return (unsigned)__builtin_amdgcn_s_getreg((3 << 11) | 20) & 0xFu; }
#define XB_SPIN(cond, bar) do { unsigned _sp = 0; while (cond) { __builtin_amdgcn_s_sleep(1); \
    if ((++_sp & 255u) == 0u) { if (xb_ld(&(bar)[XB_TMO])) break; if (_sp > XB_SPIN_CAP) { atomicAdd(&(bar)[XB_TMO], 1u); break; } } } } while (0)
struct XcdBarrier { unsigned* bar; unsigned x; volatile LAS unsigned* st; };
__device__ __forceinline__ XcdBarrier xcd_barrier_post(unsigned* bar, volatile LAS unsigned* st) {
    XcdBarrier b; b.bar = bar; b.x = xb_xcc_id(); b.st = st;
    if (threadIdx.x == 0) st[2] = xb_add(&bar[XB_XCNT(b.x)], 1u);
    return b;
}
__device__ __forceinline__ void xcd_barrier_complete(unsigned* bar, unsigned x, unsigned& nloc, unsigned& nx) {
    const unsigned G = gridDim.x * gridDim.y * gridDim.z;
    unsigned sum, cnt, mine, sp = 0u;
    for (;;) {
        sum = 0u; cnt = 0u; mine = 0u;
#pragma unroll
        for (unsigned j = 0; j < 16; ++j) { const unsigned c = xb_ld(&bar[XB_XCNT(j)]); sum += c; cnt += (c > 0u) ? 1u : 0u; mine = (j == x) ? c : mine; }
        if (sum == G) break;
        __builtin_amdgcn_s_sleep(1);
        if ((++sp & 255u) == 0u) { if (xb_ld(&bar[XB_TMO])) break; if (sp > XB_SPIN_CAP) { atomicAdd(&bar[XB_TMO], 1u); break; } }
    }
    nloc = mine > 0u ? mine : 1u; nx = cnt > 0u ? cnt : 1u;
}
__device__ __forceinline__ void xcd_barrier(const XcdBarrier& b, bool global = true) {
    asm volatile("s_waitcnt vmcnt(0)" ::: "memory");
    __syncthreads();
    if (threadIdx.x == 0) {
        unsigned* bar = b.bar;
        __builtin_amdgcn_s_waitcnt(0);
        unsigned nloc = b.st[0], nx = b.st[1];
        if (nloc == 0u) { xcd_barrier_complete(bar, b.x, nloc, nx); b.st[0] = nloc; b.st[1] = nx; }
        const unsigned old = xb_add(&bar[XB_XSUB(b.x)], 1u);
        const unsigned gen = old / nloc;
        if (!global) {
            if (old + 1u == (gen + 1u) * nloc) xb_add(&bar[XB_XGEN(b.x)], 1u);
            else XB_SPIN(xb_ld(&bar[XB_XGEN(b.x)]) == gen, bar);
            __builtin_amdgcn_fence(__ATOMIC_ACQUIRE, "agent");
            asm volatile("s_waitcnt vmcnt(0)" ::: "memory");
        } else if (old + 1u == (gen + 1u) * nloc) {
            __builtin_amdgcn_fence(__ATOMIC_RELEASE, "agent");
            asm volatile("s_waitcnt vmcnt(0)" ::: "memory");
            const unsigned og = xb_add(&bar[XB_TOP], 1u);
            const unsigned tg = og / nx;
            if (og + 1u == (tg + 1u) * nx) xb_add(&bar[XB_TOPGEN], 1u);
            else XB_SPIN(xb_ld(&bar[XB_TOPGEN]) == tg, bar);
            __builtin_amdgcn_fence(__ATOMIC_ACQUIRE, "agent");
            xb_add(&bar[XB_XGEN(b.x)], 1u);
            asm volatile("s_waitcnt vmcnt(0)" ::: "memory");
        } else {
            XB_SPIN(xb_ld(&bar[XB_XGEN(b.x)]) == gen, bar);
            __builtin_amdgcn_fence(__ATOMIC_ACQUIRE, "agent");
            asm volatile("s_waitcnt vmcnt(0)" ::: "memory");
        }
    }
    __syncthreads();
}

struct Frame {
    LAS unsigned char* lds; int tid, lane, wave, vcu, G;
    InTab in; float* out; unsigned char* ws;
};

__device__ __forceinline__ float wave_sum(float v) {
#pragma unroll
    for (int o = 1; o < 64; o <<= 1) v += __shfl_xor(v, o);
    return v;
}

enum { MAP_IDENT = 0, MAP_L0IN = 1, MAP_L1IN = 2, MAP_GATE0 = 3, MAP_GU = 4, MAP_KVB = 5 };
__device__ __forceinline__ int map_src(int kind, int n, int nsrc) {
    if (kind == MAP_IDENT) return n < nsrc ? n : -1;
    if (kind == MAP_GATE0) return n < 24 ? 1280 + n : -1;
    if (kind == MAP_GU) { const int tile = n >> 8, w = n & 127; return tile * 128 + w; }
    const int pn = n >> 8, slot = n & 255;
    const int hh = (slot >> 5) & 3, d = 32 * (slot >> 7) + (slot & 31), L = pn * 256 + hh * 64 + d;
    if (kind == MAP_KVB) return (2 * pn + (hh & 1)) * 128 + (hh >> 1) * 64 + d;
    if (kind == MAP_L0IN) {
        if (L < 512) return L;
        if (L < 1024) return 1304 + (L - 512);
        if (L < 1792) return 512 + (L - 1024);
        return 1816 + (L - 1792);
    }
    if (pn < 6) return L;
    if (pn == 6) return 1544 + slot;
    if (slot < 128) return 1800 + slot;
    if (slot < 160) return 1928 + (slot - 128);
    if (slot < 168) return 1536 + (slot - 160);
    return -1;
}
struct WDesc { const float* src; const float* src2; int K, nsrc, ndst; bf16* dst; const float* gain; int kind; };
__device__ __forceinline__ void conv_load(const WDesc& w, int item, int lane, f32x4 (&v)[8], float (&g)[8]) {
    const int nblk = w.ndst / 32, kb = item / nblk, nb = item % nblk, k0 = 64 * kb, n0 = 32 * nb;
    const int nq = 4 * (lane & 7), kr = lane >> 3; const int sc = map_src(w.kind, n0 + nq, w.nsrc);
    const float* src = (w.kind == MAP_GU && (n0 & 128)) ? w.src2 : w.src;
#pragma unroll
    for (int i = 0; i < 8; ++i) { const int kk = 8 * i + kr; v[i] = (f32x4){0.f, 0.f, 0.f, 0.f}; if (sc >= 0) v[i] = *(const f32x4*)(src + (size_t)(k0 + kk) * w.nsrc + sc); }
#pragma unroll
    for (int i = 0; i < 8; ++i) { g[i] = 1.f; if (w.gain) g[i] = w.gain[k0 + 8 * i + kr]; }
}
__device__ __forceinline__ void conv_finish(const WDesc& w, LAS float* scr, int item, int lane, const f32x4 (&v)[8], const float (&g)[8]) {
    const int nblk = w.ndst / 32, kb = item / nblk, nb = item % nblk, k0 = 64 * kb, n0 = 32 * nb;
    const int nq = 4 * (lane & 7), kr = lane >> 3;
#pragma unroll
    for (int i = 0; i < 8; ++i) { const int kk = 8 * i + kr; const float gsc = g[i];
        LAS float* d = scr + kk * 33 + nq; d[0] = v[i][0] * gsc; d[1] = v[i][1] * gsc; d[2] = v[i][2] * gsc; d[3] = v[i][3] * gsc; }
    LDS_WAIT(); asm volatile("" ::: "memory");
    const int c = lane & 7;
#pragma unroll
    for (int j = 0; j < 4; ++j) { const int nn = (lane >> 3) + 8 * j; const LAS float* s = scr + (8 * c) * 33 + nn;
        v4u o; o.x = pk2(s[0 * 33], s[1 * 33]); o.y = pk2(s[2 * 33], s[3 * 33]); o.z = pk2(s[4 * 33], s[5 * 33]); o.w = pk2(s[6 * 33], s[7 * 33]);
        *(v4u*)(w.dst + (size_t)(n0 + nn) * w.K + k0 + 8 * c) = o; }
    LDS_WAIT(); asm volatile("" ::: "memory");
}
constexpr int NMAT = 19;
__device__ __forceinline__ WDesc get_wdesc(const Frame& F, int id) {
    WDesc w; w.src2 = nullptr; w.gain = nullptr; w.kind = MAP_IDENT;
    InTab in = F.in; unsigned char* ws = F.ws;
    if (id < 4) { const int nb = id == 0 ? 1 : id == 1 ? 22 : id == 2 ? 26 : 42;
        w.src = in[nb + 1]; w.src2 = in[nb + 2]; w.gain = in[nb]; w.K = 1024; w.nsrc = FF; w.ndst = 2 * FF; w.dst = (bf16*)(ws + OFF_WGU + id * SZ_WGU); w.kind = MAP_GU; }
    else if (id < 8) { const int f = id - 4; const int nb = f == 0 ? 1 : f == 1 ? 22 : f == 2 ? 26 : 42;
        w.src = in[nb + 3]; w.K = FF; w.nsrc = 1024; w.ndst = 1024; w.dst = (bf16*)(ws + OFF_WD + f * SZ_WD); }
    else if (id == 8) { w.src = in[6]; w.gain = in[5]; w.K = 1024; w.nsrc = 2072; w.ndst = 2048; w.dst = (bf16*)(ws + OFF_WIN0); w.kind = MAP_L0IN; }
    else if (id == 9) { w.src = in[6]; w.gain = in[5]; w.K = 1024; w.nsrc = 2072; w.ndst = 32; w.dst = (bf16*)(ws + OFF_WG); w.kind = MAP_GATE0; }
    else if (id == 10) { w.src = in[21]; w.K = 1024; w.nsrc = 1024; w.ndst = 1024; w.dst = (bf16*)(ws + OFF_WOUT0); }
    else if (id == 11) { w.src = in[31]; w.gain = in[30]; w.K = 1024; w.nsrc = 1960; w.ndst = 2048; w.dst = (bf16*)(ws + OFF_WIN1); w.kind = MAP_L1IN; }
    else if (id == 12) { w.src = in[41]; w.K = 1024; w.nsrc = 1024; w.ndst = 1024; w.dst = (bf16*)(ws + OFF_WOUT1); }
    else if (id == 13) { w.src = in[36]; w.gain = in[35]; w.K = 256; w.nsrc = 768; w.ndst = 768; w.dst = (bf16*)(ws + OFF_WQB); }
    else if (id == 14) { w.src = in[38]; w.gain = in[37]; w.K = 128; w.nsrc = 1024; w.ndst = 1024; w.dst = (bf16*)(ws + OFF_WKVB); w.kind = MAP_KVB; }
    else if (id == 15) { w.src = in[14]; w.K = 2048; w.nsrc = 256; w.ndst = 256; w.dst = (bf16*)(ws + OFF_W1K); }
    else if (id == 16) { w.src = in[16]; w.K = 2048; w.nsrc = 256; w.ndst = 256; w.dst = (bf16*)(ws + OFF_W1V); }
    else if (id == 17) { w.src = in[15]; w.K = 256; w.nsrc = 64; w.ndst = 64; w.dst = (bf16*)(ws + OFF_W2K); }
    else { w.src = in[17]; w.K = 256; w.nsrc = 64; w.ndst = 64; w.dst = (bf16*)(ws + OFF_W2V); }
    return w;
}
__device__ __forceinline__ void convert_mats(Frame& F, unsigned mask, int gw, int NGW) {
    LAS float* scr = (LAS float*)(F.lds + F.wave * 16384);
    int base = 0;
    for (int id = 0; id < NMAT; ++id) {
        if (!((mask >> id) & 1u)) continue;
        const WDesc w = get_wdesc(F, id); const int nit = (w.K / 64) * (w.ndst / 32);
        int first = (gw - base) % NGW; if (first < 0) first += NGW;
        if (first < nit) { f32x4 va[8], vb[8]; float ga[8], gb[8]; conv_load(w, first, F.lane, va, ga);
            for (int it = first; it < nit; it += 2 * NGW) {
                if (it + NGW < nit) conv_load(w, it + NGW, F.lane, vb, gb);
                conv_finish(w, scr, it, F.lane, va, ga);
                if (it + NGW < nit) { if (it + 2 * NGW < nit) conv_load(w, it + 2 * NGW, F.lane, va, ga); conv_finish(w, scr, it + NGW, F.lane, vb, gb); }
            } }
        base = (base + nit) % NGW;
    }
}
constexpr unsigned MATS_P0 = (1u << 0) | (1u << 4) | (1u << 8);
constexpr unsigned MATS_P1 = (1u << 9) | (1u << 10) | (1u << 15) | (1u << 16) | (1u << 17) | (1u << 18);
constexpr unsigned MATS_P4 = (1u << 1) | (1u << 5) | (1u << 2) | (1u << 3) | (1u << 6) | (1u << 7) | (1u << 11) | (1u << 12) | (1u << 13) | (1u << 14);
constexpr unsigned MATS_P7 = 0u;
static_assert((MATS_P0 | MATS_P1 | MATS_P4 | MATS_P7) == (1u << NMAT) - 1u && (MATS_P0 & MATS_P1) == 0 && ((MATS_P0 | MATS_P1) & MATS_P4) == 0 && ((MATS_P0 | MATS_P1 | MATS_P4) & MATS_P7) == 0, "every matrix converted exactly once");
__device__ __forceinline__ void p0_prologue(Frame& F) {
    const int gw = F.vcu * NWAVES + F.wave, NGW = F.G * NWAVES;
    convert_mats(F, MATS_P0, gw, NGW);
    { const float* x = F.in[0]; bf16* xb = (bf16*)(F.ws + OFF_XBA); float* ssq = (float*)(F.ws + OFF_SSQ);
      for (int m0 = gw; m0 < NTOK; m0 += 8 * NGW) {
        f32x4 v[8][4];
#pragma unroll
        for (int q = 0; q < 8; ++q) { const int m = m0 + q * NGW; if (m < NTOK) { const f32x4* xr = (const f32x4*)(x + (size_t)m * DM) + F.lane;
#pragma unroll
            for (int j = 0; j < 4; ++j) v[q][j] = xr[64 * j]; } }
#pragma unroll
        for (int q = 0; q < 8; ++q) { const int m = m0 + q * NGW; if (m < NTOK) { float s = 0.f; v2u* o8 = (v2u*)(xb + (size_t)m * DM) + F.lane;
#pragma unroll
            for (int j = 0; j < 4; ++j) { const f32x4 t = v[q][j]; s += (t[0] * t[0] + t[1] * t[1]) + (t[2] * t[2] + t[3] * t[3]); v2u w; w.x = pk2(t[0], t[1]); w.y = pk2(t[2], t[3]); o8[64 * j] = w; }
            s = wave_sum(s);
            if (F.lane < 4) ssq[(size_t)m * 4 + F.lane] = F.lane == 0 ? s : 0.f; } }
      } }
    { float* c64 = (float*)(F.ws + OFF_ROPE64C); float* s64 = (float*)(F.ws + OFF_ROPE64S); float* c32 = (float*)(F.ws + OFF_ROPE32C); float* s32 = (float*)(F.ws + OFF_ROPE32S);
      const int gt = F.vcu * 512 + F.tid, NT = F.G * 512;
      for (int e = gt; e < SEQ * 32; e += NT) { const int t = e >> 5, i = e & 31; const float inv = 1.0f / powf(10000.0f, (float)(2 * i) / 64.0f); const float ang = (float)t * inv; c64[e] = cosf(ang); s64[e] = sinf(ang); }
      for (int e = gt; e < SEQ * 16; e += NT) { const int t = e >> 4, i = e & 15; const float inv = 1.0f / powf(10000.0f, (float)(2 * i) / 32.0f); const float ang = (float)t * inv; c32[e] = cosf(ang); s32[e] = sinf(ang); } }
    if (F.vcu < 256) {
        __syncthreads();
        const int oi = 2 * F.vcu + (F.tid >> 8), kv = oi >> 8, n = oi & 255, kc = F.tid & 255; const float* pos = F.in[kv ? 13 : 12]; const float* w1 = F.in[kv ? 16 : 14];
        float s = 0.f;
#pragma unroll
        for (int k = 0; k < 8; ++k) s += pos[kc * 8 + k] * w1[(size_t)(kc * 8 + k) * 256 + n];
        s = wave_sum(s);
        LAS float* red = (LAS float*)(F.lds);
        if (F.lane == 0) red[F.wave] = s;
        __syncthreads();
        if (F.tid < 2) ((float*)(F.ws + OFF_CBIAS))[2 * F.vcu + F.tid] = (red[4 * F.tid] + red[4 * F.tid + 1]) + (red[4 * F.tid + 2] + red[4 * F.tid + 3]);
        __syncthreads();
    }
}

__device__ __forceinline__ void gates_phase(Frame& F, int gw, int NGW) {
    const int lane = F.lane, fr = lane & 15, fq = lane >> 4;
    const bf16* xb = (const bf16*)(F.ws + OFF_XBA); const bf16* wg = (const bf16*)(F.ws + OFF_WG); const GAS float* ssq = (const GAS float*)(F.ws + OFF_SSQ);
    float* gates = (float*)(F.ws + OFF_GATES); const float* gb = F.in[7];
    for (int task = gw; task < NTOK / 16; task += NGW) {
        const int r0 = task * 16; f32x4 acc0 = {0.f, 0.f, 0.f, 0.f}, acc1 = {0.f, 0.f, 0.f, 0.f};
        const bf16* ap = xb + (size_t)(r0 + fr) * DM + 8 * fq; const bf16* bp0 = wg + (size_t)fr * DM + 8 * fq; const bf16* bp1 = wg + (size_t)(16 + fr) * DM + 8 * fq;
#pragma unroll 8
        for (int k = 0; k < DM; k += 32) {
            const bf16x8 a = *(const bf16x8*)(ap + k), b0 = *(const bf16x8*)(bp0 + k), b1 = *(const bf16x8*)(bp1 + k);
            acc0 = __builtin_amdgcn_mfma_f32_16x16x32_bf16(a, b0, acc0, 0, 0, 0); acc1 = __builtin_amdgcn_mfma_f32_16x16x32_bf16(a, b1, acc1, 0, 0, 0);
        }
#pragma unroll
        for (int j = 0; j < 4; ++j) { const int r = r0 + 4 * fq + j; const float rs = row_rstd16(ssq, r, 1.0f / 1024.0f);
            { const float z = acc0[j] * rs + gb[fr]; gates[(size_t)r * 24 + fr] = __builtin_amdgcn_rcpf(1.0f + ex2(-z * LOG2E)); }
            if (fr < 8) { const float z = acc1[j] * rs + gb[16 + fr]; gates[(size_t)r * 24 + 16 + fr] = __builtin_amdgcn_rcpf(1.0f + ex2(-z * LOG2E)); } }
    }
}
__device__ __forceinline__ void cmp2_tile(Frame& F, int kv, int pm) {
    const int lane = F.lane, fr = lane & 15, fq = lane >> 4;
    const bf16* hid = (const bf16*)(F.ws + OFF_HID) + (size_t)kv * 2048 * 256; const bf16* w2 = (const bf16*)(F.ws + (kv ? OFF_W2V : OFF_W2K));
    bf16* out = (bf16*)(F.ws + (kv ? OFF_VCMP : OFF_KCMP)); const float* gain = F.in[9];
    for (int rt = F.wave; rt < 16; rt += NWAVES) {
        const int r0 = pm * 256 + rt * 16; f32x4 acc[4];
#pragma unroll
        for (int c = 0; c < 4; ++c) acc[c] = (f32x4){0.f, 0.f, 0.f, 0.f};
        const bf16* ap = hid + (size_t)(r0 + fr) * 256 + 8 * fq;
#pragma unroll
        for (int k = 0; k < 256; k += 32) { const bf16x8 a = *(const bf16x8*)(ap + k);
#pragma unroll
            for (int c = 0; c < 4; ++c) { const bf16x8 b = *(const bf16x8*)(w2 + (size_t)(c * 16 + fr) * 256 + 8 * fq + k); acc[c] = __builtin_amdgcn_mfma_f32_16x16x32_bf16(a, b, acc[c], 0, 0, 0); } }
#pragma unroll
        for (int j = 0; j < 4; ++j) {
            float v[4];
#pragma unroll
            for (int c = 0; c < 4; ++c) v[c] = acc[c][j];
            if (kv == 0) { float ss = (v[0] * v[0] + v[1] * v[1]) + (v[2] * v[2] + v[3] * v[3]);
                ss += __shfl_xor(ss, 1); ss += __shfl_xor(ss, 2); ss += __shfl_xor(ss, 4); ss += __shfl_xor(ss, 8);
                const float r = rsq(ss * (1.0f / 64.0f) + EPS);
#pragma unroll
                for (int c = 0; c < 4; ++c) v[c] = v[c] * r * gain[c * 16 + fr]; }
#pragma unroll
            for (int c = 0; c < 4; ++c) { const int rr = r0 + 4 * fq + j, slab = rr >> 9, i = rr & 511, d = c * 16 + fr;
                out[(size_t)slab * 512 * 64 + (kv ? vtile_off(i, d) : ktile_off<64>(i, d >> 3) + (d & 7))] = (bf16)f2bf(v[c]); }
        }
    }
}

__device__ __forceinline__ void fox_scan(Frame& F, int bh) {
    const int b = bh >> 3, h = bh & 7; const float* fraw = (const float*)(F.ws + OFF_FRAW); const float fb = F.in[32][h];
    LAS float* red = (LAS float*)(F.lds);
    float v[16]; float run = 0.f; const int t0 = F.tid * 16;
#pragma unroll
    for (int i = 0; i < 16; ++i) { const float x = fraw[(size_t)bh * SEQ + t0 + i] + fb; const float ls2 = fminf(x, 0.f) * LOG2E - __builtin_amdgcn_logf(1.0f + ex2(-fabsf(x) * LOG2E)); run += ls2; v[i] = run; }
    float inc = run;
#pragma unroll
    for (int off = 1; off < 64; off <<= 1) { const float y = __shfl_up(inc, off); if (F.lane >= off) inc += y; }
    __syncthreads();
    if (F.lane == 63) red[F.wave] = inc;
    __syncthreads();
    float wbase = 0.f;
    for (int w = 0; w < F.wave; ++w) wbase += red[w];
    const float excl = wbase + inc - run;
    float* dc = (float*)(F.ws + OFF_DC2) + (size_t)bh * SEQ;
    bf16* QF = (bf16*)(F.ws + OFF_QF); bf16* KF = (bf16*)(F.ws + OFF_KF);
#pragma unroll
    for (int i = 0; i < 16; ++i) { const float val = excl + v[i]; const int t = t0 + i; dc[t] = val;
        const unsigned h1 = f2bf(val); const float r1 = val - bf2f((bf16)h1); const unsigned h2 = f2bf(r1); const float r2 = r1 - bf2f((bf16)h2); const unsigned h3 = f2bf(r2);
        const unsigned one = 0x3F80u;
        v4u qa; qa.x = one | (one << 16); qa.y = one | (h1 << 16); qa.z = h2 | (h3 << 16); qa.w = 0u;
        v4u ka; ka.x = (h1 ^ 0x8000u) | ((h2 ^ 0x8000u) << 16); ka.y = (h3 ^ 0x8000u) | (one << 16); ka.z = one | (one << 16); ka.w = 0u;
        const v4u z = {0u, 0u, 0u, 0u};
        bf16* qp = (bf16*)(F.ws + OFF_QAUG) + ((size_t)bh * SEQ + t) * 16; *(v4u*)qp = qa; *(v4u*)(qp + 8) = z;
        bf16* ksl = KF + (size_t)bh * SEQ * 80; *(v4u*)(ksl + ktile_off<80>(t, 8)) = ka; *(v4u*)(ksl + ktile_off<80>(t, 9)) = z; }
    __syncthreads();
}

__device__ __forceinline__ int fresh_tid() { int t = threadIdx.x; asm volatile("" : "+v"(t)); return t; }
namespace fa {
typedef float f32x16 __attribute__((ext_vector_type(16)));
typedef short s16x4 __attribute__((ext_vector_type(4)));
typedef short v4i16_t __attribute__((ext_vector_type(4)));
typedef LAS const char* lds_cptr;
constexpr int VSLOT = 8192, NSLOT = 4, IMPS = 129;
template <int DQK> struct Map { static constexpr int KS = DQK <= 64 ? 8192 : 12288, K = 0, V = NSLOT * KS, WS = V + NSLOT * VSLOT, IMP = WS + 8 * 256, SEL = IMP + 64 * IMPS * 4, END = SEL + 64 * 16; };
static_assert(Map<64>::END <= 131072 && Map<96>::IMP <= 131072, "attention LDS map");
__device__ __forceinline__ int crow(int r, int hi) { return (r & 3) + 8 * (r >> 2) + 4 * hi; }
__device__ __forceinline__ void glds16(const void* g, unsigned lds_base) {
    unsigned sv; asm volatile("s_mov_b32 %0, m0\n\ts_mov_b32 m0, %2\n\ts_nop 0\n\tglobal_load_lds_dwordx4 %1, off\n\ts_mov_b32 m0, %0" : "=&s"(sv) : "v"(g), "s"(lds_base) : "memory"); }
__device__ __forceinline__ s16x4 vtr(lds_cptr p) { return __builtin_bit_cast(s16x4, __builtin_amdgcn_ds_read_tr16_b64_v4i16((LAS v4i16_t*)p)); }
#define FA_MX3(a, b, c) __builtin_fmaxf(__builtin_fmaxf((a), (b)), (c))
#define FA_MFMA(a, b, c) __builtin_amdgcn_mfma_f32_32x32x16_bf16(a, b, c, 0, 0, 0)
__device__ __forceinline__ float rowmax(const f32x16& p0, const f32x16& p1) {
    float a = FA_MX3(p0[0], p0[1], p1[0]), b = FA_MX3(p0[2], p0[3], p1[1]); a = FA_MX3(a, p1[2], p1[3]);
#pragma unroll
    for (int r = 4; r < 16; r += 4) { a = FA_MX3(a, p0[r], p0[r + 1]); b = FA_MX3(b, p0[r + 2], p0[r + 3]); a = FA_MX3(a, p1[r], p1[r + 1]); b = FA_MX3(b, p1[r + 2], p1[r + 3]); }
    float m = __builtin_fmaxf(a, b); auto rr = __builtin_amdgcn_permlane32_swap(__float_as_uint(m), __float_as_uint(m), false, false);
    return __builtin_fmaxf(__uint_as_float(rr[0]), __uint_as_float(rr[1])); }
__device__ __forceinline__ float halfsum(float v) { auto rr = __builtin_amdgcn_permlane32_swap(__float_as_uint(v), __float_as_uint(v), false, false); return __uint_as_float(rr[0]) + __uint_as_float(rr[1]); }

struct PassArgs {
    const bf16* K; const bf16* V;
    int t_begin, t_end;
    int lo, hi;
    int lo_max, hi_min;
    int nomax;
};
__device__ __forceinline__ void wait_vm_bar(int n) {
    if (n == 0) asm volatile("s_waitcnt vmcnt(0) lgkmcnt(0)\n\ts_barrier" ::: "memory");
    else if (n == 1) asm volatile("s_waitcnt vmcnt(1) lgkmcnt(0)\n\ts_barrier" ::: "memory");
    else if (n == 2) asm volatile("s_waitcnt vmcnt(2) lgkmcnt(0)\n\ts_barrier" ::: "memory");
    else asm volatile("s_waitcnt vmcnt(3) lgkmcnt(0)\n\ts_barrier" ::: "memory");
}
template <int WSOFF> __device__ __forceinline__ void scale_rows(LAS char* shm, f32x16 (&o)[2], float f, int wid, int r32, int hi) {
    LAS float* wsf = (LAS float*)(shm + WSOFF) + wid * 64;
    if (hi == 0) wsf[r32] = f;
    asm volatile("s_waitcnt lgkmcnt(0)" ::: "memory");
#pragma unroll
    for (int r = 0; r < 16; ++r) { const float fr = wsf[crow(r, hi)]; o[0][r] *= fr; o[1][r] *= fr; }
    asm volatile("s_waitcnt lgkmcnt(0)" ::: "memory");
}
#ifndef FA_SKEW
#define FA_SKEW 0
#endif
constexpr float THR = 8.0f;
template <int DQK, int MODE, bool USE_SEL>
__device__ __forceinline__ void attn_pass(LAS char* shm, const bf16x8 (&qr)[DQK / 16], const PassArgs& pa, const unsigned (&sel)[4], f32x16 (&o)[2], float& m, float& l, float invl, int tok) {
    typedef Map<DQK> MP;
    const int tid = fresh_tid(), lane = tid & 63, r32 = lane & 31, hi = lane >> 5; const int wid = __builtin_amdgcn_readfirstlane(tid >> 6);
    constexpr int NCH = DQK / 8, ND = DQK / 16;
    const int nt = pa.t_end - pa.t_begin;
    const bool two_k = (wid + 8 < NCH);
    const int pt = (MODE == 1 ? 0 : 1) + 1 + (two_k ? 1 : 0);
    const bool skew = FA_SKEW && (MODE == 0) && (wid >= 4);
    const bf16* ksrc = pa.K + wid * 512 + lane * 8;
    const bf16* vsrc = pa.V + wid * 512 + lane * 8;
    const unsigned lds0 = (unsigned)(uintptr_t)shm;
#define FA_ISSUE(t_, slot_) do { const size_t ko_ = (size_t)(t_) * 64 * DQK; \
        glds16(ksrc + ko_, (unsigned)__builtin_amdgcn_readfirstlane(lds0 + MP::K + (slot_) * MP::KS + wid * 1024)); \
        if (two_k) glds16(ksrc + ko_ + 8 * 512, (unsigned)__builtin_amdgcn_readfirstlane(lds0 + MP::K + (slot_) * MP::KS + (wid + 8) * 1024)); \
        if (MODE != 1) glds16(vsrc + (size_t)(t_) * 4096, (unsigned)__builtin_amdgcn_readfirstlane(lds0 + MP::V + (slot_) * VSLOT + wid * 1024)); } while (0)
    if (nt <= 0) return;
    asm volatile("s_waitcnt vmcnt(0)" ::: "memory");
    FA_ISSUE(pa.t_begin, 0); if (nt > 1) FA_ISSUE(pa.t_begin + 1, 1);
    const float NEG = -__builtin_inff();
    f32x16 p0, p1; v4u pw[4];
    p0 = f32x16{}; p1 = f32x16{};
    bf16x8 kf[2 * ND]; s16x4 vl[8], vh[8];
#define FA_LOADK(sl, D0A, D0B) do { const lds_cptr kp = (lds_cptr)shm + MP::K + (sl) * MP::KS + hi * 1024 + r32 * 16; \
        _Pragma("unroll") for (int d0 = (D0A); d0 < (D0B); ++d0) { kf[2 * d0] = *(const LAS bf16x8*)(kp + d0 * 2048); kf[2 * d0 + 1] = *(const LAS bf16x8*)(kp + d0 * 2048 + 512); } \
        __builtin_amdgcn_sched_barrier(0); } while (0)
#define FA_LOADV(sl) do { if (MODE != 1) { const lds_cptr vp = (lds_cptr)shm + MP::V + (sl) * VSLOT + ((lane >> 4) & 1) * 32 + (lane & 3) * 8 + (4 * hi + ((lane & 15) >> 2)) * 64; \
        _Pragma("unroll") for (int d0 = 0; d0 < 2; ++d0) _Pragma("unroll") for (int ks = 0; ks < 4; ++ks) { vl[d0 * 4 + ks] = vtr(vp + d0 * 4096 + ks * 1024); vh[d0 * 4 + ks] = vtr(vp + d0 * 4096 + ks * 1024 + 512); } \
        __builtin_amdgcn_sched_barrier(0); } } while (0)
#define FA_SEG_A(t) do { \
        f32x16 cin; float c_ = -m; \
        if (USE_SEL) { const unsigned w_ = (t) < 32 ? sel[0] : (t) < 64 ? sel[1] : (t) < 96 ? sel[2] : sel[3]; c_ = ((w_ >> ((t) & 31)) & 1u) ? -m : NEG; } \
        _Pragma("unroll") for (int r = 0; r < 16; ++r) cin[r] = c_; \
        _Pragma("unroll") for (int d0 = 0; d0 < ND; ++d0) { \
            if (d0 == 0) { p0 = FA_MFMA(kf[0], qr[0], cin); p1 = FA_MFMA(kf[1], qr[0], cin); } \
            else { p0 = FA_MFMA(kf[2 * d0], qr[d0], p0); p1 = FA_MFMA(kf[2 * d0 + 1], qr[d0], p1); } } \
        if (!(64 * (t) >= pa.lo_max && 64 * (t) + 63 <= pa.hi_min)) { \
            const int kb = 64 * (t) + 4 * hi; \
            _Pragma("unroll") for (int r = 0; r < 16; ++r) { const int kv = kb + (r & 3) + 8 * (r >> 2); \
                if (kv < pa.lo || kv > pa.hi) p0[r] = NEG; if (kv + 32 < pa.lo || kv + 32 > pa.hi) p1[r] = NEG; } } \
        __builtin_amdgcn_sched_barrier(0); \
    } while (0)
#define FA_SEG_B(t) do { \
        if (MODE != 2) { \
            float rm = 0.f; if (!pa.nomax) rm = rowmax(p0, p1); \
            if (!pa.nomax && __any(rm > THR)) { \
                const float dl = __builtin_fmaxf(rm, 0.f); m += dl; const float alpha = ex2(-dl); l *= alpha; \
                _Pragma("unroll") for (int r = 0; r < 16; ++r) { p0[r] -= dl; p1[r] -= dl; } \
                if (MODE == 0) scale_rows<MP::WS>(shm, o, alpha, wid, r32, hi); \
            } \
            float ls = 0.f; \
            _Pragma("unroll") for (int r = 0; r < 16; ++r) { p0[r] = ex2(p0[r]); p1[r] = ex2(p1[r]); ls += p0[r] + p1[r]; } \
            l += ls; \
        } else { \
            _Pragma("unroll") for (int r = 0; r < 16; ++r) { p0[r] = ex2(p0[r]) * invl; p1[r] = ex2(p1[r]) * invl; } \
            LAS unsigned* imp = (LAS unsigned*)(shm + MP::IMP) + tok * IMPS; \
            _Pragma("unroll") for (int half = 0; half < 2; ++half) \
            _Pragma("unroll") for (int g = 0; g < 4; ++g) { \
                const float x0 = half ? p1[4 * g] : p0[4 * g], x1 = half ? p1[4 * g + 1] : p0[4 * g + 1], x2 = half ? p1[4 * g + 2] : p0[4 * g + 2], x3 = half ? p1[4 * g + 3] : p0[4 * g + 3]; \
                const int jsel = 16 * (t) + 8 * half + 2 * g + hi; \
                const unsigned a = (unsigned)((32.f * ((x0 + x1) + x2) + 16.f * x3) * 2097152.f + 0.5f), c = (unsigned)(16.f * x3 * 2097152.f + 0.5f); \
                if (jsel < 128) __hip_atomic_fetch_add(imp + jsel, a, __ATOMIC_RELAXED, __HIP_MEMORY_SCOPE_WORKGROUP); \
                if (jsel + 1 < 128) __hip_atomic_fetch_add(imp + jsel + 1, c, __ATOMIC_RELAXED, __HIP_MEMORY_SCOPE_WORKGROUP); } \
        } \
        if (MODE != 1) { \
            pw[0] = (v4u){pk2(p0[0], p0[1]), pk2(p0[2], p0[3]), pk2(p0[4], p0[5]), pk2(p0[6], p0[7])}; \
            pw[1] = (v4u){pk2(p0[8], p0[9]), pk2(p0[10], p0[11]), pk2(p0[12], p0[13]), pk2(p0[14], p0[15])}; \
            pw[2] = (v4u){pk2(p1[0], p1[1]), pk2(p1[2], p1[3]), pk2(p1[4], p1[5]), pk2(p1[6], p1[7])}; \
            pw[3] = (v4u){pk2(p1[8], p1[9]), pk2(p1[10], p1[11]), pk2(p1[12], p1[13]), pk2(p1[14], p1[15])}; } \
        __builtin_amdgcn_sched_barrier(0); \
    } while (0)
#define FA_SEG_C() do { if (MODE != 1) { \
        _Pragma("unroll") for (int d0 = 0; d0 < 2; ++d0) \
        _Pragma("unroll") for (int ks = 0; ks < 4; ++ks) { \
            const s16x4 a_ = vl[d0 * 4 + ks], b_ = vh[d0 * 4 + ks]; \
            const bf16x8 vf = {a_[0], a_[1], a_[2], a_[3], b_[0], b_[1], b_[2], b_[3]}; \
            o[d0] = FA_MFMA(__builtin_bit_cast(bf16x8, pw[ks]), vf, o[d0]); } \
        __builtin_amdgcn_sched_barrier(0); } } while (0)
    int slot = 0, pslot = 0;
    for (int i = 0; i < nt; ++i) {
        const int t = pa.t_begin + i;
        wait_vm_bar((i + 1 < nt) ? pt : 0);
        if (i + 2 < nt) { const int s2 = (slot + 2) & 3; FA_ISSUE(t + 2, s2); }
        if (!skew) { FA_LOADK(slot, 0, ND); FA_SEG_A(t); FA_LOADV(slot); FA_SEG_B(t); FA_SEG_C(); }
        else { if (i > 0) { FA_LOADV(pslot); FA_SEG_B(t - 1); FA_LOADK(slot, 0, ND / 2); FA_SEG_C(); FA_LOADK(slot, ND / 2, ND); } else { FA_LOADK(slot, 0, ND); } FA_SEG_A(t); }
        pslot = slot; slot = (slot + 1) & 3;
    }
    if (skew) { FA_LOADV(pslot); FA_SEG_B(pa.t_end - 1); FA_SEG_C(); }
    asm volatile("s_waitcnt lgkmcnt(0)\n\ts_barrier" ::: "memory");
#undef FA_ISSUE
#undef FA_SEG_A
#undef FA_LOADK
#undef FA_LOADV
#undef FA_SEG_B
#undef FA_SEG_C
}
template <int DQK> __device__ __forceinline__ void write_o(LAS char* shm, const f32x16 (&o)[2], bf16* dst, int pitch, int wid, int lane) {
    typedef Map<DQK> MP;
    const int r32 = lane & 31, hi = lane >> 5;
    LAS bf16* stg = (LAS bf16*)(shm + (wid < 4 ? MP::K + 2 * MP::KS + wid * 4096 : MP::V + 2 * VSLOT + (wid - 4) * 4096));
#pragma unroll
    for (int r = 0; r < 16; ++r) { const int orow = crow(r, hi);
#pragma unroll
        for (int d0 = 0; d0 < 2; ++d0) stg[orow * 64 + d0 * 32 + r32] = (bf16)f2bf(o[d0][r]); }
    asm volatile("s_waitcnt lgkmcnt(0)" ::: "memory");
#pragma unroll
    for (int i = 0; i < 4; ++i) { const int row = i * 8 + (lane >> 3), ch = lane & 7; const v4u v = *(const LAS v4u*)(stg + row * 64 + ch * 8); *(v4u*)(dst + (size_t)row * pitch + ch * 8) = v; }
    asm volatile("s_waitcnt lgkmcnt(0)" ::: "memory");
}
template <int ND> __device__ __forceinline__ void load_q(bf16x8 (&qr)[ND], const bf16* qrow, int hi) {
#pragma unroll
    for (int d0 = 0; d0 < ND; ++d0) qr[d0] = *(const bf16x8*)(qrow + d0 * 16 + hi * 8);
}
template <int ND> __device__ __forceinline__ void mla_q_finish(bf16x8 (&qr)[ND], const float* gq, const float* c32, const float* s32, int t, int hi) {
    if constexpr (ND == 6) {
        float x[6][8]; float ss = 0.f;
#pragma unroll
        for (int d0 = 0; d0 < 6; ++d0) { const v4u w = __builtin_bit_cast(v4u, qr[d0]);
            x[d0][0] = bflo(w.x); x[d0][1] = bfhi(w.x); x[d0][2] = bflo(w.y); x[d0][3] = bfhi(w.y); x[d0][4] = bflo(w.z); x[d0][5] = bfhi(w.z); x[d0][6] = bflo(w.w); x[d0][7] = bfhi(w.w);
#pragma unroll
            for (int j = 0; j < 8; ++j) ss += x[d0][j] * x[d0][j]; }
        ss = halfsum(ss);
        const float rn = rsq(ss * (1.0f / 96.0f) + EPS);
#pragma unroll
        for (int d0 = 0; d0 < 6; ++d0) { const f32x4 g0 = *(const f32x4*)(gq + 16 * d0 + 8 * hi), g1 = *(const f32x4*)(gq + 16 * d0 + 8 * hi + 4);
#pragma unroll
            for (int j = 0; j < 4; ++j) { x[d0][j] *= rn * g0[j]; x[d0][4 + j] *= rn * g1[j]; } }
        const f32x4 c0 = *(const f32x4*)(c32 + (size_t)t * 16 + 8 * hi), c1 = *(const f32x4*)(c32 + (size_t)t * 16 + 8 * hi + 4), s0 = *(const f32x4*)(s32 + (size_t)t * 16 + 8 * hi), s1 = *(const f32x4*)(s32 + (size_t)t * 16 + 8 * hi + 4);
#pragma unroll
        for (int j = 0; j < 8; ++j) { const float c = j < 4 ? c0[j & 3] : c1[j & 3], sn = j < 4 ? s0[j & 3] : s1[j & 3]; const float a = x[4][j], bb = x[5][j]; x[4][j] = a * c - bb * sn; x[5][j] = bb * c + a * sn; }
#pragma unroll
        for (int d0 = 0; d0 < 6; ++d0) { v4u w; w.x = pk2(x[d0][0] * C2_96, x[d0][1] * C2_96); w.y = pk2(x[d0][2] * C2_96, x[d0][3] * C2_96); w.z = pk2(x[d0][4] * C2_96, x[d0][5] * C2_96); w.w = pk2(x[d0][6] * C2_96, x[d0][7] * C2_96); qr[d0] = __builtin_bit_cast(bf16x8, w); }
    }
}
template <int DQK> __device__ __forceinline__ void l1_unit(LAS char* shm, int bh, int qb, int t_first, int nomax, const bf16* Q, const bf16* K, const bf16* V, bf16* O, const float* gq, const float* c32, const float* s32, const bf16* qaug) {
    const int wid = __builtin_amdgcn_readfirstlane(fresh_tid() >> 6);
    const int b = bh >> 3, h = bh & 7, q0 = qb * 256;
    f32x16 o[2]; o[0] = f32x16{}; o[1] = f32x16{}; float m = 0.f, l = 0.f;
    { const int lane = fresh_tid() & 63, r32 = lane & 31, hi = lane >> 5; const int qpos = q0 + 32 * wid + r32; const size_t row = (size_t)b * SEQ + qpos;
      bf16x8 qr[DQK / 16]; load_q<DQK / 16>(qr, Q + (row * 8 + h) * DQK, hi);
      if (DQK == 80) qr[DQK / 16 - 1] = *(const bf16x8*)(qaug + ((size_t)bh * SEQ + qpos) * 16 + hi * 8);
      if (DQK == 96) mla_q_finish(qr, gq, c32, s32, qpos, hi);
      PassArgs pa; pa.K = K + (size_t)bh * SEQ * DQK; pa.V = V + (size_t)bh * SEQ * 64; pa.t_begin = t_first; pa.t_end = (q0 + 256) / 64; pa.nomax = nomax;
      pa.lo = 0; pa.hi = qpos; pa.lo_max = 0; pa.hi_min = q0 + 32 * wid;
      const unsigned sel[4] = {0u, 0u, 0u, 0u};
      attn_pass<DQK, 0, false>(shm, qr, pa, sel, o, m, l, 0.f, 0); }
    { const int lane = fresh_tid() & 63, r32 = lane & 31, hi = lane >> 5;
      const float lt = halfsum(l); scale_rows<Map<DQK>::WS>(shm, o, lt > 0.f ? 1.0f / lt : 0.f, wid, r32, hi);
      write_o<DQK>(shm, o, O + ((size_t)b * SEQ + q0 + 32 * wid) * 1024 + h * 64, 1024, wid, lane); }
}
__device__ __forceinline__ float gain_absmax(const float* g, int n, int lane) {
    float v = 0.f; for (int i = lane; i < n; i += 64) v = __builtin_fmaxf(v, __builtin_fabsf(g[i]));
#pragma unroll
    for (int o = 1; o < 64; o <<= 1) v = __builtin_fmaxf(v, __shfl_xor(v, o));
    return __builtin_bit_cast(float, __builtin_amdgcn_readfirstlane(__builtin_bit_cast(int, v)));
}
constexpr int CW_Q1 = 12288;
__device__ __forceinline__ void att1_phase(Frame& F) {
    LAS char* shm = (LAS char*)F.lds; unsigned char* ws = F.ws; unsigned* ctl = (unsigned*)(ws + OFF_CTL);
    const int lane0 = fresh_tid() & 63;
    const float bq = gain_absmax(F.in[33], 64, lane0), bk = gain_absmax(F.in[34], 64, lane0), mq = gain_absmax(F.in[39], 96, lane0), mk = gain_absmax(F.in[40], 96, lane0);
    const float Bf = C2_64 * 64.f * bq * bk * 1.02f, Bm = C2_96 * 96.f * mq * mk * 1.02f;
    const int nomax_f = Bf <= 40.f, nomax_m = Bm <= 40.f;
    const float thr = 2.f * Bf + 43.f;
    LAS int* slotw = (LAS int*)(shm + 130048);
    const int myq = (F.vcu * 8) / F.G;
    for (;;) {
        __syncthreads();
        if (threadIdx.x == 0) { int got = -1;
            for (int k = 0; k < 8 && got < 0; ++k) { const int q = (myq + k) & 7; const unsigned id = __hip_atomic_fetch_add(ctl + CW_Q1 + 64 * q, 1u, __ATOMIC_RELAXED, __HIP_MEMORY_SCOPE_AGENT); if (id < 128u) got = q * 128 + (int)id; }
            *slotw = got; }
        __syncthreads();
        const int u = *slotw; if (u < 0) break;
        const int q = u >> 7, id = u & 127, fox = id >> 6, bh = 2 * q + ((id >> 5) & 1), qb = 31 - (id & 31);
        if (!fox) l1_unit<96>(shm, bh, qb, 0, nomax_m, (const bf16*)(ws + OFF_QM), (const bf16*)(ws + OFF_KM), (const bf16*)(ws + OFF_VM), (bf16*)(ws + OFF_O1) + 512, F.in[39], (const float*)(ws + OFF_ROPE32C), (const float*)(ws + OFF_ROPE32S), nullptr);
        else {
            const float* dc = (const float*)(ws + OFF_DC2) + (size_t)bh * SEQ; const float lim = dc[qb * 256] + thr;
            int lo = 0, hi = 4 * qb;
            while (lo < hi) { const int mid = (lo + hi) >> 1; if (dc[64 * mid + 63] < lim) hi = mid; else lo = mid + 1; }
            l1_unit<80>(shm, bh, qb, lo, nomax_f, (const bf16*)(ws + OFF_QF), (const bf16*)(ws + OFF_KF), (const bf16*)(ws + OFF_VF), (bf16*)(ws + OFF_O1), nullptr, nullptr, nullptr, (const bf16*)(ws + OFF_QAUG));
        }
    }
}
__device__ __forceinline__ void l0_unit(Frame& F, LAS char* shm, int bhk, int tb, int nomax) {
    const int wid = __builtin_amdgcn_readfirstlane(fresh_tid() >> 6);
    unsigned char* ws = F.ws;
    const int b = bhk >> 1, hk = bhk & 1, g = wid >> 1, th = wid & 1, h = hk * 4 + g, t0 = tb * 64;
    const size_t kvofs = (size_t)bhk * SEQ * 64;
    const bf16* KS = (const bf16*)(ws + OFF_KV8 + 2 * SZ_KV) + kvofs; const bf16* VS = (const bf16*)(ws + OFF_KV8 + 3 * SZ_KV) + kvofs;
    const bf16* KW = (const bf16*)(ws + OFF_KV8 + 4 * SZ_KV) + kvofs; const bf16* VW = (const bf16*)(ws + OFF_KV8 + 5 * SZ_KV) + kvofs;
    const bf16* KB = (const bf16*)(ws + OFF_KV8 + 6 * SZ_KV) + kvofs; const bf16* VB = (const bf16*)(ws + OFF_KV8 + 7 * SZ_KV) + kvofs;
    const bf16* KCM = (const bf16*)(ws + OFF_KCMP) + (size_t)bhk * 512 * 64; const bf16* VCM = (const bf16*)(ws + OFF_VCMP) + (size_t)bhk * 512 * 64;
    bf16* QO = (bf16*)(ws + OFF_QO); const bf16* QC = (const bf16*)(ws + OFF_QC);
    LAS unsigned* IMP = (LAS unsigned*)(shm + Map<64>::IMP); LAS unsigned* SEL = (LAS unsigned*)(shm + Map<64>::SEL);
    const unsigned nosel[4] = {0u, 0u, 0u, 0u};
    f32x16 o[2]; bf16x8 qr[4]; PassArgs pa; float m, l; pa.nomax = nomax;
#define CTX() const int tid_ = fresh_tid(), lane = tid_ & 63, r32 = lane & 31, hi = lane >> 5; const int tok = 32 * th + r32, tq = t0 + tok; const size_t row = (size_t)b * SEQ + tq; (void)hi; (void)row; (void)tq; (void)tok; (void)lane
#define GATE(i) (((const float*)(ws + OFF_GATES))[row * 24 + h * 3 + (i)])
#define ACCP() f32x4* accp = (f32x4*)(ws + OFF_OACC) + (size_t)F.vcu * 4096 + wid * 512 + lane
#define ACC_AT(d0, g) accp[((d0) * 4 + (g)) * 64]
#define O4(d0, g) (f32x4){o[d0][4 * (g)], o[d0][4 * (g) + 1], o[d0][4 * (g) + 2], o[d0][4 * (g) + 3]}
    { CTX();
      for (int i = tid_; i < 64 * IMPS; i += 512) IMP[i] = 0u;
      load_q<4>(qr, QC + row * 512 + h * 64, hi);
      pa.K = KCM; pa.V = VCM; pa.t_begin = 0; pa.t_end = ((((t0 + 32) >> 4) + 1) + 63) >> 6;
      pa.lo = 0; pa.hi = (tq - 31) >> 4; pa.lo_max = 0; pa.hi_min = (t0 + 32 * th - 31) >> 4;
      o[0] = f32x16{}; o[1] = f32x16{}; m = 0.f; l = 0.f;
      attn_pass<64, 1, false>(shm, qr, pa, nosel, o, m, l, 0.f, 0);
      const float lt = halfsum(l); const float invl = lt > 0.f ? 1.0f / lt : 0.f;
      attn_pass<64, 2, false>(shm, qr, pa, nosel, o, m, l, invl, tok); }
    { CTX(); ACCP();
      scale_rows<Map<64>::WS>(shm, o, GATE(0), wid, r32, hi);
#pragma unroll
      for (int d0 = 0; d0 < 2; ++d0)
#pragma unroll
        for (int g4 = 0; g4 < 4; ++g4) ACC_AT(d0, g4) = O4(d0, g4); }
    { CTX(); const int cur = tb;
      const int j0 = lane, j1 = lane + 64;
      const bool f0 = (j0 == 0) || (j0 == cur) || (j0 == cur - 1), f1 = (j1 == cur) || (j1 == cur - 1);
      const unsigned long long lt_mask = (1ull << lane) - 1ull;
      for (int kg = 0; kg < 8; kg += 4) {
        int k0[4], k1[4]; unsigned T[4];
#pragma unroll
        for (int u = 0; u < 4; ++u) { const int tk = wid * 8 + kg + u;
            k0[u] = f0 ? 0x7fffffff : (j0 <= cur ? (int)IMP[tk * IMPS + j0] : -1); k1[u] = f1 ? 0x7fffffff : (j1 <= cur ? (int)IMP[tk * IMPS + j1] : -1); T[u] = 0u; }
        for (int bit = 28; bit >= 0; --bit) {
#pragma unroll
            for (int u = 0; u < 4; ++u) { const int cand = (int)(T[u] | (1u << bit));
                const int c = __builtin_popcountll(__ballot(k0[u] >= cand)) + __builtin_popcountll(__ballot(k1[u] >= cand));
                T[u] = c >= 16 ? (unsigned)cand : T[u]; }
        }
#pragma unroll
        for (int u = 0; u < 4; ++u) { const int tk = wid * 8 + kg + u;
            const int c0 = __builtin_popcountll(__ballot(k0[u] >= 0)) + __builtin_popcountll(__ballot(k1[u] >= 0));
            const int Tq = c0 >= 16 ? (int)T[u] : -1;
            const unsigned long long gt0 = __ballot(k0[u] > Tq), gt1 = __ballot(k1[u] > Tq), eq0 = __ballot(k0[u] == Tq), eq1 = __ballot(k1[u] == Tq);
            const int need = 16 - (__builtin_popcountll(gt0) + __builtin_popcountll(gt1));
            const int rk0 = __builtin_popcountll(eq0 & lt_mask), rk1 = __builtin_popcountll(eq0) + __builtin_popcountll(eq1 & lt_mask);
            const bool s0 = (k0[u] > Tq || (k0[u] == Tq && rk0 < need)) && j0 <= cur, s1 = (k1[u] > Tq || (k1[u] == Tq && rk1 < need)) && j1 <= cur;
            const unsigned long long b0 = __ballot(s0), b1 = __ballot(s1);
            if (lane == 0) { SEL[tk * 4 + 0] = (unsigned)b0; SEL[tk * 4 + 1] = (unsigned)(b0 >> 32); SEL[tk * 4 + 2] = (unsigned)b1; SEL[tk * 4 + 3] = (unsigned)(b1 >> 32); } }
      } }
    asm volatile("s_waitcnt lgkmcnt(0)\n\ts_barrier" ::: "memory");
    { CTX();
      unsigned sel[4]; sel[0] = SEL[tok * 4 + 0]; sel[1] = SEL[tok * 4 + 1]; sel[2] = SEL[tok * 4 + 2]; sel[3] = SEL[tok * 4 + 3];
      load_q<4>(qr, QO + row * 1024 + h * 64, hi);
      pa.K = KS; pa.V = VS; pa.t_begin = 0; pa.t_end = tb + 1; pa.lo = 0; pa.hi = tq; pa.lo_max = 0; pa.hi_min = t0 + 32 * th;
      o[0] = f32x16{}; o[1] = f32x16{}; m = 0.f; l = 0.f;
      attn_pass<64, 0, true>(shm, qr, pa, sel, o, m, l, 0.f, 0); }
    { CTX(); ACCP();
      const float lt = halfsum(l); scale_rows<Map<64>::WS>(shm, o, lt > 0.f ? GATE(1) / lt : 0.f, wid, r32, hi);
#pragma unroll
      for (int d0 = 0; d0 < 2; ++d0)
#pragma unroll
        for (int g4 = 0; g4 < 4; ++g4) { const f32x4 a = ACC_AT(d0, g4); ACC_AT(d0, g4) = a + O4(d0, g4); } }
    { CTX();
      pa.K = KW; pa.V = VW; pa.t_begin = tb > 8 ? tb - 8 : 0; pa.t_end = tb + 1; pa.lo = tq - 511; pa.hi = tq; pa.lo_max = t0 + 32 * th + 31 - 511; pa.hi_min = t0 + 32 * th;
      o[0] = f32x16{}; o[1] = f32x16{}; m = 0.f; l = 0.f;
      attn_pass<64, 0, false>(shm, qr, pa, nosel, o, m, l, 0.f, 0); }
    { CTX(); ACCP();
      const float lt = halfsum(l); scale_rows<Map<64>::WS>(shm, o, lt > 0.f ? GATE(2) / lt : 0.f, wid, r32, hi);
#pragma unroll
      for (int d0 = 0; d0 < 2; ++d0)
#pragma unroll
        for (int g4 = 0; g4 < 4; ++g4) { const f32x4 a = ACC_AT(d0, g4); o[d0][4 * g4] += a[0]; o[d0][4 * g4 + 1] += a[1]; o[d0][4 * g4 + 2] += a[2]; o[d0][4 * g4 + 3] += a[3]; }
      write_o<64>(shm, o, QO + ((size_t)b * SEQ + t0 + 32 * th) * 1024 + h * 64, 1024, wid, lane); }
    { CTX();
      load_q<4>(qr, QO + row * 1024 + 512 + h * 64, hi);
      pa.K = KB; pa.V = VB; pa.t_begin = tb > 2 ? tb - 2 : 0; pa.t_end = tb + 1; pa.lo = tq - 127; pa.hi = tq; pa.lo_max = t0 + 32 * th + 31 - 127; pa.hi_min = t0 + 32 * th;
      o[0] = f32x16{}; o[1] = f32x16{}; m = 0.f; l = 0.f;
      attn_pass<64, 0, false>(shm, qr, pa, nosel, o, m, l, 0.f, 0); }
    { CTX();
      const float lt = halfsum(l); const float sk = F.in[20][h] * LOG2E; const float M2 = __builtin_fmaxf(m, sk); const float a = ex2(m - M2); const float den = lt * a + ex2(sk - M2);
      scale_rows<Map<64>::WS>(shm, o, a / den, wid, r32, hi);
      write_o<64>(shm, o, QO + ((size_t)b * SEQ + t0 + 32 * th) * 1024 + 512 + h * 64, 1024, wid, lane); }
#undef CTX
#undef GATE
#undef ACCP
#undef ACC_AT
#undef O4
}
__device__ __forceinline__ void att0_phase(Frame& F) {
    LAS char* shm = (LAS char*)F.lds;
    const int bhk = F.vcu >> 6, s = F.vcu & 63; const int lane0 = fresh_tid() & 63;
    float gq = __builtin_fmaxf(gain_absmax(F.in[8], 64, lane0), gain_absmax(F.in[18], 64, lane0));
    float gk = __builtin_fmaxf(__builtin_fmaxf(gain_absmax(F.in[9], 64, lane0), gain_absmax(F.in[10], 64, lane0)), __builtin_fmaxf(gain_absmax(F.in[11], 64, lane0), gain_absmax(F.in[19], 64, lane0)));
    const int nomax = (C2_64 * 64.f * gq * gk * 1.02f) <= 40.f;
    for (int i = 0; i < 2; ++i) l0_unit(F, shm, bhk, i == 0 ? s : 127 - s, nomax);
}
}

__device__ __forceinline__ void refresh_frame(Frame& F) { const int t = fresh_tid(); F.tid = t; F.lane = t & 63; F.wave = __builtin_amdgcn_readfirstlane(t >> 6); }
constexpr int RING_BYTES = 131072, MISC_OFF = RING_BYTES + 320, INTAB_OFF = RING_BYTES + 1024, LDS_BYTES = 147456;
constexpr int NPHASE = 18;
struct Args { const float* in[46]; float* out; unsigned char* ws; int ph_lo, ph_hi; };

__global__ void __launch_bounds__(NWAVES * 64, 2) mega_fwd(Args args) {
    extern __shared__ __attribute__((aligned(16))) unsigned char lds[];
    Frame F;
    F.lds = (LAS unsigned char*)lds; F.tid = threadIdx.x; F.lane = F.tid & 63; F.wave = __builtin_amdgcn_readfirstlane(F.tid >> 6);
    F.G = gridDim.x; { const int bx = blockIdx.x; F.vcu = (F.G % 8 == 0) ? (bx % 8) * (F.G / 8) + bx / 8 : bx; }
    F.in = (InTab)(F.lds + INTAB_OFF); F.out = args.out; F.ws = args.ws;
    volatile LAS unsigned* MISC = (volatile LAS unsigned*)(F.lds + MISC_OFF);
    for (int u = F.tid; u < (LDS_BYTES - RING_BYTES) / 4; u += NWAVES * 64) ((LAS unsigned*)(F.lds + RING_BYTES))[u] = 0u;
    __syncthreads();
    { const __attribute__((address_space(4))) fptr_t* ka = (const __attribute__((address_space(4))) fptr_t*)__builtin_amdgcn_kernarg_segment_ptr();
      if (F.tid < 46) F.in[F.tid] = ka[F.tid]; }
    __syncthreads();
    unsigned* ctl = (unsigned*)(F.ws + OFF_CTL);
    XcdBarrier bar = xcd_barrier_post(ctl + 4096, MISC + 8);
    const int lo = args.ph_lo, hi = args.ph_hi;
    int vb = (int)blockIdx.x; bool xlocal = false;
#define IN(k) (refresh_frame(F), lo <= (k) && (k) < hi)
#define BOTH(k) (IN(k) && IN((k) + 1))
#define SEAM_G(k) do { if (BOTH(k)) { xcd_barrier(bar, true); } } while (0)
#define SEAM_L(k) do { if (BOTH(k)) xcd_barrier(bar, !xlocal); } while (0)
#define SEAM(k) SEAM_G(k)
#define GD_INIT() GemmDesc gd; gd.in = F.in; gd.ws = F.ws; gd.out = F.out; gd.ep = 0; gd.M = NTOK; gd.K = DM; gd.lda = DM; gd.N = DM; gd.A = nullptr; gd.Bt = nullptr; const int bx = vb; unsigned char* ws = F.ws
#define FFN_PHASES(p0_, fidx_, cfgb_, first_, last_) \
    if (IN(p0_)) { GD_INIT(); gd.A = (const bf16*)(ws + ((cfgb_) ? OFF_XBB : OFF_XBA)); gd.Bt = (const bf16*)(ws + OFF_WGU + (fidx_) * SZ_WGU); gd.N = 2 * FF; gd.ep = (cfgb_) ? 1 : 0; \
        gemm_phase<EPI_GATEUP>(F.lds, gd, F.G, bx); } \
    SEAM_L(p0_); \
    if (IN((p0_) + 1)) { GD_INIT(); gd.A = (const bf16*)(ws + ((cfgb_) ? OFF_ACTB : OFF_ACTA)); gd.Bt = (const bf16*)(ws + OFF_WD + (fidx_) * SZ_WD); gd.K = FF; gd.lda = FF; gd.ep = ((first_) ? 1 : 0) | ((cfgb_) ? 16 : 0) | ((last_) ? 32 : 0); \
        gemm_phase<EPI_RESID>(F.lds, gd, F.G, bx); } \
    SEAM_L((p0_) + 1)

    if (IN(0)) p0_prologue(F);
    SEAM(0);
    if (lo == 0 && hi > 1) {
        unsigned* bw = ctl + 4096; bool ok = (F.G == 256);
#pragma unroll
        for (unsigned j = 0; j < 16; ++j) { const unsigned c = xb_ld(&bw[XB_XCNT(j)]); ok = ok && (c == (j < 8u ? 32u : 0u)); }
        const unsigned rank = MISC[10];
        if (ok && bar.x < 8u && rank < 32u) { vb = (int)(rank * 8u + bar.x); xlocal = true; }
        vb = __builtin_amdgcn_readfirstlane(vb);
        F.vcu = (vb % 8) * (F.G / 8) + vb / 8;
    }
    if (IN(1)) { GD_INIT(); gd.A = (const bf16*)(ws + OFF_XBA); gd.Bt = (const bf16*)(ws + OFF_WGU); gd.N = 2 * FF;
        gemm_phase<EPI_GATEUP>(F.lds, gd, F.G, bx);
        const int nfull = (NTOK / 256) * (2 * FF / 256) - 5 * F.G;
        if (bx >= nfull) { refresh_frame(F); convert_mats(F, MATS_P1, (bx - nfull) * NWAVES + F.wave, (F.G - nfull) * NWAVES); } }
    SEAM_L(1);
    if (IN(2)) { GD_INIT(); gd.A = (const bf16*)(ws + OFF_ACTA); gd.Bt = (const bf16*)(ws + OFF_WD); gd.K = FF; gd.lda = FF; gd.ep = 1;
        gemm_phase<EPI_RESID>(F.lds, gd, F.G, bx); }
    SEAM_L(2);
    if (IN(3)) { GD_INIT(); gd.A = (const bf16*)(ws + OFF_XBA); gd.Bt = (const bf16*)(ws + OFF_WIN0); gd.N = 2048; gemm_phase<EPI_L0IN>(F.lds, gd, F.G, bx); }
    SEAM(3);
    if (IN(4)) {
        GD_INIT();
        for (int gi = 0; gi < 2; ++gi) {
            gd.A = (const bf16*)(ws + OFF_KV8 + gi * SZ_KV); gd.Bt = (const bf16*)(ws + (gi ? OFF_W1V : OFF_W1K)); gd.M = 2048; gd.N = 256; gd.K = 2048; gd.lda = 1024; gd.ep = gi;
            gemm_phase<EPI_CMP1>(F.lds, gd, F.G, (bx + gi * 128) % F.G);
        }
        bool has_unit = false;
        for (int i = 0; i < 2; ++i) { const int cb = (bx + i * 128) % F.G; pg8::StaticOrder S; S.init(2048, 256, F.G, cb); pg8::Unit u;
            for (int k = 0; S.next(k, u); ++k) { cmp2_tile(F, i, u.pm); has_unit = true; } }
        if (!has_unit) {
            const int b2 = bx < 8 ? 0 : (bx < 128 ? bx - 8 : bx - 16);
            refresh_frame(F); __syncthreads(); convert_mats(F, MATS_P4, b2 * NWAVES + F.wave, (F.G - 16) * NWAVES); __syncthreads();
            refresh_frame(F); gates_phase(F, b2 * NWAVES + F.wave, (F.G - 16) * NWAVES); }
    }
    SEAM(4);
    if (IN(5)) fa::att0_phase(F);
    SEAM(5);
    if (IN(6)) { GD_INIT(); gd.A = (const bf16*)(ws + OFF_QO); gd.Bt = (const bf16*)(ws + OFF_WOUT0); gd.ep = 4; gemm_phase<EPI_RESID>(F.lds, gd, F.G, bx); }
    SEAM_L(6);
    if (IN(7)) { GD_INIT(); gd.A = (const bf16*)(ws + OFF_XBA); gd.Bt = (const bf16*)(ws + OFF_WGU + SZ_WGU); gd.N = 2 * FF;
        gemm_phase<EPI_GATEUP>(F.lds, gd, F.G, bx);
        const int nfull = (NTOK / 256) * (2 * FF / 256) - 5 * F.G;
        if (MATS_P7 != 0u && bx >= nfull) { refresh_frame(F); convert_mats(F, MATS_P7, (bx - nfull) * NWAVES + F.wave, (F.G - nfull) * NWAVES); } }
    SEAM_L(7);
    if (IN(8)) { GD_INIT(); gd.A = (const bf16*)(ws + OFF_ACTA); gd.Bt = (const bf16*)(ws + OFF_WD + SZ_WD); gd.K = FF; gd.lda = FF; gd.ep = 8;
        gemm_phase<EPI_RESID>(F.lds, gd, F.G, bx); }
    SEAM_L(8);
    FFN_PHASES(9, 2, false, false, false);
    if (IN(11)) { GD_INIT(); gd.A = (const bf16*)(ws + OFF_XBA); gd.Bt = (const bf16*)(ws + OFF_WIN1); gd.N = 2048; gemm_phase<EPI_L1IN>(F.lds, gd, F.G, bx); }
    SEAM(11);
    if (IN(12)) {
        GD_INIT();
        gd.A = (const bf16*)(ws + OFF_CQ); gd.Bt = (const bf16*)(ws + OFF_WQB); gd.N = 768; gd.K = 256; gd.lda = 256;
        gemm_phase<EPI_QB>(F.lds, gd, F.G, bx);
        gd.A = (const bf16*)(ws + OFF_CKV); gd.Bt = (const bf16*)(ws + OFF_WKVB); gd.N = 1024; gd.K = 128; gd.lda = 128;
        if (bx < F.G - 16) gemm_phase<EPI_KVB>(F.lds, gd, F.G - 16, (bx + 48) % (F.G - 16));
        else { refresh_frame(F); fox_scan(F, bx - (F.G - 16)); }
    }
    SEAM(12);
    if (IN(14)) fa::att1_phase(F);
    SEAM(14);
    if (IN(15)) { GD_INIT(); gd.A = (const bf16*)(ws + OFF_O1); gd.Bt = (const bf16*)(ws + OFF_WOUT1); gd.ep = 2 | 4; gemm_phase<EPI_RESID>(F.lds, gd, F.G, bx); }
    SEAM_L(15);
    FFN_PHASES(16, 3, true, false, true);
#undef IN
#undef BOTH
#undef SEAM
#undef GD_INIT
#undef FFN_PHASES
}

extern "C" void kernel_launch(void* const* d_in, const int* in_sizes, int n_in, void* d_out, int out_size, void* d_ws, size_t ws_size, hipStream_t stream) {
    static int grid = 0;
    if (grid == 0) {
        if (n_in != 46 || in_sizes[0] != NTOK * DM || out_size != NTOK * DM || ws_size < WS_END) { fprintf(stderr, "kernel_launch: unexpected shapes (n_in %d, ws %zu)\n", n_in, ws_size); grid = -1; return; }
        int dev = 0, cus = 0, per_cu = 0;
        hipGetDevice(&dev); hipDeviceGetAttribute(&cus, hipDeviceAttributeMultiprocessorCount, dev);
        hipFuncSetAttribute((const void*)mega_fwd, hipFuncAttributeMaxDynamicSharedMemorySize, LDS_BYTES);
        hipOccupancyMaxActiveBlocksPerMultiprocessor(&per_cu, (const void*)mega_fwd, NWAVES * 64, LDS_BYTES);
        if (per_cu < 1) { fprintf(stderr, "kernel_launch: occupancy query says %d blocks per CU\n", per_cu); per_cu = 1; }
        (void)hipGetLastError();
        grid = cus;
        if (grid > cus * per_cu) grid = cus * per_cu;
    }
    if (grid < 0) return;
    hipMemsetAsync((char*)d_ws + OFF_CTL, 0, CTL_BYTES, stream);
    Args a{};
    for (int i = 0; i < 46; ++i) a.in[i] = (const float*)d_in[i];
    a.out = (float*)d_out; a.ws = (unsigned char*)d_ws; a.ph_lo = 0; a.ph_hi = NPHASE;
    void* kargs[] = {&a};
    hipError_t e = hipLaunchCooperativeKernel((const void*)mega_fwd, dim3(grid), dim3(NWAVES * 64), kargs, LDS_BYTES, stream);
    if (e != hipSuccess) fprintf(stderr, "kernel_launch: cooperative launch failed: %s (grid %d)\n", hipGetErrorString(e), grid);
}
```

```cpp
#include <hip/hip_runtime.h>
#include <hip/hip_cooperative_groups.h>
#include <cstdio>
#include <cstdint>
namespace cg = cooperative_groups;

#define GAS __attribute__((address_space(1)))
#define LAS __attribute__((address_space(3)))
typedef unsigned short bf16;
typedef unsigned v4u __attribute__((ext_vector_type(4)));
typedef unsigned v2u __attribute__((ext_vector_type(2)));
typedef float f32x4 __attribute__((ext_vector_type(4)));
typedef float f32x2 __attribute__((ext_vector_type(2)));
typedef short bf16x8 __attribute__((ext_vector_type(8)));
typedef __bf16 bf16x2_t __attribute__((ext_vector_type(2)));

constexpr int NTOK = 16384, SEQ = 8192, DM = 1024, FF = 2816;
constexpr float EPS = 1e-6f;
constexpr float LOG2E = 1.4426950408889634f;
constexpr float C2_64 = 0.125f * LOG2E;
constexpr float C2_96 = 0.10206207261596575f * LOG2E;
constexpr int NWAVES = 8;

constexpr size_t MiB = 1u << 20, KiB = 1u << 10;
constexpr size_t OFF_CTL = 0, CTL_BYTES = 64 * KiB;
constexpr size_t OFF_SSQ = 1 * MiB;
constexpr size_t OFF_ROPE64C = 2 * MiB, OFF_ROPE64S = 3 * MiB;
constexpr size_t OFF_ROPE32C = 4 * MiB, OFF_ROPE32S = 4 * MiB + 512 * KiB;
constexpr size_t OFF_GATES = 5 * MiB;
constexpr size_t OFF_CBIAS = 6 * MiB + 512 * KiB;
constexpr size_t OFF_SSQCQ = 7 * MiB, OFF_SSQCKV = 7 * MiB + 256 * KiB;
constexpr size_t OFF_SSQKR = 6 * MiB + 768 * KiB;
constexpr size_t OFF_DC2 = 7 * MiB + 512 * KiB;
constexpr size_t OFF_FRAW = 8 * MiB;
constexpr size_t OFF_KR = 8 * MiB + 512 * KiB;
constexpr size_t OFF_WG = 9 * MiB + 512 * KiB;
constexpr size_t OFF_W2K = OFF_WG + 64 * KiB, OFF_W2V = OFF_W2K + 32 * KiB;
constexpr size_t OFF_KCMP = 10 * MiB, OFF_VCMP = 10 * MiB + 256 * KiB;
constexpr size_t OFF_HID = 11 * MiB;
constexpr size_t OFF_WGU = 13 * MiB;
constexpr size_t OFF_WD = 57 * MiB;
constexpr size_t SZ_WGU = 11 * MiB, SZ_WD = 5 * MiB + 512 * KiB;
constexpr size_t OFF_WIN0 = 79 * MiB, OFF_WIN1 = 83 * MiB, OFF_WOUT0 = 87 * MiB, OFF_WOUT1 = 89 * MiB;
constexpr size_t OFF_WQB = 91 * MiB, OFF_WKVB = 91 * MiB + 512 * KiB;
constexpr size_t OFF_W1K = 92 * MiB, OFF_W1V = 93 * MiB;
constexpr size_t OFF_XBA = 94 * MiB, OFF_ACTA = 126 * MiB;
constexpr size_t OFF_XBB = 126 * MiB, OFF_ACTB = 158 * MiB;
constexpr size_t OFF_QO = 126 * MiB;
constexpr size_t OFF_QC = 158 * MiB;
constexpr size_t OFF_OACC = 208 * MiB;
constexpr size_t OFF_KV8 = 174 * MiB;
constexpr size_t SZ_KV = 4 * MiB;
constexpr size_t OFF_QF = 126 * MiB;
constexpr size_t OFF_KF = 146 * MiB;
constexpr size_t OFF_VF = 166 * MiB;
constexpr size_t OFF_QM = 182 * MiB;
constexpr size_t OFF_VM = 206 * MiB;
constexpr size_t OFF_KM = 222 * MiB;
constexpr size_t OFF_CQ = 13 * MiB;
constexpr size_t OFF_CKV = 24 * MiB;
constexpr size_t OFF_O1 = 13 * MiB;
constexpr size_t OFF_QAUG = 246 * MiB;
constexpr size_t WS_END = 256 * MiB;

__device__ __forceinline__ unsigned f2bf(float f) { unsigned u = __builtin_bit_cast(unsigned, f); return (u + 0x7fffu + ((u >> 16) & 1u)) >> 16; }
__device__ __forceinline__ unsigned pk2(float lo, float hi) { f32x2 v = {lo, hi}; bf16x2_t b = __builtin_convertvector(v, bf16x2_t); return __builtin_bit_cast(unsigned, b); }
__device__ __forceinline__ float bflo(unsigned w) { return __builtin_bit_cast(float, w << 16); }
__device__ __forceinline__ float bfhi(unsigned w) { return __builtin_bit_cast(float, w & 0xffff0000u); }
__device__ __forceinline__ float bf2f(bf16 h) { return __builtin_bit_cast(float, (unsigned)h << 16); }
__device__ __forceinline__ float ex2(float x) { return __builtin_amdgcn_exp2f(x); }
__device__ __forceinline__ float rsq(float x) { return __builtin_amdgcn_rsqf(x); }
#define LDS_WAIT() asm volatile("s_waitcnt lgkmcnt(0)" ::: "memory")
#define VM_WAIT() asm volatile("s_waitcnt vmcnt(0)" ::: "memory")

template <int DQK> __device__ __forceinline__ size_t ktile_off(int t, int c) { return (size_t)(t >> 6) * (64 * DQK) + c * 512 + (t & 63) * 8; }
__device__ __forceinline__ size_t vtile_off(int t, int d) { return (size_t)(t >> 6) * 4096 + (d >> 5) * 2048 + (t & 63) * 32 + (d & 31); }
namespace pg8 {
constexpr int BM = 256, BK = 64, HALF = 128, HTB = HALF * BK * 2, STAGE_BYTES = 8 * HTB, NXCD = 8, WGM = 8;
__device__ __forceinline__ int lds_byte(int r, int c) { const int st = (r >> 4) * 2 + (c >> 5), rr = r & 15, cc = c & 31, ob = rr * 64 + cc * 2; return st * 1024 + (ob ^ (((ob >> 9) & 1) << 5)); }
__device__ __forceinline__ void stage_rc(int b, int& R, int& C) { const int st = b / 1024, sb = b % 1024, swz = sb ^ (((sb >> 9) & 1) << 5); R = (st >> 1) * 16 + swz / 64; C = (st & 1) * 32 + (swz % 64) / 2; }
__device__ __forceinline__ int perm32(int rho) { const int n = rho >> 4, i = rho & 15; return 8 * (i >> 2) + 4 * n + (i & 3); }
struct Unit { int pm, pn; };
struct StaticOrder {
    int nM, nN, nwg, G, c;
    __device__ __forceinline__ void init(int M, int N, int G_, int c_) { nM = M / BM; nN = N / BM; nwg = nM * nN; G = G_; c = c_; }
    __device__ __forceinline__ bool next(int i, Unit& u) const {
        const int L = i * G + c; if (L >= nwg) return false;
        int wgid = L; { const int q = nwg / NXCD, r = nwg % NXCD, xcd = wgid % NXCD, off = wgid / NXCD; wgid = (xcd < r ? xcd * (q + 1) : r * (q + 1) + (xcd - r) * q) + off; }
        const int nig = WGM * nN, gid = wgid / nig, fm = gid * WGM, gsz = (nM - fm) < WGM ? (nM - fm) : WGM;
        u.pm = fm + ((wgid % nig) % gsz); u.pn = (wgid % nig) / gsz; return true;
    }
};
}

typedef const float* fptr_t;
typedef LAS fptr_t* InTab;
enum { EPI_GATEUP = 0, EPI_RESID = 1, EPI_L0IN = 2, EPI_L1IN = 3, EPI_QB = 4, EPI_KVB = 5, EPI_CMP1 = 6 };
struct GemmDesc {
    const bf16* A; const bf16* Bt; int M, N, K, lda;
    int ep;
    float* out;
    InTab in;
    unsigned char* ws;
};

__device__ __forceinline__ float row_rstd16(const GAS float* ssq, int r, float inv_n) {
    const f32x4 a = *(const GAS f32x4*)(ssq + (size_t)r * 4);
    return rsq(((a[0] + a[1]) + (a[2] + a[3])) * inv_n + EPS);
}
__device__ __forceinline__ float row_rstd4(const GAS float* ssq, int r, float inv_n) {
    const f32x4 a = *(const GAS f32x4*)(ssq + (size_t)r * 4);
    return rsq(((a[0] + a[1]) + (a[2] + a[3])) * inv_n + EPS);
}
__device__ __forceinline__ float silu_f(float g) { return g * __builtin_amdgcn_rcpf(1.0f + ex2(-g * LOG2E)); }
__device__ __forceinline__ v4u pack8(const f32x4 a, const f32x4 b) { v4u w; w.x = pk2(a[0], a[1]); w.y = pk2(a[2], a[3]); w.z = pk2(b[0], b[1]); w.w = pk2(b[2], b[3]); return w; }

__device__ __forceinline__ void head_norm_rope(f32x4 (&v)[2][2], f32x4 (&w)[2][2], int mode, const GAS float* gain, const GAS float* cosT, const GAS float* sinT, int t, int fq) {
    if (mode == 0) return;
    float ss = 0.f;
#pragma unroll
    for (int bj = 0; bj < 2; ++bj)
#pragma unroll
        for (int n = 0; n < 2; ++n) ss += (v[bj][n][0] * v[bj][n][0] + v[bj][n][1] * v[bj][n][1]) + (v[bj][n][2] * v[bj][n][2] + v[bj][n][3] * v[bj][n][3]);
    ss += __shfl_xor(ss, 16); ss += __shfl_xor(ss, 32);
    const float r = rsq(ss * (1.0f / 64.0f) + EPS);
#pragma unroll
    for (int bj = 0; bj < 2; ++bj)
#pragma unroll
        for (int n = 0; n < 2; ++n) { const f32x4 g = *(const GAS f32x4*)(gain + 32 * bj + 8 * fq + 4 * n); v[bj][n] = v[bj][n] * r * g; }
    if (mode == 2) {
#pragma unroll
        for (int n = 0; n < 2; ++n) {
            const f32x4 c = *(const GAS f32x4*)(cosT + (size_t)t * 32 + 8 * fq + 4 * n), s = *(const GAS f32x4*)(sinT + (size_t)t * 32 + 8 * fq + 4 * n);
            w[0][n] = v[0][n] * c - v[1][n] * s; w[1][n] = v[1][n] * c + v[0][n] * s;
        }
    }
}

template <int EPI> __device__ __forceinline__ void gemm_epilogue(const GemmDesc& g_, const f32x4 (&acc)[2][2][4][2], const pg8::Unit& u, int wr, int wc, int fr, int fq) {
    asm volatile("" : "+v"(fr), "+v"(fq));
    GemmDesc g = g_;
    { unsigned long long w_ = (unsigned long long)g.ws; asm volatile("" : "+s"(w_)); g.ws = (unsigned char*)w_; }
    { unsigned t_ = (unsigned)(uintptr_t)g.in; asm volatile("" : "+s"(t_)); g.in = (InTab)(uintptr_t)t_; }
    const int rbase = u.pm * 256 + wr * 64 + fr;
    if constexpr (EPI == EPI_GATEUP) {
        const int col0 = u.pn * 128 + wc * 32 + 8 * fq;
#pragma unroll
        for (int ai = 0; ai < 2; ++ai)
#pragma unroll
            for (int m = 0; m < 4; ++m) {
                const int r = rbase + ai * 128 + m * 16; const float rs = row_rstd16((const GAS float*)(g.ws + OFF_SSQ), r, 1.0f / 1024.0f);
                const float k1 = -rs * LOG2E, rs2 = rs * rs;
                f32x4 a[2];
#pragma unroll
                for (int n = 0; n < 2; ++n) { const f32x4 ga = acc[ai][0][m][n], ua = acc[ai][1][m][n]; const f32x4 x = ga * k1, gu = ga * ua;
                    const f32x4 rc = {__builtin_amdgcn_rcpf(1.0f + ex2(x[0])), __builtin_amdgcn_rcpf(1.0f + ex2(x[1])), __builtin_amdgcn_rcpf(1.0f + ex2(x[2])), __builtin_amdgcn_rcpf(1.0f + ex2(x[3]))};
                    a[n] = gu * (rc * rs2); }
                *(GAS v4u*)((GAS bf16*)(g.ws + ((g.ep & 1) ? OFF_ACTB : OFF_ACTA)) + (size_t)r * FF + col0) = pack8(a[0], a[1]);
            }
    } else if constexpr (EPI == EPI_RESID) {
        const GAS float* xin32 = (const GAS float*)g.in[0]; GAS float* xout = (GAS float*)g.out;
        const GAS bf16* xsrc = (const GAS bf16*)(g.ws + ((g.ep & 16) ? OFF_XBB : OFF_XBA)); GAS bf16* xb = (GAS bf16*)(g.ws + ((g.ep & 2) ? OFF_XBB : OFF_XBA)); GAS float* ssq_out = (GAS float*)(g.ws + OFF_SSQ);
        const float alpha = (g.ep & 4) ? 1.0f : 0.5f; const bool first = (g.ep & 1) != 0, last = (g.ep & 32) != 0;
        LAS float* red = (LAS float*)((LAS unsigned char*)g.in - 1024 + 2048);
#pragma unroll
        for (int ai = 0; ai < 2; ++ai)
#pragma unroll
            for (int m = 0; m < 4; ++m) {
                const int r = rbase + ai * 128 + m * 16; float ss = 0.f;
#pragma unroll
                for (int bj = 0; bj < 2; ++bj)
#pragma unroll
                    for (int n = 0; n < 2; ++n) {
                        const size_t off = (size_t)r * DM + u.pn * 256 + bj * 128 + wc * 32 + n * 16 + 4 * fq;
                        f32x4 xo;
                        if (first) xo = *(const GAS f32x4*)(xin32 + off);
                        else { const v2u w = *(const GAS v2u*)(xsrc + off); xo = (f32x4){bflo(w.x), bfhi(w.x), bflo(w.y), bfhi(w.y)}; }
                        const f32x4 xn = xo + acc[ai][bj][m][n] * alpha;
                        if (last) *(GAS f32x4*)(xout + off) = xn;
                        else { v2u w; w.x = pk2(xn[0], xn[1]); w.y = pk2(xn[2], xn[3]); *(GAS v2u*)(xb + off) = w;
                            const f32x4 xq = {bflo(w.x), bfhi(w.x), bflo(w.y), bfhi(w.y)};
                            ss += (xq[0] * xq[0] + xq[1] * xq[1]) + (xq[2] * xq[2] + xq[3] * xq[3]); }
                    }
                ss += __shfl_xor(ss, 16); ss += __shfl_xor(ss, 32);
                if (!last && fq == 0) red[(wr * 128 + ai * 64 + m * 16 + fr) * 4 + wc] = ss;
            }
        if (!last) {
            asm volatile("s_waitcnt lgkmcnt(0)\n\ts_barrier" ::: "memory");
            const int tid_ = wr * 256 + wc * 64 + (fq * 16 + fr);
            if (tid_ < 256) { const int rr = tid_; const int wr2 = rr >> 7, rem = rr & 127, ai2 = rem >> 6, m2 = (rem >> 4) & 3, fr2 = rem & 15;
                const f32x4 p = *(const LAS f32x4*)(red + rr * 4);
                ssq_out[(size_t)(u.pm * 256 + wr2 * 64 + ai2 * 128 + m2 * 16 + fr2) * 4 + u.pn] = (p[0] + p[1]) + (p[2] + p[3]); }
            asm volatile("s_waitcnt lgkmcnt(0)\n\ts_barrier" ::: "memory");
        }
    } else if constexpr (EPI == EPI_L0IN) {
        const int pn = u.pn, hh = wc; int mode; const GAS float* gain = nullptr; GAS bf16* dst; GAS bf16* dst2 = nullptr; int tokmajor, pitch, colofs, isv_ = 0; float sc = 1.f;
        GAS unsigned char* ws = (GAS unsigned char*)g.ws;
        if (pn < 2) { mode = 2; gain = (const GAS float*)g.in[8]; dst = (GAS bf16*)(ws + OFF_QO); dst2 = (GAS bf16*)(ws + OFF_QC); tokmajor = 1; pitch = 1024; colofs = (pn * 4 + hh) * 64; sc = C2_64; }
        else if (pn < 4) { mode = 2; gain = (const GAS float*)g.in[18]; dst = (GAS bf16*)(ws + OFF_QO); tokmajor = 1; pitch = 1024; colofs = 512 + ((pn - 2) * 4 + hh) * 64; sc = C2_64; }
        else { const int isv = hh >> 1, hk = hh & 1; const int tens = (pn - 4) * 2 + isv; isv_ = isv;
            dst = (GAS bf16*)(ws + OFF_KV8 + (size_t)tens * SZ_KV) + (size_t)hk * SEQ * 64; tokmajor = 0; pitch = 64; colofs = 0;
            if (isv || pn == 4) mode = 0; else { mode = 2; gain = (const GAS float*)((pn == 5) ? g.in[10] : (pn == 6) ? g.in[11] : g.in[19]); } }
        const GAS float* cosT = (const GAS float*)(ws + OFF_ROPE64C); const GAS float* sinT = (const GAS float*)(ws + OFF_ROPE64S);
#pragma unroll
        for (int ai = 0; ai < 2; ++ai)
#pragma unroll
            for (int m = 0; m < 4; ++m) {
                const int r = rbase + ai * 128 + m * 16; const float rs = row_rstd16((const GAS float*)(g.ws + OFF_SSQ), r, 1.0f / 1024.0f);
                const int t = r & (SEQ - 1), b = r >> 13;
                f32x4 v[2][2], w[2][2];
#pragma unroll
                for (int bj = 0; bj < 2; ++bj)
#pragma unroll
                    for (int n = 0; n < 2; ++n) v[bj][n] = acc[ai][bj][m][n] * rs;
                head_norm_rope(v, w, mode, gain, cosT, sinT, t, fq);
                GAS bf16 *plo, *phi;
                if (tokmajor) { plo = dst + (size_t)r * pitch + colofs + 8 * fq; phi = plo + 32; }
                else if (pn == 4) { plo = dst + ((size_t)b * 2 * SEQ + t) * 64 + 8 * fq; phi = plo + 32; }
                else if (isv_) { GAS bf16* sl = dst + (size_t)b * 2 * SEQ * 64; plo = sl + vtile_off(t, 8 * fq); phi = sl + vtile_off(t, 32 + 8 * fq); }
                else { GAS bf16* sl = dst + (size_t)b * 2 * SEQ * 64; plo = sl + ktile_off<64>(t, fq); phi = sl + ktile_off<64>(t, 4 + fq); }
                if (mode == 2) {
                    *(GAS v4u*)(plo) = pack8(w[0][0] * sc, w[0][1] * sc); *(GAS v4u*)(phi) = pack8(w[1][0] * sc, w[1][1] * sc);
                    if (dst2) { GAS bf16* rp2 = dst2 + (size_t)r * 512 + colofs; *(GAS v4u*)(rp2 + 8 * fq) = pack8(v[0][0] * sc, v[0][1] * sc); *(GAS v4u*)(rp2 + 32 + 8 * fq) = pack8(v[1][0] * sc, v[1][1] * sc); }
                } else {
                    *(GAS v4u*)(plo) = pack8(v[0][0], v[0][1]); *(GAS v4u*)(phi) = pack8(v[1][0], v[1][1]);
                }
            }
    } else if constexpr (EPI == EPI_L1IN) {
        const int pn = u.pn; GAS unsigned char* ws = (GAS unsigned char*)g.ws;
        if (pn < 6) {
            const int hh = wc, h = (pn & 1) * 4 + hh; const int which = pn >> 1;
            const GAS float* gain = (const GAS float*)(which == 0 ? g.in[33] : g.in[34]); const int mode = which == 2 ? 0 : 1; const float sc = which == 0 ? C2_64 : 1.f;
#pragma unroll
            for (int ai = 0; ai < 2; ++ai)
#pragma unroll
                for (int m = 0; m < 4; ++m) {
                    const int r = rbase + ai * 128 + m * 16; const float rs = row_rstd16((const GAS float*)(g.ws + OFF_SSQ), r, 1.0f / 1024.0f);
                    const int t = r & (SEQ - 1), b = r >> 13;
                    f32x4 v[2][2], w[2][2];
#pragma unroll
                    for (int bj = 0; bj < 2; ++bj)
#pragma unroll
                        for (int n = 0; n < 2; ++n) v[bj][n] = acc[ai][bj][m][n] * rs;
                    head_norm_rope(v, w, mode, gain, nullptr, nullptr, t, fq);
                    GAS bf16 *plo, *phi;
                    if (which == 0) { plo = (GAS bf16*)(ws + OFF_QF) + ((size_t)r * 8 + h) * 80 + 8 * fq; phi = plo + 32; }
                    else if (which == 1) { GAS bf16* sl = (GAS bf16*)(ws + OFF_KF) + ((size_t)b * 8 + h) * SEQ * 80; plo = sl + ktile_off<80>(t, fq); phi = sl + ktile_off<80>(t, 4 + fq); }
                    else { GAS bf16* sl = (GAS bf16*)(ws + OFF_VF) + ((size_t)b * 8 + h) * SEQ * 64; plo = sl + vtile_off(t, 8 * fq); phi = sl + vtile_off(t, 32 + 8 * fq); }
                    *(GAS v4u*)(plo) = pack8(v[0][0] * sc, v[0][1] * sc); *(GAS v4u*)(phi) = pack8(v[1][0] * sc, v[1][1] * sc);
                }
        } else {
#pragma unroll
            for (int ai = 0; ai < 2; ++ai)
#pragma unroll
                for (int m = 0; m < 4; ++m) {
                    const int r = rbase + ai * 128 + m * 16; const float rs = row_rstd16((const GAS float*)(g.ws + OFF_SSQ), r, 1.0f / 1024.0f);
                    f32x4 v[2][2];
#pragma unroll
                    for (int bj = 0; bj < 2; ++bj)
#pragma unroll
                        for (int n = 0; n < 2; ++n) v[bj][n] = acc[ai][bj][m][n] * rs;
                    float s0 = 0.f, s1 = 0.f;
#pragma unroll
                    for (int n = 0; n < 2; ++n) { s0 += (v[0][n][0] * v[0][n][0] + v[0][n][1] * v[0][n][1]) + (v[0][n][2] * v[0][n][2] + v[0][n][3] * v[0][n][3]);
                                                  s1 += (v[1][n][0] * v[1][n][0] + v[1][n][1] * v[1][n][1]) + (v[1][n][2] * v[1][n][2] + v[1][n][3] * v[1][n][3]); }
                    if (pn == 6) {
                        GAS bf16* rowp = (GAS bf16*)(ws + OFF_CQ) + (size_t)r * 256 + wc * 32 + 8 * fq;
                        *(GAS v4u*)(rowp) = pack8(v[0][0], v[0][1]); *(GAS v4u*)(rowp + 128) = pack8(v[1][0], v[1][1]);
                        float ss = s0 + s1; ss += __shfl_xor(ss, 16); ss += __shfl_xor(ss, 32);
                        if (fq == 0) ((GAS float*)(ws + OFF_SSQCQ))[(size_t)r * 4 + wc] = ss;
                    } else {
                        GAS bf16* rowp = (GAS bf16*)(ws + OFF_CKV) + (size_t)r * 128 + wc * 32 + 8 * fq;
                        *(GAS v4u*)(rowp) = pack8(v[0][0], v[0][1]);
                        float ss = s0; ss += __shfl_xor(ss, 16); ss += __shfl_xor(ss, 32);
                        if (fq == 0) ((GAS float*)(ws + OFF_SSQCKV))[(size_t)r * 4 + wc] = ss;
                        if (wc == 0) { *(GAS v4u*)((GAS bf16*)(ws + OFF_KR) + (size_t)r * 32 + 8 * fq) = pack8(v[1][0], v[1][1]);
                            float sr = s1; sr += __shfl_xor(sr, 16); sr += __shfl_xor(sr, 32); if (fq == 0) ((GAS float*)(ws + OFF_SSQKR))[r] = sr; }
                        if (wc == 1 && fq == 0) { GAS float* fp = (GAS float*)(ws + OFF_FRAW) + (size_t)(r >> 13) * 8 * SEQ + (r & (SEQ - 1));
#pragma unroll
                            for (int hh2 = 0; hh2 < 4; ++hh2) { fp[(size_t)hh2 * SEQ] = v[1][0][hh2]; fp[(size_t)(4 + hh2) * SEQ] = v[1][1][hh2]; } }
                    }
                }
        }
    } else if constexpr (EPI == EPI_QB) {
        GAS unsigned char* ws = (GAS unsigned char*)g.ws;
#pragma unroll
        for (int ai = 0; ai < 2; ++ai)
#pragma unroll
            for (int m = 0; m < 4; ++m) {
                const int r = rbase + ai * 128 + m * 16; const float rs = row_rstd4((const GAS float*)(ws + OFF_SSQCQ), r, 1.0f / 256.0f);
                GAS bf16* rowp = (GAS bf16*)(ws + OFF_QM) + (size_t)r * 768 + u.pn * 256 + wc * 32 + 8 * fq;
                *(GAS v4u*)(rowp) = pack8(acc[ai][0][m][0] * rs, acc[ai][0][m][1] * rs); *(GAS v4u*)(rowp + 128) = pack8(acc[ai][1][m][0] * rs, acc[ai][1][m][1] * rs);
            }
    } else if constexpr (EPI == EPI_KVB) {
        GAS unsigned char* ws = (GAS unsigned char*)g.ws; const int h = u.pn * 2 + (wc & 1); const bool isv = wc >= 2;
        const GAS float* gk = (const GAS float*)g.in[40]; const GAS float* c32 = (const GAS float*)(ws + OFF_ROPE32C); const GAS float* s32 = (const GAS float*)(ws + OFF_ROPE32S);
#pragma unroll
        for (int ai = 0; ai < 2; ++ai)
#pragma unroll
            for (int m = 0; m < 4; ++m) {
                const int r = rbase + ai * 128 + m * 16; const float rs = row_rstd4((const GAS float*)(ws + OFF_SSQCKV), r, 1.0f / 128.0f);
                const int t = r & (SEQ - 1), b = r >> 13;
                f32x4 v[2][2];
#pragma unroll
                for (int bj = 0; bj < 2; ++bj)
#pragma unroll
                    for (int n = 0; n < 2; ++n) v[bj][n] = acc[ai][bj][m][n] * rs;
                if (isv) {
                    GAS bf16* sl = (GAS bf16*)(ws + OFF_VM) + ((size_t)b * 8 + h) * SEQ * 64;
                    *(GAS v4u*)(sl + vtile_off(t, 8 * fq)) = pack8(v[0][0], v[0][1]); *(GAS v4u*)(sl + vtile_off(t, 32 + 8 * fq)) = pack8(v[1][0], v[1][1]);
                } else {
                    float ss = 0.f;
#pragma unroll
                    for (int bj = 0; bj < 2; ++bj)
#pragma unroll
                        for (int n = 0; n < 2; ++n) ss += (v[bj][n][0] * v[bj][n][0] + v[bj][n][1] * v[bj][n][1]) + (v[bj][n][2] * v[bj][n][2] + v[bj][n][3] * v[bj][n][3]);
                    ss += __shfl_xor(ss, 16); ss += __shfl_xor(ss, 32);
                    const float rn = rsq((ss + ((const GAS float*)(ws + OFF_SSQKR))[r]) * (1.0f / 96.0f) + EPS);
                    GAS bf16* sl = (GAS bf16*)(ws + OFF_KM) + ((size_t)b * 8 + h) * SEQ * 96;
#pragma unroll
                    for (int bj = 0; bj < 2; ++bj) { const f32x4 g0 = *(const GAS f32x4*)(gk + 32 * bj + 8 * fq), g1 = *(const GAS f32x4*)(gk + 32 * bj + 8 * fq + 4);
                        *(GAS v4u*)(sl + ktile_off<96>(t, 4 * bj + fq)) = pack8(v[bj][0] * rn * g0, v[bj][1] * rn * g1); }
                    if (fq < 2) {
                        const GAS bf16* kr = (const GAS bf16*)(ws + OFF_KR) + (size_t)r * 32; const v4u wa = *(const GAS v4u*)(kr + 8 * fq), wb = *(const GAS v4u*)(kr + 16 + 8 * fq);
                        const f32x4 a0 = {bflo(wa.x), bfhi(wa.x), bflo(wa.y), bfhi(wa.y)}, a1 = {bflo(wa.z), bfhi(wa.z), bflo(wa.w), bfhi(wa.w)};
                        const f32x4 b0 = {bflo(wb.x), bfhi(wb.x), bflo(wb.y), bfhi(wb.y)}, b1 = {bflo(wb.z), bfhi(wb.z), bflo(wb.w), bfhi(wb.w)};
                        const f32x4 ga0 = *(const GAS f32x4*)(gk + 64 + 8 * fq), ga1 = *(const GAS f32x4*)(gk + 68 + 8 * fq), gb0 = *(const GAS f32x4*)(gk + 80 + 8 * fq), gb1 = *(const GAS f32x4*)(gk + 84 + 8 * fq);
                        const f32x4 c0 = *(const GAS f32x4*)(c32 + (size_t)t * 16 + 8 * fq), c1 = *(const GAS f32x4*)(c32 + (size_t)t * 16 + 8 * fq + 4), s0 = *(const GAS f32x4*)(s32 + (size_t)t * 16 + 8 * fq), s1 = *(const GAS f32x4*)(s32 + (size_t)t * 16 + 8 * fq + 4);
                        const f32x4 xa0 = a0 * rn * ga0, xa1 = a1 * rn * ga1, xb0 = b0 * rn * gb0, xb1 = b1 * rn * gb1;
                        *(GAS v4u*)(sl + ktile_off<96>(t, 8 + fq)) = pack8(xa0 * c0 - xb0 * s0, xa1 * c1 - xb1 * s1);
                        *(GAS v4u*)(sl + ktile_off<96>(t, 10 + fq)) = pack8(xb0 * c0 + xa0 * s0, xb1 * c1 + xa1 * s1);
                    }
                }
            }
    } else {
        const GAS float* bias = (const GAS float*)(g.ws + OFF_CBIAS) + g.ep * 256; GAS bf16* o0 = (GAS bf16*)(g.ws + OFF_HID) + (size_t)g.ep * 2048 * 256;
#pragma unroll
        for (int bj = 0; bj < 2; ++bj) {
            const int col0 = bj * 128 + wc * 32 + 8 * fq; const f32x4 b0 = *(const GAS f32x4*)(bias + col0), b1 = *(const GAS f32x4*)(bias + col0 + 4);
#pragma unroll
            for (int ai = 0; ai < 2; ++ai)
#pragma unroll
                for (int m = 0; m < 4; ++m) {
                    const int r = rbase + ai * 128 + m * 16; const f32x4 x0 = acc[ai][bj][m][0] + b0, x1 = acc[ai][bj][m][1] + b1;
                    const f32x4 y0 = {silu_f(x0[0]), silu_f(x0[1]), silu_f(x0[2]), silu_f(x0[3])}, y1 = {silu_f(x1[0]), silu_f(x1[1]), silu_f(x1[2]), silu_f(x1[3])};
                    *(GAS v4u*)(o0 + (size_t)r * 256 + col0) = pack8(y0, y1);
                }
        }
    }
}

template <int EPI> __device__ __forceinline__ void gemm_phase(LAS unsigned char* lds, const GemmDesc& g, int G, int cblk) {
    constexpr bool PERM = (EPI != EPI_RESID);
    using namespace pg8;
    int tid = threadIdx.x; asm volatile("" : "+v"(tid));
    const int wid = __builtin_amdgcn_readfirstlane(tid >> 6), lane = tid & 63, wr = wid >> 2, wc = wid & 3, fr = lane & 15, fq = lane >> 4;
    const int K = g.K, nt = K / BK, lda = g.lda;
    StaticOrder S; S.init(g.M, g.N, G, cblk);
    unsigned voffA[2], voffB[2];
#pragma unroll
    for (int i = 0; i < 2; ++i) { int R, C; stage_rc(tid * 16 + i * 8192, R, C); const int Rb = PERM ? ((R & ~31) + perm32(R & 31)) : R;
        voffA[i] = (unsigned)(R * lda + C) * 2u; voffB[i] = (unsigned)(Rb * K + C) * 2u; }
    const size_t kstep = (size_t)(BK * 2);
    const size_t hstepA = (size_t)HALF * lda * 2, hstepB = (size_t)HALF * K * 2;
    const size_t tstepA = 2 * hstepA, tstepB = 2 * hstepB;
    const unsigned ldsw = (unsigned)wid * 1024u;
    const int aoff = lds_byte(wr * 64 + fr, fq * 8), boff = lds_byte(wc * 32 + fr, fq * 8);
#define PG8_SA(b, h) (((b) * 2 + (h)) * HTB)
#define PG8_SB(b, h) ((4 + (b) * 2 + (h)) * HTB)
#define PG8_STAGE(bufoff, gbase, voff) do { _Pragma("unroll") for (int _i = 0; _i < 2; ++_i) \
        __builtin_amdgcn_global_load_lds((const unsigned*)((const char*)(gbase) + (voff)[_i]), (LAS unsigned*)(lds + (bufoff) + ldsw + _i * 8192), 16, 0, 0); } while (0)
#define PG8_LDA(dst, b, h) do { _Pragma("unroll") for (int m = 0; m < 4; ++m) _Pragma("unroll") for (int k = 0; k < 2; ++k) dst[m][k] = *(const LAS bf16x8*)(lds + PG8_SA(b, h) + aoff + m * 2048 + k * 1024); } while (0)
#define PG8_LDB(dst, b, h) do { _Pragma("unroll") for (int n = 0; n < 2; ++n) _Pragma("unroll") for (int k = 0; k < 2; ++k) dst[n][k] = *(const LAS bf16x8*)(lds + PG8_SB(b, h) + boff + n * 2048 + k * 1024); } while (0)
#define PG8_MMA(ai, bj, At, Bt) do { __builtin_amdgcn_s_setprio(1); _Pragma("unroll") for (int m = 0; m < 4; ++m) _Pragma("unroll") for (int n = 0; n < 2; ++n) _Pragma("unroll") for (int k = 0; k < 2; ++k) \
        acc[ai][bj][m][n] = __builtin_amdgcn_mfma_f32_16x16x32_bf16(Bt[n][k], At[m][k], acc[ai][bj][m][n], 0, 0, 0); __builtin_amdgcn_s_setprio(0); } while (0)
#define PG8_WAIT_V(n) asm volatile("s_waitcnt vmcnt(" #n ")" ::: "memory")
#define PG8_WAIT_L(n) asm volatile("s_waitcnt lgkmcnt(" #n ")" ::: "memory")
#define PG8_BAR __builtin_amdgcn_s_barrier()
#define PG8_SCHED __builtin_amdgcn_sched_barrier(0)
    Unit cur, nxt; int ui = 0;
    if (!S.next(0, cur)) return;
    f32x4 acc[2][2][4][2];
#pragma unroll
    for (int a = 0; a < 2; ++a)
#pragma unroll
        for (int b = 0; b < 2; ++b)
#pragma unroll
            for (int m = 0; m < 4; ++m)
#pragma unroll
                for (int n = 0; n < 2; ++n) acc[a][b][m][n] = (f32x4){0.f, 0.f, 0.f, 0.f};
    bf16x8 At[4][2], B0[2][2], B1[2][2];
    const char* cA = (const char*)g.A + (size_t)cur.pm * tstepA; const char* cB = (const char*)g.Bt + (size_t)cur.pn * tstepB;
    PG8_STAGE(PG8_SB(0, 0), cB, voffB); PG8_STAGE(PG8_SB(0, 1), cB + hstepB, voffB); PG8_STAGE(PG8_SA(0, 0), cA, voffA); PG8_STAGE(PG8_SA(0, 1), cA + hstepA, voffA);
    if (wr == 1) PG8_BAR;
    PG8_WAIT_V(2); PG8_BAR;
    PG8_STAGE(PG8_SB(1, 0), cB + kstep, voffB); PG8_STAGE(PG8_SA(1, 0), cA + kstep, voffA); PG8_STAGE(PG8_SB(1, 1), cB + hstepB + kstep, voffB);
    PG8_WAIT_V(6); PG8_BAR;
    for (;;) {
        const bool has_next = S.next(ui + 1, nxt);
        const char* nA = has_next ? (const char*)g.A + (size_t)nxt.pm * tstepA : cA; const char* nB = has_next ? (const char*)g.Bt + (size_t)nxt.pn * tstepB : cB;
        for (int t = 0; t < nt; t += 2) {
            const bool last = (t == nt - 2);
            const char* a1 = cA + (size_t)(t + 1) * kstep;
            const char* a2 = last ? nA : cA + (size_t)(t + 2) * kstep; const char* b2 = last ? nB : cB + (size_t)(t + 2) * kstep;
            const char* a3 = a2 + kstep; const char* b3 = b2 + kstep;
            PG8_LDB(B0, 0, 0); PG8_LDB(B1, 0, 1); PG8_SCHED; PG8_LDA(At, 0, 0); PG8_STAGE(PG8_SA(1, 1), a1 + hstepA, voffA);
            PG8_WAIT_V(8); PG8_WAIT_L(0); PG8_BAR; PG8_MMA(0, 0, At, B0); PG8_MMA(0, 1, At, B1); PG8_BAR; PG8_SCHED;
            PG8_LDA(At, 0, 1); PG8_STAGE(PG8_SB(0, 0), b2, voffB); PG8_STAGE(PG8_SB(0, 1), b2 + hstepB, voffB); PG8_STAGE(PG8_SA(0, 0), a2, voffA);
            PG8_WAIT_V(8); PG8_WAIT_L(0); PG8_BAR; PG8_MMA(1, 0, At, B0); PG8_MMA(1, 1, At, B1); PG8_BAR; PG8_SCHED;
            PG8_LDB(B0, 1, 0); PG8_LDB(B1, 1, 1); PG8_SCHED; PG8_LDA(At, 1, 0); PG8_STAGE(PG8_SA(0, 1), a2 + hstepA, voffA);
            PG8_WAIT_V(8); PG8_WAIT_L(0); PG8_BAR; PG8_MMA(0, 0, At, B0); PG8_MMA(0, 1, At, B1); PG8_BAR; PG8_SCHED;
            PG8_LDA(At, 1, 1); PG8_STAGE(PG8_SB(1, 0), b3, voffB); PG8_STAGE(PG8_SB(1, 1), b3 + hstepB, voffB); PG8_STAGE(PG8_SA(1, 0), a3, voffA);
            PG8_WAIT_V(8); PG8_WAIT_L(0); PG8_BAR; PG8_MMA(1, 0, At, B0); PG8_MMA(1, 1, At, B1); PG8_BAR; PG8_SCHED;
        }
        if (wr == 0) PG8_BAR;
        gemm_epilogue<EPI>(g, acc, cur, wr, wc, fr, fq);
        if (!has_next) break;
#pragma unroll
        for (int a = 0; a < 2; ++a)
#pragma unroll
            for (int b = 0; b < 2; ++b)
#pragma unroll
                for (int m = 0; m < 4; ++m)
#pragma unroll
                    for (int n = 0; n < 2; ++n) acc[a][b][m][n] = (f32x4){0.f, 0.f, 0.f, 0.f};
        cur = nxt; cA = nA; cB = nB; ++ui;
        if (wr == 1) PG8_BAR;
    }
    PG8_WAIT_V(0);
    PG8_BAR;
#undef PG8_SA
#undef PG8_SB
#undef PG8_STAGE
#undef PG8_LDA
#undef PG8_LDB
#undef PG8_MMA
#undef PG8_WAIT_V
#undef PG8_WAIT_L
#undef PG8_BAR
#undef PG8_SCHED
}

#define XB_TMO      128
#define XB_XCNT(j)  (256  + 64 * (j))
#define XB_XSUB(j)  (1280 + 64 * (j))
#define XB_XGEN(j)  (2304 + 64 * (j))
#define XB_TOP      3328
#define XB_TOPGEN   3392
#define XCD_BAR_WORDS 3456
#define XB_SPIN_CAP (1u << 23)
__device__ __forceinline__ unsigned xb_ld(unsigned* p)              { return __hip_atomic_load(p, __ATOMIC_RELAXED, __HIP_MEMORY_SCOPE_AGENT); }
__device__ __forceinline__ unsigned xb_add(unsigned* p, unsigned v) { return __hip_atomic_fetch_add(p, v, __ATOMIC_RELAXED, __HIP_MEMORY_SCOPE_AGENT); }
__device__ __forceinline__ unsigned xb_xcc_id() { return (unsigned)__builtin_amdgcn_s_getreg((3 << 11) | 20) & 0xFu; }
#define XB_SPIN(cond, bar) do { unsigned _sp = 0; while (cond) { __builtin_amdgcn_s_sleep(1); \
    if ((++_sp & 255u) == 0u) { if (xb_ld(&(bar)[XB_TMO])) break; if (_sp > XB_SPIN_CAP) { atomicAdd(&(bar)[XB_TMO], 1u); break; } } } } while (0)
struct XcdBarrier { unsigned* bar; unsigned x; volatile LAS unsigned* st; };
__device__ __forceinline__ XcdBarrier xcd_barrier_post(unsigned* bar, volatile LAS unsigned* st) {
    XcdBarrier b; b.bar = bar; b.x = xb_xcc_id(); b.st = st;
    if (threadIdx.x == 0) st[2] = xb_add(&bar[XB_XCNT(b.x)], 1u);
    return b;
}
__device__ __forceinline__ void xcd_barrier_complete(unsigned* bar, unsigned x, unsigned& nloc, unsigned& nx) {
    const unsigned G = gridDim.x * gridDim.y * gridDim.z;
    unsigned sum, cnt, mine, sp = 0u;
    for (;;) {
        sum = 0u; cnt = 0u; mine = 0u;
#pragma unroll
        for (unsigned j = 0; j < 16; ++j) { const unsigned c = xb_ld(&bar[XB_XCNT(j)]); sum += c; cnt += (c > 0u) ? 1u : 0u; mine = (j == x) ? c : mine; }
        if (sum == G) break;
        __builtin_amdgcn_s_sleep(1);
        if ((++sp & 255u) == 0u) { if (xb_ld(&bar[XB_TMO])) break; if (sp > XB_SPIN_CAP) { atomicAdd(&bar[XB_TMO], 1u); break; } }
    }
    nloc = mine > 0u ? mine : 1u; nx = cnt > 0u ? cnt : 1u;
}
__device__ __forceinline__ void xcd_barrier(const XcdBarrier& b, bool global = true) {
    asm volatile("s_waitcnt vmcnt(0)" ::: "memory");
    __syncthreads();
    if (threadIdx.x == 0) {
        unsigned* bar = b.bar;
        __builtin_amdgcn_s_waitcnt(0);
        unsigned nloc = b.st[0], nx = b.st[1];
        if (nloc == 0u) { xcd_barrier_complete(bar, b.x, nloc, nx); b.st[0] = nloc; b.st[1] = nx; }
        const unsigned old = xb_add(&bar[XB_XSUB(b.x)], 1u);
        const unsigned gen = old / nloc;
        if (!global) {
            if (old + 1u == (gen + 1u) * nloc) xb_add(&bar[XB_XGEN(b.x)], 1u);
            else XB_SPIN(xb_ld(&bar[XB_XGEN(b.x)]) == gen, bar);
            __builtin_amdgcn_fence(__ATOMIC_ACQUIRE, "agent");
            asm volatile("s_waitcnt vmcnt(0)" ::: "memory");
        } else if (old + 1u == (gen + 1u) * nloc) {
            __builtin_amdgcn_fence(__ATOMIC_RELEASE, "agent");
            asm volatile("s_waitcnt vmcnt(0)" ::: "memory");
            const unsigned og = xb_add(&bar[XB_TOP], 1u);
            const unsigned tg = og / nx;
            if (og + 1u == (tg + 1u) * nx) xb_add(&bar[XB_TOPGEN], 1u);
            else XB_SPIN(xb_ld(&bar[XB_TOPGEN]) == tg, bar);
            __builtin_amdgcn_fence(__ATOMIC_ACQUIRE, "agent");
            xb_add(&bar[XB_XGEN(b.x)], 1u);
            asm volatile("s_waitcnt vmcnt(0)" ::: "memory");
        } else {
            XB_SPIN(xb_ld(&bar[XB_XGEN(b.x)]) == gen, bar);
            __builtin_amdgcn_fence(__ATOMIC_ACQUIRE, "agent");
            asm volatile("s_waitcnt vmcnt(0)" ::: "memory");
        }
    }
    __syncthreads();
}

struct Frame {
    LAS unsigned char* lds; int tid, lane, wave, vcu, G;
    InTab in; float* out; unsigned char* ws;
};

__device__ __forceinline__ float wave_sum(float v) {
#pragma unroll
    for (int o = 1; o < 64; o <<= 1) v += __shfl_xor(v, o);
    return v;
}

enum { MAP_IDENT = 0, MAP_L0IN = 1, MAP_L1IN = 2, MAP_GATE0 = 3, MAP_GU = 4, MAP_KVB = 5 };
__device__ __forceinline__ int map_src(int kind, int n, int nsrc) {
    if (kind == MAP_IDENT) return n < nsrc ? n : -1;
    if (kind == MAP_GATE0) return n < 24 ? 1280 + n : -1;
    if (kind == MAP_GU) { const int tile = n >> 8, w = n & 127; return tile * 128 + w; }
    const int pn = n >> 8, slot = n & 255;
    const int hh = (slot >> 5) & 3, d = 32 * (slot >> 7) + (slot & 31), L = pn * 256 + hh * 64 + d;
    if (kind == MAP_KVB) return (2 * pn + (hh & 1)) * 128 + (hh >> 1) * 64 + d;
    if (kind == MAP_L0IN) {
        if (L < 512) return L;
        if (L < 1024) return 1304 + (L - 512);
        if (L < 1792) return 512 + (L - 1024);
        return 1816 + (L - 1792);
    }
    if (pn < 6) return L;
    if (pn == 6) return 1544 + slot;
    if (slot < 128) return 1800 + slot;
    if (slot < 160) return 1928 + (slot - 128);
    if (slot < 168) return 1536 + (slot - 160);
    return -1;
}
struct WDesc { const float* src; const float* src2; int K, nsrc, ndst; bf16* dst; const float* gain; int kind; };
__device__ __forceinline__ void conv_load(const WDesc& w, int item, int lane, f32x4 (&v)[8], float (&g)[8]) {
    const int nblk = w.ndst / 32, kb = item / nblk, nb = item % nblk, k0 = 64 * kb, n0 = 32 * nb;
    const int nq = 4 * (lane & 7), kr = lane >> 3; const int sc = map_src(w.kind, n0 + nq, w.nsrc);
    const float* src = (w.kind == MAP_GU && (n0 & 128)) ? w.src2 : w.src;
#pragma unroll
    for (int i = 0; i < 8; ++i) { const int kk = 8 * i + kr; v[i] = (f32x4){0.f, 0.f, 0.f, 0.f}; if (sc >= 0) v[i] = *(const f32x4*)(src + (size_t)(k0 + kk) * w.nsrc + sc); }
#pragma unroll
    for (int i = 0; i < 8; ++i) { g[i] = 1.f; if (w.gain) g[i] = w.gain[k0 + 8 * i + kr]; }
}
__device__ __forceinline__ void conv_finish(const WDesc& w, LAS float* scr, int item, int lane, const f32x4 (&v)[8], const float (&g)[8]) {
    const int nblk = w.ndst / 32, kb = item / nblk, nb = item % nblk, k0 = 64 * kb, n0 = 32 * nb;
    const int nq = 4 * (lane & 7), kr = lane >> 3;
#pragma unroll
    for (int i = 0; i < 8; ++i) { const int kk = 8 * i + kr; const float gsc = g[i];
        LAS float* d = scr + kk * 33 + nq; d[0] = v[i][0] * gsc; d[1] = v[i][1] * gsc; d[2] = v[i][2] * gsc; d[3] = v[i][3] * gsc; }
    LDS_WAIT(); asm volatile("" ::: "memory");
    const int c = lane & 7;
#pragma unroll
    for (int j = 0; j < 4; ++j) { const int nn = (lane >> 3) + 8 * j; const LAS float* s = scr + (8 * c) * 33 + nn;
        v4u o; o.x = pk2(s[0 * 33], s[1 * 33]); o.y = pk2(s[2 * 33], s[3 * 33]); o.z = pk2(s[4 * 33], s[5 * 33]); o.w = pk2(s[6 * 33], s[7 * 33]);
        *(v4u*)(w.dst + (size_t)(n0 + nn) * w.K + k0 + 8 * c) = o; }
    LDS_WAIT(); asm volatile("" ::: "memory");
}
constexpr int NMAT = 19;
__device__ __forceinline__ WDesc get_wdesc(const Frame& F, int id) {
    WDesc w; w.src2 = nullptr; w.gain = nullptr; w.kind = MAP_IDENT;
    InTab in = F.in; unsigned char* ws = F.ws;
    if (id < 4) { const int nb = id == 0 ? 1 : id == 1 ? 22 : id == 2 ? 26 : 42;
        w.src = in[nb + 1]; w.src2 = in[nb + 2]; w.gain = in[nb]; w.K = 1024; w.nsrc = FF; w.ndst = 2 * FF; w.dst = (bf16*)(ws + OFF_WGU + id * SZ_WGU); w.kind = MAP_GU; }
    else if (id < 8) { const int f = id - 4; const int nb = f == 0 ? 1 : f == 1 ? 22 : f == 2 ? 26 : 42;
        w.src = in[nb + 3]; w.K = FF; w.nsrc = 1024; w.ndst = 1024; w.dst = (bf16*)(ws + OFF_WD + f * SZ_WD); }
    else if (id == 8) { w.src = in[6]; w.gain = in[5]; w.K = 1024; w.nsrc = 2072; w.ndst = 2048; w.dst = (bf16*)(ws + OFF_WIN0); w.kind = MAP_L0IN; }
    else if (id == 9) { w.src = in[6]; w.gain = in[5]; w.K = 1024; w.nsrc = 2072; w.ndst = 32; w.dst = (bf16*)(ws + OFF_WG); w.kind = MAP_GATE0; }
    else if (id == 10) { w.src = in[21]; w.K = 1024; w.nsrc = 1024; w.ndst = 1024; w.dst = (bf16*)(ws + OFF_WOUT0); }
    else if (id == 11) { w.src = in[31]; w.gain = in[30]; w.K = 1024; w.nsrc = 1960; w.ndst = 2048; w.dst = (bf16*)(ws + OFF_WIN1); w.kind = MAP_L1IN; }
    else if (id == 12) { w.src = in[41]; w.K = 1024; w.nsrc = 1024; w.ndst = 1024; w.dst = (bf16*)(ws + OFF_WOUT1); }
    else if (id == 13) { w.src = in[36]; w.gain = in[35]; w.K = 256; w.nsrc = 768; w.ndst = 768; w.dst = (bf16*)(ws + OFF_WQB); }
    else if (id == 14) { w.src = in[38]; w.gain = in[37]; w.K = 128; w.nsrc = 1024; w.ndst = 1024; w.dst = (bf16*)(ws + OFF_WKVB); w.kind = MAP_KVB; }
    else if (id == 15) { w.src = in[14]; w.K = 2048; w.nsrc = 256; w.ndst = 256; w.dst = (bf16*)(ws + OFF_W1K); }
    else if (id == 16) { w.src = in[16]; w.K = 2048; w.nsrc = 256; w.ndst = 256; w.dst = (bf16*)(ws + OFF_W1V); }
    else if (id == 17) { w.src = in[15]; w.K = 256; w.nsrc = 64; w.ndst = 64; w.dst = (bf16*)(ws + OFF_W2K); }
    else { w.src = in[17]; w.K = 256; w.nsrc = 64; w.ndst = 64; w.dst = (bf16*)(ws + OFF_W2V); }
    return w;
}
__device__ __forceinline__ void convert_mats(Frame& F, unsigned mask, int gw, int NGW) {
    LAS float* scr = (LAS float*)(F.lds + F.wave * 16384);
    int base = 0;
    for (int id = 0; id < NMAT; ++id) {
        if (!((mask >> id) & 1u)) continue;
        const WDesc w = get_wdesc(F, id); const int nit = (w.K / 64) * (w.ndst / 32);
        int first = (gw - base) % NGW; if (first < 0) first += NGW;
        if (first < nit) { f32x4 va[8], vb[8]; float ga[8], gb[8]; conv_load(w, first, F.lane, va, ga);
            for (int it = first; it < nit; it += 2 * NGW) {
                if (it + NGW < nit) conv_load(w, it + NGW, F.lane, vb, gb);
                conv_finish(w, scr, it, F.lane, va, ga);
                if (it + NGW < nit) { if (it + 2 * NGW < nit) conv_load(w, it + 2 * NGW, F.lane, va, ga); conv_finish(w, scr, it + NGW, F.lane, vb, gb); }
            } }
        base = (base + nit) % NGW;
    }
}
constexpr unsigned MATS_P0 = (1u << 0) | (1u << 4) | (1u << 8);
constexpr unsigned MATS_P1 = (1u << 9) | (1u << 10) | (1u << 15) | (1u << 16) | (1u << 17) | (1u << 18);
constexpr unsigned MATS_P4 = (1u << 1) | (1u << 5) | (1u << 2) | (1u << 3) | (1u << 6) | (1u << 7) | (1u << 11) | (1u << 12) | (1u << 13) | (1u << 14);
constexpr unsigned MATS_P7 = 0u;
static_assert((MATS_P0 | MATS_P1 | MATS_P4 | MATS_P7) == (1u << NMAT) - 1u && (MATS_P0 & MATS_P1) == 0 && ((MATS_P0 | MATS_P1) & MATS_P4) == 0 && ((MATS_P0 | MATS_P1 | MATS_P4) & MATS_P7) == 0, "every matrix converted exactly once");
__device__ __forceinline__ void p0_prologue(Frame& F) {
    const int gw = F.vcu * NWAVES + F.wave, NGW = F.G * NWAVES;
    convert_mats(F, MATS_P0, gw, NGW);
    { const float* x = F.in[0]; bf16* xb = (bf16*)(F.ws + OFF_XBA); float* ssq = (float*)(F.ws + OFF_SSQ);
      for (int m0 = gw; m0 < NTOK; m0 += 8 * NGW) {
        f32x4 v[8][4];
#pragma unroll
        for (int q = 0; q < 8; ++q) { const int m = m0 + q * NGW; if (m < NTOK) { const f32x4* xr = (const f32x4*)(x + (size_t)m * DM) + F.lane;
#pragma unroll
            for (int j = 0; j < 4; ++j) v[q][j] = xr[64 * j]; } }
#pragma unroll
        for (int q = 0; q < 8; ++q) { const int m = m0 + q * NGW; if (m < NTOK) { float s = 0.f; v2u* o8 = (v2u*)(xb + (size_t)m * DM) + F.lane;
#pragma unroll
            for (int j = 0; j < 4; ++j) { const f32x4 t = v[q][j]; s += (t[0] * t[0] + t[1] * t[1]) + (t[2] * t[2] + t[3] * t[3]); v2u w; w.x = pk2(t[0], t[1]); w.y = pk2(t[2], t[3]); o8[64 * j] = w; }
            s = wave_sum(s);
            if (F.lane < 4) ssq[(size_t)m * 4 + F.lane] = F.lane == 0 ? s : 0.f; } }
      } }
    { float* c64 = (float*)(F.ws + OFF_ROPE64C); float* s64 = (float*)(F.ws + OFF_ROPE64S); float* c32 = (float*)(F.ws + OFF_ROPE32C); float* s32 = (float*)(F.ws + OFF_ROPE32S);
      const int gt = F.vcu * 512 + F.tid, NT = F.G * 512;
      for (int e = gt; e < SEQ * 32; e += NT) { const int t = e >> 5, i = e & 31; const float inv = 1.0f / powf(10000.0f, (float)(2 * i) / 64.0f); const float ang = (float)t * inv; c64[e] = cosf(ang); s64[e] = sinf(ang); }
      for (int e = gt; e < SEQ * 16; e += NT) { const int t = e >> 4, i = e & 15; const float inv = 1.0f / powf(10000.0f, (float)(2 * i) / 32.0f); const float ang = (float)t * inv; c32[e] = cosf(ang); s32[e] = sinf(ang); } }
    if (F.vcu < 256) {
        __syncthreads();
        const int oi = 2 * F.vcu + (F.tid >> 8), kv = oi >> 8, n = oi & 255, kc = F.tid & 255; const float* pos = F.in[kv ? 13 : 12]; const float* w1 = F.in[kv ? 16 : 14];
        float s = 0.f;
#pragma unroll
        for (int k = 0; k < 8; ++k) s += pos[kc * 8 + k] * w1[(size_t)(kc * 8 + k) * 256 + n];
        s = wave_sum(s);
        LAS float* red = (LAS float*)(F.lds);
        if (F.lane == 0) red[F.wave] = s;
        __syncthreads();
        if (F.tid < 2) ((float*)(F.ws + OFF_CBIAS))[2 * F.vcu + F.tid] = (red[4 * F.tid] + red[4 * F.tid + 1]) + (red[4 * F.tid + 2] + red[4 * F.tid + 3]);
        __syncthreads();
    }
}

__device__ __forceinline__ void gates_phase(Frame& F, int gw, int NGW) {
    const int lane = F.lane, fr = lane & 15, fq = lane >> 4;
    const bf16* xb = (const bf16*)(F.ws + OFF_XBA); const bf16* wg = (const bf16*)(F.ws + OFF_WG); const GAS float* ssq = (const GAS float*)(F.ws + OFF_SSQ);
    float* gates = (float*)(F.ws + OFF_GATES); const float* gb = F.in[7];
    for (int task = gw; task < NTOK / 16; task += NGW) {
        const int r0 = task * 16; f32x4 acc0 = {0.f, 0.f, 0.f, 0.f}, acc1 = {0.f, 0.f, 0.f, 0.f};
        const bf16* ap = xb + (size_t)(r0 + fr) * DM + 8 * fq; const bf16* bp0 = wg + (size_t)fr * DM + 8 * fq; const bf16* bp1 = wg + (size_t)(16 + fr) * DM + 8 * fq;
#pragma unroll 8
        for (int k = 0; k < DM; k += 32) {
            const bf16x8 a = *(const bf16x8*)(ap + k), b0 = *(const bf16x8*)(bp0 + k), b1 = *(const bf16x8*)(bp1 + k);
            acc0 = __builtin_amdgcn_mfma_f32_16x16x32_bf16(a, b0, acc0, 0, 0, 0); acc1 = __builtin_amdgcn_mfma_f32_16x16x32_bf16(a, b1, acc1, 0, 0, 0);
        }
#pragma unroll
        for (int j = 0; j < 4; ++j) { const int r = r0 + 4 * fq + j; const float rs = row_rstd16(ssq, r, 1.0f / 1024.0f);
            { const float z = acc0[j] * rs + gb[fr]; gates[(size_t)r * 24 + fr] = __builtin_amdgcn_rcpf(1.0f + ex2(-z * LOG2E)); }
            if (fr < 8) { const float z = acc1[j] * rs + gb[16 + fr]; gates[(size_t)r * 24 + 16 + fr] = __builtin_amdgcn_rcpf(1.0f + ex2(-z * LOG2E)); } }
    }
}
__device__ __forceinline__ void cmp2_tile(Frame& F, int kv, int pm) {
    const int lane = F.lane, fr = lane & 15, fq = lane >> 4;
    const bf16* hid = (const bf16*)(F.ws + OFF_HID) + (size_t)kv * 2048 * 256; const bf16* w2 = (const bf16*)(F.ws + (kv ? OFF_W2V : OFF_W2K));
    bf16* out = (bf16*)(F.ws + (kv ? OFF_VCMP : OFF_KCMP)); const float* gain = F.in[9];
    for (int rt = F.wave; rt < 16; rt += NWAVES) {
        const int r0 = pm * 256 + rt * 16; f32x4 acc[4];
#pragma unroll
        for (int c = 0; c < 4; ++c) acc[c] = (f32x4){0.f, 0.f, 0.f, 0.f};
        const bf16* ap = hid + (size_t)(r0 + fr) * 256 + 8 * fq;
#pragma unroll
        for (int k = 0; k < 256; k += 32) { const bf16x8 a = *(const bf16x8*)(ap + k);
#pragma unroll
            for (int c = 0; c < 4; ++c) { const bf16x8 b = *(const bf16x8*)(w2 + (size_t)(c * 16 + fr) * 256 + 8 * fq + k); acc[c] = __builtin_amdgcn_mfma_f32_16x16x32_bf16(a, b, acc[c], 0, 0, 0); } }
#pragma unroll
        for (int j = 0; j < 4; ++j) {
            float v[4];
#pragma unroll
            for (int c = 0; c < 4; ++c) v[c] = acc[c][j];
            if (kv == 0) { float ss = (v[0] * v[0] + v[1] * v[1]) + (v[2] * v[2] + v[3] * v[3]);
                ss += __shfl_xor(ss, 1); ss += __shfl_xor(ss, 2); ss += __shfl_xor(ss, 4); ss += __shfl_xor(ss, 8);
                const float r = rsq(ss * (1.0f / 64.0f) + EPS);
#pragma unroll
                for (int c = 0; c < 4; ++c) v[c] = v[c] * r * gain[c * 16 + fr]; }
#pragma unroll
            for (int c = 0; c < 4; ++c) { const int rr = r0 + 4 * fq + j, slab = rr >> 9, i = rr & 511, d = c * 16 + fr;
                out[(size_t)slab * 512 * 64 + (kv ? vtile_off(i, d) : ktile_off<64>(i, d >> 3) + (d & 7))] = (bf16)f2bf(v[c]); }
        }
    }
}

__device__ __forceinline__ void fox_scan(Frame& F, int bh) {
    const int b = bh >> 3, h = bh & 7; const float* fraw = (const float*)(F.ws + OFF_FRAW); const float fb = F.in[32][h];
    LAS float* red = (LAS float*)(F.lds);
    float v[16]; float run = 0.f; const int t0 = F.tid * 16;
#pragma unroll
    for (int i = 0; i < 16; ++i) { const float x = fraw[(size_t)bh * SEQ + t0 + i] + fb; const float ls2 = fminf(x, 0.f) * LOG2E - __builtin_amdgcn_logf(1.0f + ex2(-fabsf(x) * LOG2E)); run += ls2; v[i] = run; }
    float inc = run;
#pragma unroll
    for (int off = 1; off < 64; off <<= 1) { const float y = __shfl_up(inc, off); if (F.lane >= off) inc += y; }
    __syncthreads();
    if (F.lane == 63) red[F.wave] = inc;
    __syncthreads();
    float wbase = 0.f;
    for (int w = 0; w < F.wave; ++w) wbase += red[w];
    const float excl = wbase + inc - run;
    float* dc = (float*)(F.ws + OFF_DC2) + (size_t)bh * SEQ;
    bf16* QF = (bf16*)(F.ws + OFF_QF); bf16* KF = (bf16*)(F.ws + OFF_KF);
#pragma unroll
    for (int i = 0; i < 16; ++i) { const float val = excl + v[i]; const int t = t0 + i; dc[t] = val;
        const unsigned h1 = f2bf(val); const float r1 = val - bf2f((bf16)h1); const unsigned h2 = f2bf(r1); const float r2 = r1 - bf2f((bf16)h2); const unsigned h3 = f2bf(r2);
        const unsigned one = 0x3F80u;
        v4u qa; qa.x = one | (one << 16); qa.y = one | (h1 << 16); qa.z = h2 | (h3 << 16); qa.w = 0u;
        v4u ka; ka.x = (h1 ^ 0x8000u) | ((h2 ^ 0x8000u) << 16); ka.y = (h3 ^ 0x8000u) | (one << 16); ka.z = one | (one << 16); ka.w = 0u;
        const v4u z = {0u, 0u, 0u, 0u};
        bf16* qp = (bf16*)(F.ws + OFF_QAUG) + ((size_t)bh * SEQ + t) * 16; *(v4u*)qp = qa; *(v4u*)(qp + 8) = z;
        bf16* ksl = KF + (size_t)bh * SEQ * 80; *(v4u*)(ksl + ktile_off<80>(t, 8)) = ka; *(v4u*)(ksl + ktile_off<80>(t, 9)) = z; }
    __syncthreads();
}

__device__ __forceinline__ int fresh_tid() { int t = threadIdx.x; asm volatile("" : "+v"(t)); return t; }
namespace fa {
typedef float f32x16 __attribute__((ext_vector_type(16)));
typedef short s16x4 __attribute__((ext_vector_type(4)));
typedef short v4i16_t __attribute__((ext_vector_type(4)));
typedef LAS const char* lds_cptr;
constexpr int VSLOT = 8192, NSLOT = 4, IMPS = 129;
template <int DQK> struct Map { static constexpr int KS = DQK <= 64 ? 8192 : 12288, K = 0, V = NSLOT * KS, WS = V + NSLOT * VSLOT, IMP = WS + 8 * 256, SEL = IMP + 64 * IMPS * 4, END = SEL + 64 * 16; };
static_assert(Map<64>::END <= 131072 && Map<96>::IMP <= 131072, "attention LDS map");
__device__ __forceinline__ int crow(int r, int hi) { return (r & 3) + 8 * (r >> 2) + 4 * hi; }
__device__ __forceinline__ void glds16(const void* g, unsigned lds_base) {
    unsigned sv; asm volatile("s_mov_b32 %0, m0\n\ts_mov_b32 m0, %2\n\ts_nop 0\n\tglobal_load_lds_dwordx4 %1, off\n\ts_mov_b32 m0, %0" : "=&s"(sv) : "v"(g), "s"(lds_base) : "memory"); }
__device__ __forceinline__ s16x4 vtr(lds_cptr p) { return __builtin_bit_cast(s16x4, __builtin_amdgcn_ds_read_tr16_b64_v4i16((LAS v4i16_t*)p)); }
#define FA_MX3(a, b, c) __builtin_fmaxf(__builtin_fmaxf((a), (b)), (c))
#define FA_MFMA(a, b, c) __builtin_amdgcn_mfma_f32_32x32x16_bf16(a, b, c, 0, 0, 0)
__device__ __forceinline__ float rowmax(const f32x16& p0, const f32x16& p1) {
    float a = FA_MX3(p0[0], p0[1], p1[0]), b = FA_MX3(p0[2], p0[3], p1[1]); a = FA_MX3(a, p1[2], p1[3]);
#pragma unroll
    for (int r = 4; r < 16; r += 4) { a = FA_MX3(a, p0[r], p0[r + 1]); b = FA_MX3(b, p0[r + 2], p0[r + 3]); a = FA_MX3(a, p1[r], p1[r + 1]); b = FA_MX3(b, p1[r + 2], p1[r + 3]); }
    float m = __builtin_fmaxf(a, b); auto rr = __builtin_amdgcn_permlane32_swap(__float_as_uint(m), __float_as_uint(m), false, false);
    return __builtin_fmaxf(__uint_as_float(rr[0]), __uint_as_float(rr[1])); }
__device__ __forceinline__ float halfsum(float v) { auto rr = __builtin_amdgcn_permlane32_swap(__float_as_uint(v), __float_as_uint(v), false, false); return __uint_as_float(rr[0]) + __uint_as_float(rr[1]); }

struct PassArgs {
    const bf16* K; const bf16* V;
    int t_begin, t_end;
    int lo, hi;
    int lo_max, hi_min;
    int nomax;
};
__device__ __forceinline__ void wait_vm_bar(int n) {
    if (n == 0) asm volatile("s_waitcnt vmcnt(0) lgkmcnt(0)\n\ts_barrier" ::: "memory");
    else if (n == 1) asm volatile("s_waitcnt vmcnt(1) lgkmcnt(0)\n\ts_barrier" ::: "memory");
    else if (n == 2) asm volatile("s_waitcnt vmcnt(2) lgkmcnt(0)\n\ts_barrier" ::: "memory");
    else asm volatile("s_waitcnt vmcnt(3) lgkmcnt(0)\n\ts_barrier" ::: "memory");
}
template <int WSOFF> __device__ __forceinline__ void scale_rows(LAS char* shm, f32x16 (&o)[2], float f, int wid, int r32, int hi) {
    LAS float* wsf = (LAS float*)(shm + WSOFF) + wid * 64;
    if (hi == 0) wsf[r32] = f;
    asm volatile("s_waitcnt lgkmcnt(0)" ::: "memory");
#pragma unroll
    for (int r = 0; r < 16; ++r) { const float fr = wsf[crow(r, hi)]; o[0][r] *= fr; o[1][r] *= fr; }
    asm volatile("s_waitcnt lgkmcnt(0)" ::: "memory");
}
#ifndef FA_SKEW
#define FA_SKEW 0
#endif
constexpr float THR = 8.0f;
template <int DQK, int MODE, bool USE_SEL>
__device__ __forceinline__ void attn_pass(LAS char* shm, const bf16x8 (&qr)[DQK / 16], const PassArgs& pa, const unsigned (&sel)[4], f32x16 (&o)[2], float& m, float& l, float invl, int tok) {
    typedef Map<DQK> MP;
    const int tid = fresh_tid(), lane = tid & 63, r32 = lane & 31, hi = lane >> 5; const int wid = __builtin_amdgcn_readfirstlane(tid >> 6);
    constexpr int NCH = DQK / 8, ND = DQK / 16;
    const int nt = pa.t_end - pa.t_begin;
    const bool two_k = (wid + 8 < NCH);
    const int pt = (MODE == 1 ? 0 : 1) + 1 + (two_k ? 1 : 0);
    const bool skew = FA_SKEW && (MODE == 0) && (wid >= 4);
    const bf16* ksrc = pa.K + wid * 512 + lane * 8;
    const bf16* vsrc = pa.V + wid * 512 + lane * 8;
    const unsigned lds0 = (unsigned)(uintptr_t)shm;
#define FA_ISSUE(t_, slot_) do { const size_t ko_ = (size_t)(t_) * 64 * DQK; \
        glds16(ksrc + ko_, (unsigned)__builtin_amdgcn_readfirstlane(lds0 + MP::K + (slot_) * MP::KS + wid * 1024)); \
        if (two_k) glds16(ksrc + ko_ + 8 * 512, (unsigned)__builtin_amdgcn_readfirstlane(lds0 + MP::K + (slot_) * MP::KS + (wid + 8) * 1024)); \
        if (MODE != 1) glds16(vsrc + (size_t)(t_) * 4096, (unsigned)__builtin_amdgcn_readfirstlane(lds0 + MP::V + (slot_) * VSLOT + wid * 1024)); } while (0)
    if (nt <= 0) return;
    FA_ISSUE(pa.t_begin, 0); if (nt > 1) FA_ISSUE(pa.t_begin + 1, 1);
    const float NEG = -__builtin_inff();
    f32x16 p0, p1; v4u pw[4];
    p0 = f32x16{}; p1 = f32x16{};
    bf16x8 kf[2 * ND]; s16x4 vl[8], vh[8];
#define FA_LOADK(sl, D0A, D0B) do { const lds_cptr kp = (lds_cptr)shm + MP::K + (sl) * MP::KS + hi * 1024 + r32 * 16; \
        _Pragma("unroll") for (int d0 = (D0A); d0 < (D0B); ++d0) { kf[2 * d0] = *(const LAS bf16x8*)(kp + d0 * 2048); kf[2 * d0 + 1] = *(const LAS bf16x8*)(kp + d0 * 2048 + 512); } \
        __builtin_amdgcn_sched_barrier(0); } while (0)
#define FA_LOADV(sl) do { if (MODE != 1) { const lds_cptr vp = (lds_cptr)shm + MP::V + (sl) * VSLOT + ((lane >> 4) & 1) * 32 + (lane & 3) * 8 + (4 * hi + ((lane & 15) >> 2)) * 64; \
        _Pragma("unroll") for (int d0 = 0; d0 < 2; ++d0) _Pragma("unroll") for (int ks = 0; ks < 4; ++ks) { vl[d0 * 4 + ks] = vtr(vp + d0 * 4096 + ks * 1024); vh[d0 * 4 + ks] = vtr(vp + d0 * 4096 + ks * 1024 + 512); } \
        __builtin_amdgcn_sched_barrier(0); } } while (0)
#define FA_SEG_A(t) do { \
        f32x16 cin; float c_ = -m; \
        if (USE_SEL) { const unsigned w_ = (t) < 32 ? sel[0] : (t) < 64 ? sel[1] : (t) < 96 ? sel[2] : sel[3]; c_ = ((w_ >> ((t) & 31)) & 1u) ? -m : NEG; } \
        _Pragma("unroll") for (int r = 0; r < 16; ++r) cin[r] = c_; \
        _Pragma("unroll") for (int d0 = 0; d0 < ND; ++d0) { \
            if (d0 == 0) { p0 = FA_MFMA(kf[0], qr[0], cin); p1 = FA_MFMA(kf[1], qr[0], cin); } \
            else { p0 = FA_MFMA(kf[2 * d0], qr[d0], p0); p1 = FA_MFMA(kf[2 * d0 + 1], qr[d0], p1); } } \
        if (!(64 * (t) >= pa.lo_max && 64 * (t) + 63 <= pa.hi_min)) { \
            const int kb = 64 * (t) + 4 * hi; \
            _Pragma("unroll") for (int r = 0; r < 16; ++r) { const int kv = kb + (r & 3) + 8 * (r >> 2); \
                if (kv < pa.lo || kv > pa.hi) p0[r] = NEG; if (kv + 32 < pa.lo || kv + 32 > pa.hi) p1[r] = NEG; } } \
        __builtin_amdgcn_sched_barrier(0); \
    } while (0)
#define FA_SEG_B(t) do { \
        if (MODE != 2) { \
            float rm = 0.f; if (!pa.nomax) rm = rowmax(p0, p1); \
            if (!pa.nomax && __any(rm > THR)) { \
                const float dl = __builtin_fmaxf(rm, 0.f); m += dl; const float alpha = ex2(-dl); l *= alpha; \
                _Pragma("unroll") for (int r = 0; r < 16; ++r) { p0[r] -= dl; p1[r] -= dl; } \
                if (MODE == 0) scale_rows<MP::WS>(shm, o, alpha, wid, r32, hi); \
            } \
            float ls = 0.f; \
            _Pragma("unroll") for (int r = 0; r < 16; ++r) { p0[r] = ex2(p0[r]); p1[r] = ex2(p1[r]); ls += p0[r] + p1[r]; } \
            l += ls; \
        } else { \
            _Pragma("unroll") for (int r = 0; r < 16; ++r) { p0[r] = ex2(p0[r]) * invl; p1[r] = ex2(p1[r]) * invl; } \
            LAS unsigned* imp = (LAS unsigned*)(shm + MP::IMP) + tok * IMPS; \
            _Pragma("unroll") for (int half = 0; half < 2; ++half) \
            _Pragma("unroll") for (int g = 0; g < 4; ++g) { \
                const float x0 = half ? p1[4 * g] : p0[4 * g], x1 = half ? p1[4 * g + 1] : p0[4 * g + 1], x2 = half ? p1[4 * g + 2] : p0[4 * g + 2], x3 = half ? p1[4 * g + 3] : p0[4 * g + 3]; \
                const int jsel = 16 * (t) + 8 * half + 2 * g + hi; \
                const unsigned a = (unsigned)((32.f * ((x0 + x1) + x2) + 16.f * x3) * 2097152.f + 0.5f), c = (unsigned)(16.f * x3 * 2097152.f + 0.5f); \
                if (jsel < 128) __hip_atomic_fetch_add(imp + jsel, a, __ATOMIC_RELAXED, __HIP_MEMORY_SCOPE_WORKGROUP); \
                if (jsel + 1 < 128) __hip_atomic_fetch_add(imp + jsel + 1, c, __ATOMIC_RELAXED, __HIP_MEMORY_SCOPE_WORKGROUP); } \
        } \
        if (MODE != 1) { \
            pw[0] = (v4u){pk2(p0[0], p0[1]), pk2(p0[2], p0[3]), pk2(p0[4], p0[5]), pk2(p0[6], p0[7])}; \
            pw[1] = (v4u){pk2(p0[8], p0[9]), pk2(p0[10], p0[11]), pk2(p0[12], p0[13]), pk2(p0[14], p0[15])}; \
            pw[2] = (v4u){pk2(p1[0], p1[1]), pk2(p1[2], p1[3]), pk2(p1[4], p1[5]), pk2(p1[6], p1[7])}; \
            pw[3] = (v4u){pk2(p1[8], p1[9]), pk2(p1[10], p1[11]), pk2(p1[12], p1[13]), pk2(p1[14], p1[15])}; } \
        __builtin_amdgcn_sched_barrier(0); \
    } while (0)
#define FA_SEG_C() do { if (MODE != 1) { \
        _Pragma("unroll") for (int d0 = 0; d0 < 2; ++d0) \
        _Pragma("unroll") for (int ks = 0; ks < 4; ++ks) { \
            const s16x4 a_ = vl[d0 * 4 + ks], b_ = vh[d0 * 4 + ks]; \
            const bf16x8 vf = {a_[0], a_[1], a_[2], a_[3], b_[0], b_[1], b_[2], b_[3]}; \
            o[d0] = FA_MFMA(__builtin_bit_cast(bf16x8, pw[ks]), vf, o[d0]); } \
        __builtin_amdgcn_sched_barrier(0); } } while (0)
    int slot = 0, pslot = 0;
    for (int i = 0; i < nt; ++i) {
        const int t = pa.t_begin + i;
        wait_vm_bar((i + 1 < nt) ? pt : 0);
        if (i + 2 < nt) { const int s2 = (slot + 2) & 3; FA_ISSUE(t + 2, s2); }
        if (!skew) { FA_LOADK(slot, 0, ND); FA_SEG_A(t); FA_LOADV(slot); FA_SEG_B(t); FA_SEG_C(); }
        else { if (i > 0) { FA_LOADV(pslot); FA_SEG_B(t - 1); FA_LOADK(slot, 0, ND / 2); FA_SEG_C(); FA_LOADK(slot, ND / 2, ND); } else { FA_LOADK(slot, 0, ND); } FA_SEG_A(t); }
        pslot = slot; slot = (slot + 1) & 3;
    }
    if (skew) { FA_LOADV(pslot); FA_SEG_B(pa.t_end - 1); FA_SEG_C(); }
    asm volatile("s_waitcnt lgkmcnt(0)\n\ts_barrier" ::: "memory");
#undef FA_ISSUE
#undef FA_SEG_A
#undef FA_LOADK
#undef FA_LOADV
#undef FA_SEG_B
#undef FA_SEG_C
}
template <int DQK> __device__ __forceinline__ void write_o(LAS char* shm, const f32x16 (&o)[2], bf16* dst, int pitch, int wid, int lane) {
    typedef Map<DQK> MP;
    const int r32 = lane & 31, hi = lane >> 5;
    LAS bf16* stg = (LAS bf16*)(shm + (wid < 4 ? MP::K + 2 * MP::KS + wid * 4096 : MP::V + 2 * VSLOT + (wid - 4) * 4096));
#pragma unroll
    for (int r = 0; r < 16; ++r) { const int orow = crow(r, hi);
#pragma unroll
        for (int d0 = 0; d0 < 2; ++d0) stg[orow * 64 + d0 * 32 + r32] = (bf16)f2bf(o[d0][r]); }
    asm volatile("s_waitcnt lgkmcnt(0)" ::: "memory");
#pragma unroll
    for (int i = 0; i < 4; ++i) { const int row = i * 8 + (lane >> 3), ch = lane & 7; const v4u v = *(const LAS v4u*)(stg + row * 64 + ch * 8); *(v4u*)(dst + (size_t)row * pitch + ch * 8) = v; }
    asm volatile("s_waitcnt lgkmcnt(0)" ::: "memory");
}
template <int ND> __device__ __forceinline__ void load_q(bf16x8 (&qr)[ND], const bf16* qrow, int hi) {
#pragma unroll
    for (int d0 = 0; d0 < ND; ++d0) qr[d0] = *(const bf16x8*)(qrow + d0 * 16 + hi * 8);
}
template <int ND> __device__ __forceinline__ void mla_q_finish(bf16x8 (&qr)[ND], const float* gq, const float* c32, const float* s32, int t, int hi) {
    if constexpr (ND == 6) {
        float x[6][8]; float ss = 0.f;
#pragma unroll
        for (int d0 = 0; d0 < 6; ++d0) { const v4u w = __builtin_bit_cast(v4u, qr[d0]);
            x[d0][0] = bflo(w.x); x[d0][1] = bfhi(w.x); x[d0][2] = bflo(w.y); x[d0][3] = bfhi(w.y); x[d0][4] = bflo(w.z); x[d0][5] = bfhi(w.z); x[d0][6] = bflo(w.w); x[d0][7] = bfhi(w.w);
#pragma unroll
            for (int j = 0; j < 8; ++j) ss += x[d0][j] * x[d0][j]; }
        ss = halfsum(ss);
        const float rn = rsq(ss * (1.0f / 96.0f) + EPS);
#pragma unroll
        for (int d0 = 0; d0 < 6; ++d0) { const f32x4 g0 = *(const f32x4*)(gq + 16 * d0 + 8 * hi), g1 = *(const f32x4*)(gq + 16 * d0 + 8 * hi + 4);
#pragma unroll
            for (int j = 0; j < 4; ++j) { x[d0][j] *= rn * g0[j]; x[d0][4 + j] *= rn * g1[j]; } }
        const f32x4 c0 = *(const f32x4*)(c32 + (size_t)t * 16 + 8 * hi), c1 = *(const f32x4*)(c32 + (size_t)t * 16 + 8 * hi + 4), s0 = *(const f32x4*)(s32 + (size_t)t * 16 + 8 * hi), s1 = *(const f32x4*)(s32 + (size_t)t * 16 + 8 * hi + 4);
#pragma unroll
        for (int j = 0; j < 8; ++j) { const float c = j < 4 ? c0[j & 3] : c1[j & 3], sn = j < 4 ? s0[j & 3] : s1[j & 3]; const float a = x[4][j], bb = x[5][j]; x[4][j] = a * c - bb * sn; x[5][j] = bb * c + a * sn; }
#pragma unroll
        for (int d0 = 0; d0 < 6; ++d0) { v4u w; w.x = pk2(x[d0][0] * C2_96, x[d0][1] * C2_96); w.y = pk2(x[d0][2] * C2_96, x[d0][3] * C2_96); w.z = pk2(x[d0][4] * C2_96, x[d0][5] * C2_96); w.w = pk2(x[d0][6] * C2_96, x[d0][7] * C2_96); qr[d0] = __builtin_bit_cast(bf16x8, w); }
    }
}
template <int DQK> __device__ __forceinline__ void l1_unit(LAS char* shm, int bh, int qb, int t_first, int nomax, const bf16* Q, const bf16* K, const bf16* V, bf16* O, const float* gq, const float* c32, const float* s32, const bf16* qaug) {
    const int wid = __builtin_amdgcn_readfirstlane(fresh_tid() >> 6);
    const int b = bh >> 3, h = bh & 7, q0 = qb * 256;
    f32x16 o[2]; o[0] = f32x16{}; o[1] = f32x16{}; float m = 0.f, l = 0.f;
    { const int lane = fresh_tid() & 63, r32 = lane & 31, hi = lane >> 5; const int qpos = q0 + 32 * wid + r32; const size_t row = (size_t)b * SEQ + qpos;
      bf16x8 qr[DQK / 16]; load_q<DQK / 16>(qr, Q + (row * 8 + h) * DQK, hi);
      if (DQK == 80) qr[DQK / 16 - 1] = *(const bf16x8*)(qaug + ((size_t)bh * SEQ + qpos) * 16 + hi * 8);
      if (DQK == 96) mla_q_finish(qr, gq, c32, s32, qpos, hi);
      PassArgs pa; pa.K = K + (size_t)bh * SEQ * DQK; pa.V = V + (size_t)bh * SEQ * 64; pa.t_begin = t_first; pa.t_end = (q0 + 256) / 64; pa.nomax = nomax;
      pa.lo = 0; pa.hi = qpos; pa.lo_max = 0; pa.hi_min = q0 + 32 * wid;
      const unsigned sel[4] = {0u, 0u, 0u, 0u};
      attn_pass<DQK, 0, false>(shm, qr, pa, sel, o, m, l, 0.f, 0); }
    { const int lane = fresh_tid() & 63, r32 = lane & 31, hi = lane >> 5;
      const float lt = halfsum(l); scale_rows<Map<DQK>::WS>(shm, o, lt > 0.f ? 1.0f / lt : 0.f, wid, r32, hi);
      write_o<DQK>(shm, o, O + ((size_t)b * SEQ + q0 + 32 * wid) * 1024 + h * 64, 1024, wid, lane); }
}
__device__ __forceinline__ float gain_absmax(const float* g, int n, int lane) {
    float v = 0.f; for (int i = lane; i < n; i += 64) v = __builtin_fmaxf(v, __builtin_fabsf(g[i]));
#pragma unroll
    for (int o = 1; o < 64; o <<= 1) v = __builtin_fmaxf(v, __shfl_xor(v, o));
    return __builtin_bit_cast(float, __builtin_amdgcn_readfirstlane(__builtin_bit_cast(int, v)));
}
constexpr int CW_Q1 = 12288;
__device__ __forceinline__ void att1_phase(Frame& F) {
    LAS char* shm = (LAS char*)F.lds; unsigned char* ws = F.ws; unsigned* ctl = (unsigned*)(ws + OFF_CTL);
    const int lane0 = fresh_tid() & 63;
    const float bq = gain_absmax(F.in[33], 64, lane0), bk = gain_absmax(F.in[34], 64, lane0), mq = gain_absmax(F.in[39], 96, lane0), mk = gain_absmax(F.in[40], 96, lane0);
    const float Bf = C2_64 * 64.f * bq * bk * 1.02f, Bm = C2_96 * 96.f * mq * mk * 1.02f;
    const int nomax_f = Bf <= 40.f, nomax_m = Bm <= 40.f;
    const float thr = 2.f * Bf + 43.f;
    LAS int* slotw = (LAS int*)(shm + 130048);
    const int myq = (F.vcu * 8) / F.G;
    for (;;) {
        __syncthreads();
        if (threadIdx.x == 0) { int got = -1;
            for (int k = 0; k < 8 && got < 0; ++k) { const int q = (myq + k) & 7; const unsigned id = __hip_atomic_fetch_add(ctl + CW_Q1 + 64 * q, 1u, __ATOMIC_RELAXED, __HIP_MEMORY_SCOPE_AGENT); if (id < 128u) got = q * 128 + (int)id; }
            *slotw = got; }
        __syncthreads();
        const int u = *slotw; if (u < 0) break;
        const int q = u >> 7, id = u & 127, fox = id >> 6, bh = 2 * q + ((id >> 5) & 1), qb = 31 - (id & 31);
        if (!fox) l1_unit<96>(shm, bh, qb, 0, nomax_m, (const bf16*)(ws + OFF_QM), (const bf16*)(ws + OFF_KM), (const bf16*)(ws + OFF_VM), (bf16*)(ws + OFF_O1) + 512, F.in[39], (const float*)(ws + OFF_ROPE32C), (const float*)(ws + OFF_ROPE32S), nullptr);
        else {
            const float* dc = (const float*)(ws + OFF_DC2) + (size_t)bh * SEQ; const float lim = dc[qb * 256] + thr;
            int lo = 0, hi = 4 * qb;
            while (lo < hi) { const int mid = (lo + hi) >> 1; if (dc[64 * mid + 63] < lim) hi = mid; else lo = mid + 1; }
            l1_unit<80>(shm, bh, qb, lo, nomax_f, (const bf16*)(ws + OFF_QF), (const bf16*)(ws + OFF_KF), (const bf16*)(ws + OFF_VF), (bf16*)(ws + OFF_O1), nullptr, nullptr, nullptr, (const bf16*)(ws + OFF_QAUG));
        }
    }
}
__device__ __forceinline__ void l0_unit(Frame& F, LAS char* shm, int bhk, int tb, int nomax) {
    const int wid = __builtin_amdgcn_readfirstlane(fresh_tid() >> 6);
    unsigned char* ws = F.ws;
    const int b = bhk >> 1, hk = bhk & 1, g = wid >> 1, th = wid & 1, h = hk * 4 + g, t0 = tb * 64;
    const size_t kvofs = (size_t)bhk * SEQ * 64;
    const bf16* KS = (const bf16*)(ws + OFF_KV8 + 2 * SZ_KV) + kvofs; const bf16* VS = (const bf16*)(ws + OFF_KV8 + 3 * SZ_KV) + kvofs;
    const bf16* KW = (const bf16*)(ws + OFF_KV8 + 4 * SZ_KV) + kvofs; const bf16* VW = (const bf16*)(ws + OFF_KV8 + 5 * SZ_KV) + kvofs;
    const bf16* KB = (const bf16*)(ws + OFF_KV8 + 6 * SZ_KV) + kvofs; const bf16* VB = (const bf16*)(ws + OFF_KV8 + 7 * SZ_KV) + kvofs;
    const bf16* KCM = (const bf16*)(ws + OFF_KCMP) + (size_t)bhk * 512 * 64; const bf16* VCM = (const bf16*)(ws + OFF_VCMP) + (size_t)bhk * 512 * 64;
    bf16* QO = (bf16*)(ws + OFF_QO); const bf16* QC = (const bf16*)(ws + OFF_QC);
    LAS unsigned* IMP = (LAS unsigned*)(shm + Map<64>::IMP); LAS unsigned* SEL = (LAS unsigned*)(shm + Map<64>::SEL);
    const unsigned nosel[4] = {0u, 0u, 0u, 0u};
    f32x16 o[2]; bf16x8 qr[4]; PassArgs pa; float m, l, gate_c = 0.f; pa.nomax = nomax;
#define CTX() const int tid_ = fresh_tid(), lane = tid_ & 63, r32 = lane & 31, hi = lane >> 5; const int tok = 32 * th + r32, tq = t0 + tok; const size_t row = (size_t)b * SEQ + tq; (void)hi; (void)row; (void)tq; (void)tok; (void)lane
#define GATE(i) (((const float*)(ws + OFF_GATES))[row * 24 + h * 3 + (i)])
#define ACCP() f32x4* accp = (f32x4*)(ws + OFF_OACC) + (size_t)F.vcu * 4096 + wid * 512 + lane
#define ACC_AT(d0, g) accp[((d0) * 4 + (g)) * 64]
#define O4(d0, g) (f32x4){o[d0][4 * (g)], o[d0][4 * (g) + 1], o[d0][4 * (g) + 2], o[d0][4 * (g) + 3]}
    { CTX();
      for (int i = tid_; i < 64 * IMPS; i += 512) IMP[i] = 0u;
      load_q<4>(qr, QC + row * 512 + h * 64, hi);
      pa.K = KCM; pa.V = VCM; pa.t_begin = 0; pa.t_end = ((((t0 + 32) >> 4) + 1) + 63) >> 6;
      pa.lo = 0; pa.hi = (tq - 31) >> 4; pa.lo_max = 0; pa.hi_min = (t0 + 32 * th - 31) >> 4;
      o[0] = f32x16{}; o[1] = f32x16{}; m = 0.f; l = 0.f;
      gate_c = GATE(0);
      attn_pass<64, 1, false>(shm, qr, pa, nosel, o, m, l, 0.f, 0);
      const float lt = halfsum(l); const float invl = lt > 0.f ? 1.0f / lt : 0.f;
      attn_pass<64, 2, false>(shm, qr, pa, nosel, o, m, l, invl, tok); }
    { CTX(); ACCP();
      scale_rows<Map<64>::WS>(shm, o, gate_c, wid, r32, hi);
#pragma unroll
      for (int d0 = 0; d0 < 2; ++d0)
#pragma unroll
        for (int g4 = 0; g4 < 4; ++g4) ACC_AT(d0, g4) = O4(d0, g4); }
    { CTX(); const int cur = tb;
      const int j0 = lane, j1 = lane + 64;
      const bool f0 = (j0 == 0) || (j0 == cur) || (j0 == cur - 1), f1 = (j1 == cur) || (j1 == cur - 1);
      const unsigned long long lt_mask = (1ull << lane) - 1ull;
      for (int kg = 0; kg < 8; kg += 4) {
        int k0[4], k1[4]; unsigned T[4];
#pragma unroll
        for (int u = 0; u < 4; ++u) { const int tk = wid * 8 + kg + u;
            k0[u] = f0 ? 0x7fffffff : (j0 <= cur ? (int)IMP[tk * IMPS + j0] : -1); k1[u] = f1 ? 0x7fffffff : (j1 <= cur ? (int)IMP[tk * IMPS + j1] : -1); T[u] = 0u; }
        for (int bit = 28; bit >= 0; --bit) {
#pragma unroll
            for (int u = 0; u < 4; ++u) { const int cand = (int)(T[u] | (1u << bit));
                const int c = __builtin_popcountll(__ballot(k0[u] >= cand)) + __builtin_popcountll(__ballot(k1[u] >= cand));
                T[u] = c >= 16 ? (unsigned)cand : T[u]; }
        }
#pragma unroll
        for (int u = 0; u < 4; ++u) { const int tk = wid * 8 + kg + u;
            const int c0 = __builtin_popcountll(__ballot(k0[u] >= 0)) + __builtin_popcountll(__ballot(k1[u] >= 0));
            const int Tq = c0 >= 16 ? (int)T[u] : -1;
            const unsigned long long gt0 = __ballot(k0[u] > Tq), gt1 = __ballot(k1[u] > Tq), eq0 = __ballot(k0[u] == Tq), eq1 = __ballot(k1[u] == Tq);
            const int need = 16 - (__builtin_popcountll(gt0) + __builtin_popcountll(gt1));
            const int rk0 = __builtin_popcountll(eq0 & lt_mask), rk1 = __builtin_popcountll(eq0) + __builtin_popcountll(eq1 & lt_mask);
            const bool s0 = (k0[u] > Tq || (k0[u] == Tq && rk0 < need)) && j0 <= cur, s1 = (k1[u] > Tq || (k1[u] == Tq && rk1 < need)) && j1 <= cur;
            const unsigned long long b0 = __ballot(s0), b1 = __ballot(s1);
            if (lane == 0) { SEL[tk * 4 + 0] = (unsigned)b0; SEL[tk * 4 + 1] = (unsigned)(b0 >> 32); SEL[tk * 4 + 2] = (unsigned)b1; SEL[tk * 4 + 3] = (unsigned)(b1 >> 32); } }
      } }
    asm volatile("s_waitcnt lgkmcnt(0)\n\ts_barrier" ::: "memory");
    { CTX();
      unsigned sel[4]; sel[0] = SEL[tok * 4 + 0]; sel[1] = SEL[tok * 4 + 1]; sel[2] = SEL[tok * 4 + 2]; sel[3] = SEL[tok * 4 + 3];
      load_q<4>(qr, QO + row * 1024 + h * 64, hi);
      pa.K = KS; pa.V = VS; pa.t_begin = 0; pa.t_end = tb + 1; pa.lo = 0; pa.hi = tq; pa.lo_max = 0; pa.hi_min = t0 + 32 * th;
      o[0] = f32x16{}; o[1] = f32x16{}; m = 0.f; l = 0.f;
      gate_c = GATE(1);
      attn_pass<64, 0, true>(shm, qr, pa, sel, o, m, l, 0.f, 0); }
    { CTX(); ACCP();
      const float lt = halfsum(l); scale_rows<Map<64>::WS>(shm, o, lt > 0.f ? gate_c / lt : 0.f, wid, r32, hi);
#pragma unroll
      for (int d0 = 0; d0 < 2; ++d0)
#pragma unroll
        for (int g4 = 0; g4 < 4; ++g4) { const f32x4 a = ACC_AT(d0, g4); ACC_AT(d0, g4) = a + O4(d0, g4); } }
    { CTX();
      gate_c = GATE(2);
      pa.K = KW; pa.V = VW; pa.t_begin = tb > 8 ? tb - 8 : 0; pa.t_end = tb + 1; pa.lo = tq - 511; pa.hi = tq; pa.lo_max = t0 + 32 * th + 31 - 511; pa.hi_min = t0 + 32 * th;
      o[0] = f32x16{}; o[1] = f32x16{}; m = 0.f; l = 0.f;
      attn_pass<64, 0, false>(shm, qr, pa, nosel, o, m, l, 0.f, 0); }
    { CTX(); ACCP();
      const float lt = halfsum(l); scale_rows<Map<64>::WS>(shm, o, lt > 0.f ? gate_c / lt : 0.f, wid, r32, hi);
#pragma unroll
      for (int d0 = 0; d0 < 2; ++d0)
#pragma unroll
        for (int g4 = 0; g4 < 4; ++g4) { const f32x4 a = ACC_AT(d0, g4); o[d0][4 * g4] += a[0]; o[d0][4 * g4 + 1] += a[1]; o[d0][4 * g4 + 2] += a[2]; o[d0][4 * g4 + 3] += a[3]; }
      write_o<64>(shm, o, QO + ((size_t)b * SEQ + t0 + 32 * th) * 1024 + h * 64, 1024, wid, lane); }
    { CTX();
      load_q<4>(qr, QO + row * 1024 + 512 + h * 64, hi);
      pa.K = KB; pa.V = VB; pa.t_begin = tb > 2 ? tb - 2 : 0; pa.t_end = tb + 1; pa.lo = tq - 127; pa.hi = tq; pa.lo_max = t0 + 32 * th + 31 - 127; pa.hi_min = t0 + 32 * th;
      o[0] = f32x16{}; o[1] = f32x16{}; m = 0.f; l = 0.f;
      attn_pass<64, 0, false>(shm, qr, pa, nosel, o, m, l, 0.f, 0); }
    { CTX();
      const float lt = halfsum(l); const float sk = F.in[20][h] * LOG2E; const float M2 = __builtin_fmaxf(m, sk); const float a = ex2(m - M2); const float den = lt * a + ex2(sk - M2);
      scale_rows<Map<64>::WS>(shm, o, a / den, wid, r32, hi);
      write_o<64>(shm, o, QO + ((size_t)b * SEQ + t0 + 32 * th) * 1024 + 512 + h * 64, 1024, wid, lane); }
#undef CTX
#undef GATE
#undef ACCP
#undef ACC_AT
#undef O4
}
__device__ __forceinline__ void att0_phase(Frame& F) {
    LAS char* shm = (LAS char*)F.lds;
    const int bhk = F.vcu >> 6, s = F.vcu & 63; const int lane0 = fresh_tid() & 63;
    float gq = __builtin_fmaxf(gain_absmax(F.in[8], 64, lane0), gain_absmax(F.in[18], 64, lane0));
    float gk = __builtin_fmaxf(__builtin_fmaxf(gain_absmax(F.in[9], 64, lane0), gain_absmax(F.in[10], 64, lane0)), __builtin_fmaxf(gain_absmax(F.in[11], 64, lane0), gain_absmax(F.in[19], 64, lane0)));
    const int nomax = (C2_64 * 64.f * gq * gk * 1.02f) <= 40.f;
    for (int i = 0; i < 2; ++i) l0_unit(F, shm, bhk, i == 0 ? s : 127 - s, nomax);
}
}

__device__ __forceinline__ void refresh_frame(Frame& F) { const int t = fresh_tid(); F.tid = t; F.lane = t & 63; F.wave = __builtin_amdgcn_readfirstlane(t >> 6); }
constexpr int RING_BYTES = 131072, MISC_OFF = RING_BYTES + 320, INTAB_OFF = RING_BYTES + 1024, LDS_BYTES = 147456;
constexpr int NPHASE = 18;
struct Args { const float* in[46]; float* out; unsigned char* ws; int ph_lo, ph_hi; };

__global__ void __launch_bounds__(NWAVES * 64, 2) mega_fwd(Args args) {
    extern __shared__ __attribute__((aligned(16))) unsigned char lds[];
    Frame F;
    F.lds = (LAS unsigned char*)lds; F.tid = threadIdx.x; F.lane = F.tid & 63; F.wave = __builtin_amdgcn_readfirstlane(F.tid >> 6);
    F.G = gridDim.x; { const int bx = blockIdx.x; F.vcu = (F.G % 8 == 0) ? (bx % 8) * (F.G / 8) + bx / 8 : bx; }
    F.in = (InTab)(F.lds + INTAB_OFF); F.out = args.out; F.ws = args.ws;
    volatile LAS unsigned* MISC = (volatile LAS unsigned*)(F.lds + MISC_OFF);
    for (int u = F.tid; u < (LDS_BYTES - RING_BYTES) / 4; u += NWAVES * 64) ((LAS unsigned*)(F.lds + RING_BYTES))[u] = 0u;
    __syncthreads();
    { const __attribute__((address_space(4))) fptr_t* ka = (const __attribute__((address_space(4))) fptr_t*)__builtin_amdgcn_kernarg_segment_ptr();
      if (F.tid < 46) F.in[F.tid] = ka[F.tid]; }
    __syncthreads();
    unsigned* ctl = (unsigned*)(F.ws + OFF_CTL);
    XcdBarrier bar = xcd_barrier_post(ctl + 4096, MISC + 8);
    const int lo = args.ph_lo, hi = args.ph_hi;
    int vb = (int)blockIdx.x; bool xlocal = false;
#define IN(k) (refresh_frame(F), lo <= (k) && (k) < hi)
#define BOTH(k) (IN(k) && IN((k) + 1))
#define SEAM_G(k) do { if (BOTH(k)) { xcd_barrier(bar, true); } } while (0)
#define SEAM_L(k) do { if (BOTH(k)) xcd_barrier(bar, !xlocal); } while (0)
#define SEAM(k) SEAM_G(k)
#define GD_INIT() GemmDesc gd; gd.in = F.in; gd.ws = F.ws; gd.out = F.out; gd.ep = 0; gd.M = NTOK; gd.K = DM; gd.lda = DM; gd.N = DM; gd.A = nullptr; gd.Bt = nullptr; const int bx = vb; unsigned char* ws = F.ws
#define FFN_PHASES(p0_, fidx_, cfgb_, first_, last_) \
    if (IN(p0_)) { GD_INIT(); gd.A = (const bf16*)(ws + ((cfgb_) ? OFF_XBB : OFF_XBA)); gd.Bt = (const bf16*)(ws + OFF_WGU + (fidx_) * SZ_WGU); gd.N = 2 * FF; gd.ep = (cfgb_) ? 1 : 0; \
        gemm_phase<EPI_GATEUP>(F.lds, gd, F.G, bx); } \
    SEAM_L(p0_); \
    if (IN((p0_) + 1)) { GD_INIT(); gd.A = (const bf16*)(ws + ((cfgb_) ? OFF_ACTB : OFF_ACTA)); gd.Bt = (const bf16*)(ws + OFF_WD + (fidx_) * SZ_WD); gd.K = FF; gd.lda = FF; gd.ep = ((first_) ? 1 : 0) | ((cfgb_) ? 16 : 0) | ((last_) ? 32 : 0); \
        gemm_phase<EPI_RESID>(F.lds, gd, F.G, bx); } \
    SEAM_L((p0_) + 1)

    if (IN(0)) p0_prologue(F);
    SEAM(0);
    if (lo == 0 && hi > 1) {
        unsigned* bw = ctl + 4096; bool ok = (F.G == 256);
#pragma unroll
        for (unsigned j = 0; j < 16; ++j) { const unsigned c = xb_ld(&bw[XB_XCNT(j)]); ok = ok && (c == (j < 8u ? 32u : 0u)); }
        const unsigned rank = MISC[10];
        if (ok && bar.x < 8u && rank < 32u) { vb = (int)(rank * 8u + bar.x); xlocal = true; }
        vb = __builtin_amdgcn_readfirstlane(vb);
        F.vcu = (vb % 8) * (F.G / 8) + vb / 8;
    }
    if (IN(1)) { GD_INIT(); gd.A = (const bf16*)(ws + OFF_XBA); gd.Bt = (const bf16*)(ws + OFF_WGU); gd.N = 2 * FF;
        gemm_phase<EPI_GATEUP>(F.lds, gd, F.G, bx);
        const int nfull = (NTOK / 256) * (2 * FF / 256) - 5 * F.G;
        if (bx >= nfull) { refresh_frame(F); convert_mats(F, MATS_P1, (bx - nfull) * NWAVES + F.wave, (F.G - nfull) * NWAVES); } }
    SEAM_L(1);
    if (IN(2)) { GD_INIT(); gd.A = (const bf16*)(ws + OFF_ACTA); gd.Bt = (const bf16*)(ws + OFF_WD); gd.K = FF; gd.lda = FF; gd.ep = 1;
        gemm_phase<EPI_RESID>(F.lds, gd, F.G, bx); }
    SEAM_L(2);
    if (IN(3)) { GD_INIT(); gd.A = (const bf16*)(ws + OFF_XBA); gd.Bt = (const bf16*)(ws + OFF_WIN0); gd.N = 2048; gemm_phase<EPI_L0IN>(F.lds, gd, F.G, bx); }
    SEAM(3);
    if (IN(4)) {
        GD_INIT();
        for (int gi = 0; gi < 2; ++gi) {
            gd.A = (const bf16*)(ws + OFF_KV8 + gi * SZ_KV); gd.Bt = (const bf16*)(ws + (gi ? OFF_W1V : OFF_W1K)); gd.M = 2048; gd.N = 256; gd.K = 2048; gd.lda = 1024; gd.ep = gi;
            gemm_phase<EPI_CMP1>(F.lds, gd, F.G, (bx + gi * 128) % F.G);
        }
        bool has_unit = false;
        for (int i = 0; i < 2; ++i) { const int cb = (bx + i * 128) % F.G; pg8::StaticOrder S; S.init(2048, 256, F.G, cb); pg8::Unit u;
            for (int k = 0; S.next(k, u); ++k) { cmp2_tile(F, i, u.pm); has_unit = true; } }
        if (!has_unit) {
            const int b2 = bx < 8 ? 0 : (bx < 128 ? bx - 8 : bx - 16);
            refresh_frame(F); __syncthreads(); convert_mats(F, MATS_P4, b2 * NWAVES + F.wave, (F.G - 16) * NWAVES); __syncthreads();
            refresh_frame(F); gates_phase(F, b2 * NWAVES + F.wave, (F.G - 16) * NWAVES); }
    }
    SEAM(4);
    if (IN(5)) fa::att0_phase(F);
    SEAM(5);
    if (IN(6)) { GD_INIT(); gd.A = (const bf16*)(ws + OFF_QO); gd.Bt = (const bf16*)(ws + OFF_WOUT0); gd.ep = 4; gemm_phase<EPI_RESID>(F.lds, gd, F.G, bx); }
    SEAM_L(6);
    if (IN(7)) { GD_INIT(); gd.A = (const bf16*)(ws + OFF_XBA); gd.Bt = (const bf16*)(ws + OFF_WGU + SZ_WGU); gd.N = 2 * FF;
        gemm_phase<EPI_GATEUP>(F.lds, gd, F.G, bx);
        const int nfull = (NTOK / 256) * (2 * FF / 256) - 5 * F.G;
        if (MATS_P7 != 0u && bx >= nfull) { refresh_frame(F); convert_mats(F, MATS_P7, (bx - nfull) * NWAVES + F.wave, (F.G - nfull) * NWAVES); } }
    SEAM_L(7);
    if (IN(8)) { GD_INIT(); gd.A = (const bf16*)(ws + OFF_ACTA); gd.Bt = (const bf16*)(ws + OFF_WD + SZ_WD); gd.K = FF; gd.lda = FF; gd.ep = 8;
        gemm_phase<EPI_RESID>(F.lds, gd, F.G, bx); }
    SEAM_L(8);
    FFN_PHASES(9, 2, false, false, false);
    if (IN(11)) { GD_INIT(); gd.A = (const bf16*)(ws + OFF_XBA); gd.Bt = (const bf16*)(ws + OFF_WIN1); gd.N = 2048; gemm_phase<EPI_L1IN>(F.lds, gd, F.G, bx); }
    SEAM(11);
    if (IN(12)) {
        GD_INIT();
        gd.A = (const bf16*)(ws + OFF_CQ); gd.Bt = (const bf16*)(ws + OFF_WQB); gd.N = 768; gd.K = 256; gd.lda = 256;
        gemm_phase<EPI_QB>(F.lds, gd, F.G, bx);
        gd.A = (const bf16*)(ws + OFF_CKV); gd.Bt = (const bf16*)(ws + OFF_WKVB); gd.N = 1024; gd.K = 128; gd.lda = 128;
        if (bx < F.G - 16) gemm_phase<EPI_KVB>(F.lds, gd, F.G - 16, (bx + 48) % (F.G - 16));
        else { refresh_frame(F); fox_scan(F, bx - (F.G - 16)); }
    }
    SEAM(12);
    if (IN(14)) fa::att1_phase(F);
    SEAM(14);
    if (IN(15)) { GD_INIT(); gd.A = (const bf16*)(ws + OFF_O1); gd.Bt = (const bf16*)(ws + OFF_WOUT1); gd.ep = 2 | 4; gemm_phase<EPI_RESID>(F.lds, gd, F.G, bx); }
    SEAM_L(15);
    FFN_PHASES(16, 3, true, false, true);
#undef IN
#undef BOTH
#undef SEAM
#undef GD_INIT
#undef FFN_PHASES
}

extern "C" void kernel_launch(void* const* d_in, const int* in_sizes, int n_in, void* d_out, int out_size, void* d_ws, size_t ws_size, hipStream_t stream) {
    static int grid = 0;
    if (grid == 0) {
        if (n_in != 46 || in_sizes[0] != NTOK * DM || out_size != NTOK * DM || ws_size < WS_END) { fprintf(stderr, "kernel_launch: unexpected shapes (n_in %d, ws %zu)\n", n_in, ws_size); grid = -1; return; }
        int dev = 0, cus = 0, per_cu = 0;
        hipGetDevice(&dev); hipDeviceGetAttribute(&cus, hipDeviceAttributeMultiprocessorCount, dev);
        hipFuncSetAttribute((const void*)mega_fwd, hipFuncAttributeMaxDynamicSharedMemorySize, LDS_BYTES);
        hipOccupancyMaxActiveBlocksPerMultiprocessor(&per_cu, (const void*)mega_fwd, NWAVES * 64, LDS_BYTES);
        if (per_cu < 1) { fprintf(stderr, "kernel_launch: occupancy query says %d blocks per CU\n", per_cu); per_cu = 1; }
        (void)hipGetLastError();
        grid = cus;
        if (grid > cus * per_cu) grid = cus * per_cu;
    }
    if (grid < 0) return;
    hipMemsetAsync((char*)d_ws + OFF_CTL, 0, CTL_BYTES, stream);
    Args a{};
    for (int i = 0; i < 46; ++i) a.in[i] = (const float*)d_in[i];
    a.out = (float*)d_out; a.ws = (unsigned char*)d_ws; a.ph_lo = 0; a.ph_hi = NPHASE;
    void* kargs[] = {&a};
    hipError_t e = hipLaunchCooperativeKernel((const void*)mega_fwd, dim3(grid), dim3(NWAVES * 64), kargs, LDS_BYTES, stream);
    if (e != hipSuccess) fprintf(stderr, "kernel_launch: cooperative launch failed: %s (grid %d)\n", hipGetErrorString(e), grid);
}
```

```cpp
#include <hip/hip_runtime.h>
#include <hip/hip_cooperative_groups.h>
#include <cstdio>
#include <cstdint>
namespace cg = cooperative_groups;

#define GAS __attribute__((address_space(1)))
#define LAS __attribute__((address_space(3)))
typedef unsigned short bf16;
typedef unsigned v4u __attribute__((ext_vector_type(4)));
typedef unsigned v2u __attribute__((ext_vector_type(2)));
typedef float f32x4 __attribute__((ext_vector_type(4)));
typedef float f32x2 __attribute__((ext_vector_type(2)));
typedef short bf16x8 __attribute__((ext_vector_type(8)));
typedef __bf16 bf16x2_t __attribute__((ext_vector_type(2)));

constexpr int NTOK = 16384, SEQ = 8192, DM = 1024, FF = 2816;
constexpr float EPS = 1e-6f;
constexpr float LOG2E = 1.4426950408889634f;
constexpr float C2_64 = 0.125f * LOG2E;
constexpr float C2_96 = 0.10206207261596575f * LOG2E;
constexpr int NWAVES = 8;

constexpr size_t MiB = 1u << 20, KiB = 1u << 10;
constexpr size_t OFF_CTL = 0, CTL_BYTES = 64 * KiB;
constexpr size_t OFF_SSQ = 1 * MiB;
constexpr size_t OFF_ROPE64C = 2 * MiB, OFF_ROPE64S = 3 * MiB;
constexpr size_t OFF_ROPE32C = 4 * MiB, OFF_ROPE32S = 4 * MiB + 512 * KiB;
constexpr size_t OFF_GATES = 5 * MiB;
constexpr size_t OFF_CBIAS = 6 * MiB + 512 * KiB;
constexpr size_t OFF_SSQCQ = 7 * MiB, OFF_SSQCKV = 7 * MiB + 256 * KiB;
constexpr size_t OFF_SSQKR = 6 * MiB + 768 * KiB;
constexpr size_t OFF_DC2 = 7 * MiB + 512 * KiB;
constexpr size_t OFF_FRAW = 8 * MiB;
constexpr size_t OFF_KR = 8 * MiB + 512 * KiB;
constexpr size_t OFF_WG = 9 * MiB + 512 * KiB;
constexpr size_t OFF_W2K = OFF_WG + 64 * KiB, OFF_W2V = OFF_W2K + 32 * KiB;
constexpr size_t OFF_KCMP = 10 * MiB, OFF_VCMP = 10 * MiB + 256 * KiB;
constexpr size_t OFF_HID = 11 * MiB;
constexpr size_t OFF_WGU = 13 * MiB;
constexpr size_t OFF_WD = 57 * MiB;
constexpr size_t SZ_WGU = 11 * MiB, SZ_WD = 5 * MiB + 512 * KiB;
constexpr size_t OFF_WIN0 = 79 * MiB, OFF_WIN1 = 83 * MiB, OFF_WOUT0 = 87 * MiB, OFF_WOUT1 = 89 * MiB;
constexpr size_t OFF_WQB = 91 * MiB, OFF_WKVB = 91 * MiB + 512 * KiB;
constexpr size_t OFF_W1K = 92 * MiB, OFF_W1V = 93 * MiB;
constexpr size_t OFF_XBA = 94 * MiB, OFF_ACTA = 126 * MiB;
constexpr size_t OFF_XBB = 126 * MiB, OFF_ACTB = 158 * MiB;
constexpr size_t OFF_QO = 126 * MiB;
constexpr size_t OFF_QC = 158 * MiB;
constexpr size_t OFF_OACC = 208 * MiB;
constexpr size_t OFF_KV8 = 174 * MiB;
constexpr size_t SZ_KV = 4 * MiB;
constexpr size_t OFF_QF = 126 * MiB;
constexpr size_t OFF_KF = 146 * MiB;
constexpr size_t OFF_VF = 166 * MiB;
constexpr size_t OFF_QM = 182 * MiB;
constexpr size_t OFF_VM = 206 * MiB;
constexpr size_t OFF_KM = 222 * MiB;
constexpr size_t OFF_CQ = 13 * MiB;
constexpr size_t OFF_CKV = 24 * MiB;
constexpr size_t OFF_O1 = 13 * MiB;
constexpr size_t OFF_QAUG = 246 * MiB;
constexpr size_t WS_END = 256 * MiB;

__device__ __forceinline__ unsigned f2bf(float f) { unsigned u = __builtin_bit_cast(unsigned, f); return (u + 0x7fffu + ((u >> 16) & 1u)) >> 16; }
__device__ __forceinline__ unsigned pk2(float lo, float hi) { f32x2 v = {lo, hi}; bf16x2_t b = __builtin_convertvector(v, bf16x2_t); return __builtin_bit_cast(unsigned, b); }
__device__ __forceinline__ float bflo(unsigned w) { return __builtin_bit_cast(float, w << 16); }
__device__ __forceinline__ float bfhi(unsigned w) { return __builtin_bit_cast(float, w & 0xffff0000u); }
__device__ __forceinline__ float bf2f(bf16 h) { return __builtin_bit_cast(float, (unsigned)h << 16); }
__device__ __forceinline__ float ex2(float x) { return __builtin_amdgcn_exp2f(x); }
__device__ __forceinline__ float rsq(float x) { return __builtin_amdgcn_rsqf(x); }
#define LDS_WAIT() asm volatile("s_waitcnt lgkmcnt(0)" ::: "memory")
#define VM_WAIT() asm volatile("s_waitcnt vmcnt(0)" ::: "memory")

template <int DQK> __device__ __forceinline__ size_t ktile_off(int t, int c) { return (size_t)(t >> 6) * (64 * DQK) + c * 512 + (t & 63) * 8; }
__device__ __forceinline__ size_t vtile_off(int t, int d) { return (size_t)(t >> 6) * 4096 + (d >> 5) * 2048 + (t & 63) * 32 + (d & 31); }
namespace pg8 {
constexpr int BM = 256, BK = 64, HALF = 128, HTB = HALF * BK * 2, STAGE_BYTES = 8 * HTB, NXCD = 8, WGM = 8;
__device__ __forceinline__ int lds_byte(int r, int c) { const int st = (r >> 4) * 2 + (c >> 5), rr = r & 15, cc = c & 31, ob = rr * 64 + cc * 2; return st * 1024 + (ob ^ (((ob >> 9) & 1) << 5)); }
__device__ __forceinline__ void stage_rc(int b, int& R, int& C) { const int st = b / 1024, sb = b % 1024, swz = sb ^ (((sb >> 9) & 1) << 5); R = (st >> 1) * 16 + swz / 64; C = (st & 1) * 32 + (swz % 64) / 2; }
__device__ __forceinline__ int perm32(int rho) { const int n = rho >> 4, i = rho & 15; return 8 * (i >> 2) + 4 * n + (i & 3); }
struct Unit { int pm, pn; };
struct StaticOrder {
    int nM, nN, nwg, G, c;
    __device__ __forceinline__ void init(int M, int N, int G_, int c_) { nM = M / BM; nN = N / BM; nwg = nM * nN; G = G_; c = c_; }
    __device__ __forceinline__ bool next(int i, Unit& u) const {
        const int L = i * G + c; if (L >= nwg) return false;
        int wgid = L; { const int q = nwg / NXCD, r = nwg % NXCD, xcd = wgid % NXCD, off = wgid / NXCD; wgid = (xcd < r ? xcd * (q + 1) : r * (q + 1) + (xcd - r) * q) + off; }
        const int nig = WGM * nN, gid = wgid / nig, fm = gid * WGM, gsz = (nM - fm) < WGM ? (nM - fm) : WGM;
        u.pm = fm + ((wgid % nig) % gsz); u.pn = (wgid % nig) / gsz; return true;
    }
};
}

typedef const float* fptr_t;
typedef LAS fptr_t* InTab;
enum { EPI_GATEUP = 0, EPI_RESID = 1, EPI_L0IN = 2, EPI_L1IN = 3, EPI_QB = 4, EPI_KVB = 5, EPI_CMP1 = 6 };
struct GemmDesc {
    const bf16* A; const bf16* Bt; int M, N, K, lda;
    int ep;
    float* out;
    InTab in;
    unsigned char* ws;
};

__device__ __forceinline__ float row_rstd16(const GAS float* ssq, int r, float inv_n) {
    const f32x4 a = *(const GAS f32x4*)(ssq + (size_t)r * 4);
    return rsq(((a[0] + a[1]) + (a[2] + a[3])) * inv_n + EPS);
}
__device__ __forceinline__ float row_rstd4(const GAS float* ssq, int r, float inv_n) {
    const f32x4 a = *(const GAS f32x4*)(ssq + (size_t)r * 4);
    return rsq(((a[0] + a[1]) + (a[2] + a[3])) * inv_n + EPS);
}
__device__ __forceinline__ float silu_f(float g) { return g * __builtin_amdgcn_rcpf(1.0f + ex2(-g * LOG2E)); }
__device__ __forceinline__ v4u pack8(const f32x4 a, const f32x4 b) { v4u w; w.x = pk2(a[0], a[1]); w.y = pk2(a[2], a[3]); w.z = pk2(b[0], b[1]); w.w = pk2(b[2], b[3]); return w; }

__device__ __forceinline__ void head_norm_rope(f32x4 (&v)[2][2], f32x4 (&w)[2][2], int mode, const GAS float* gain, const GAS float* cosT, const GAS float* sinT, int t, int fq) {
    if (mode == 0) return;
    float ss = 0.f;
#pragma unroll
    for (int bj = 0; bj < 2; ++bj)
#pragma unroll
        for (int n = 0; n < 2; ++n) ss += (v[bj][n][0] * v[bj][n][0] + v[bj][n][1] * v[bj][n][1]) + (v[bj][n][2] * v[bj][n][2] + v[bj][n][3] * v[bj][n][3]);
    ss += __shfl_xor(ss, 16); ss += __shfl_xor(ss, 32);
    const float r = rsq(ss * (1.0f / 64.0f) + EPS);
#pragma unroll
    for (int bj = 0; bj < 2; ++bj)
#pragma unroll
        for (int n = 0; n < 2; ++n) { const f32x4 g = *(const GAS f32x4*)(gain + 32 * bj + 8 * fq + 4 * n); v[bj][n] = v[bj][n] * r * g; }
    if (mode == 2) {
#pragma unroll
        for (int n = 0; n < 2; ++n) {
            const f32x4 c = *(const GAS f32x4*)(cosT + (size_t)t * 32 + 8 * fq + 4 * n), s = *(const GAS f32x4*)(sinT + (size_t)t * 32 + 8 * fq + 4 * n);
            w[0][n] = v[0][n] * c - v[1][n] * s; w[1][n] = v[1][n] * c + v[0][n] * s;
        }
    }
}

template <int EPI> __device__ __forceinline__ void gemm_epilogue(const GemmDesc& g_, const f32x4 (&acc)[2][2][4][2], const pg8::Unit& u, int wr, int wc, int fr, int fq) {
    asm volatile("" : "+v"(fr), "+v"(fq));
    GemmDesc g = g_;
    { unsigned long long w_ = (unsigned long long)g.ws; asm volatile("" : "+s"(w_)); g.ws = (unsigned char*)w_; }
    { unsigned t_ = (unsigned)(uintptr_t)g.in; asm volatile("" : "+s"(t_)); g.in = (InTab)(uintptr_t)t_; }
    const int rbase = u.pm * 256 + wr * 64 + fr;
    if constexpr (EPI == EPI_GATEUP) {
        const int col0 = u.pn * 128 + wc * 32 + 8 * fq;
#pragma unroll
        for (int ai = 0; ai < 2; ++ai)
#pragma unroll
            for (int m = 0; m < 4; ++m) {
                const int r = rbase + ai * 128 + m * 16; const float rs = row_rstd16((const GAS float*)(g.ws + OFF_SSQ), r, 1.0f / 1024.0f);
                const float k1 = -rs * LOG2E, rs2 = rs * rs;
                f32x4 a[2];
#pragma unroll
                for (int n = 0; n < 2; ++n) { const f32x4 ga = acc[ai][0][m][n], ua = acc[ai][1][m][n]; const f32x4 x = ga * k1, gu = ga * ua;
                    const f32x4 rc = {__builtin_amdgcn_rcpf(1.0f + ex2(x[0])), __builtin_amdgcn_rcpf(1.0f + ex2(x[1])), __builtin_amdgcn_rcpf(1.0f + ex2(x[2])), __builtin_amdgcn_rcpf(1.0f + ex2(x[3]))};
                    a[n] = gu * (rc * rs2); }
                *(GAS v4u*)((GAS bf16*)(g.ws + ((g.ep & 1) ? OFF_ACTB : OFF_ACTA)) + (size_t)r * FF + col0) = pack8(a[0], a[1]);
            }
    } else if constexpr (EPI == EPI_RESID) {
        const GAS float* xin32 = (const GAS float*)g.in[0]; GAS float* xout = (GAS float*)g.out;
        const GAS bf16* xsrc = (const GAS bf16*)(g.ws + ((g.ep & 16) ? OFF_XBB : OFF_XBA)); GAS bf16* xb = (GAS bf16*)(g.ws + ((g.ep & 2) ? OFF_XBB : OFF_XBA)); GAS float* ssq_out = (GAS float*)(g.ws + OFF_SSQ);
        const float alpha = (g.ep & 4) ? 1.0f : 0.5f; const bool first = (g.ep & 1) != 0, last = (g.ep & 32) != 0;
        LAS float* red = (LAS float*)((LAS unsigned char*)g.in - 1024 + 2048);
#pragma unroll
        for (int ai = 0; ai < 2; ++ai)
#pragma unroll
            for (int m = 0; m < 4; ++m) {
                const int r = rbase + ai * 128 + m * 16; float ss = 0.f;
#pragma unroll
                for (int bj = 0; bj < 2; ++bj)
#pragma unroll
                    for (int n = 0; n < 2; ++n) {
                        const size_t off = (size_t)r * DM + u.pn * 256 + bj * 128 + wc * 32 + n * 16 + 4 * fq;
                        f32x4 xo;
                        if (first) xo = *(const GAS f32x4*)(xin32 + off);
                        else { const v2u w = *(const GAS v2u*)(xsrc + off); xo = (f32x4){bflo(w.x), bfhi(w.x), bflo(w.y), bfhi(w.y)}; }
                        const f32x4 xn = xo + acc[ai][bj][m][n] * alpha;
                        if (last) *(GAS f32x4*)(xout + off) = xn;
                        else { v2u w; w.x = pk2(xn[0], xn[1]); w.y = pk2(xn[2], xn[3]); *(GAS v2u*)(xb + off) = w;
                            const f32x4 xq = {bflo(w.x), bfhi(w.x), bflo(w.y), bfhi(w.y)};
                            ss += (xq[0] * xq[0] + xq[1] * xq[1]) + (xq[2] * xq[2] + xq[3] * xq[3]); }
                    }
                ss += __shfl_xor(ss, 16); ss += __shfl_xor(ss, 32);
                if (!last && fq == 0) red[(wr * 128 + ai * 64 + m * 16 + fr) * 4 + wc] = ss;
            }
        if (!last) {
            asm volatile("s_waitcnt lgkmcnt(0)\n\ts_barrier" ::: "memory");
            const int tid_ = wr * 256 + wc * 64 + (fq * 16 + fr);
            if (tid_ < 256) { const int rr = tid_; const int wr2 = rr >> 7, rem = rr & 127, ai2 = rem >> 6, m2 = (rem >> 4) & 3, fr2 = rem & 15;
                const f32x4 p = *(const LAS f32x4*)(red + rr * 4);
                ssq_out[(size_t)(u.pm * 256 + wr2 * 64 + ai2 * 128 + m2 * 16 + fr2) * 4 + u.pn] = (p[0] + p[1]) + (p[2] + p[3]); }
            asm volatile("s_waitcnt lgkmcnt(0)\n\ts_barrier" ::: "memory");
        }
    } else if constexpr (EPI == EPI_L0IN) {
        const int pn = u.pn, hh = wc; int mode; const GAS float* gain = nullptr; GAS bf16* dst; GAS bf16* dst2 = nullptr; int tokmajor, pitch, colofs, isv_ = 0; float sc = 1.f;
        GAS unsigned char* ws = (GAS unsigned char*)g.ws;
        if (pn < 2) { mode = 2; gain = (const GAS float*)g.in[8]; dst = (GAS bf16*)(ws + OFF_QO); dst2 = (GAS bf16*)(ws + OFF_QC); tokmajor = 1; pitch = 1024; colofs = (pn * 4 + hh) * 64; sc = C2_64; }
        else if (pn < 4) { mode = 2; gain = (const GAS float*)g.in[18]; dst = (GAS bf16*)(ws + OFF_QO); tokmajor = 1; pitch = 1024; colofs = 512 + ((pn - 2) * 4 + hh) * 64; sc = C2_64; }
        else { const int isv = hh >> 1, hk = hh & 1; const int tens = (pn - 4) * 2 + isv; isv_ = isv;
            dst = (GAS bf16*)(ws + OFF_KV8 + (size_t)tens * SZ_KV) + (size_t)hk * SEQ * 64; tokmajor = 0; pitch = 64; colofs = 0;
            if (isv || pn == 4) mode = 0; else { mode = 2; gain = (const GAS float*)((pn == 5) ? g.in[10] : (pn == 6) ? g.in[11] : g.in[19]); } }
        const GAS float* cosT = (const GAS float*)(ws + OFF_ROPE64C); const GAS float* sinT = (const GAS float*)(ws + OFF_ROPE64S);
#pragma unroll
        for (int ai = 0; ai < 2; ++ai)
#pragma unroll
            for (int m = 0; m < 4; ++m) {
                const int r = rbase + ai * 128 + m * 16; const float rs = row_rstd16((const GAS float*)(g.ws + OFF_SSQ), r, 1.0f / 1024.0f);
                const int t = r & (SEQ - 1), b = r >> 13;
                f32x4 v[2][2], w[2][2];
#pragma unroll
                for (int bj = 0; bj < 2; ++bj)
#pragma unroll
                    for (int n = 0; n < 2; ++n) v[bj][n] = acc[ai][bj][m][n] * rs;
                head_norm_rope(v, w, mode, gain, cosT, sinT, t, fq);
                GAS bf16 *plo, *phi;
                if (tokmajor) { plo = dst + (size_t)r * pitch + colofs + 8 * fq; phi = plo + 32; }
                else if (pn == 4) { plo = dst + ((size_t)b * 2 * SEQ + t) * 64 + 8 * fq; phi = plo + 32; }
                else if (isv_) { GAS bf16* sl = dst + (size_t)b * 2 * SEQ * 64; plo = sl + vtile_off(t, 8 * fq); phi = sl + vtile_off(t, 32 + 8 * fq); }
                else { GAS bf16* sl = dst + (size_t)b * 2 * SEQ * 64; plo = sl + ktile_off<64>(t, fq); phi = sl + ktile_off<64>(t, 4 + fq); }
                if (mode == 2) {
                    *(GAS v4u*)(plo) = pack8(w[0][0] * sc, w[0][1] * sc); *(GAS v4u*)(phi) = pack8(w[1][0] * sc, w[1][1] * sc);
                    if (dst2) { GAS bf16* rp2 = dst2 + (size_t)r * 512 + colofs; *(GAS v4u*)(rp2 + 8 * fq) = pack8(v[0][0] * sc, v[0][1] * sc); *(GAS v4u*)(rp2 + 32 + 8 * fq) = pack8(v[1][0] * sc, v[1][1] * sc); }
                } else {
                    *(GAS v4u*)(plo) = pack8(v[0][0], v[0][1]); *(GAS v4u*)(phi) = pack8(v[1][0], v[1][1]);
                }
            }
    } else if constexpr (EPI == EPI_L1IN) {
        const int pn = u.pn; GAS unsigned char* ws = (GAS unsigned char*)g.ws;
        if (pn < 6) {
            const int hh = wc, h = (pn & 1) * 4 + hh; const int which = pn >> 1;
            const GAS float* gain = (const GAS float*)(which == 0 ? g.in[33] : g.in[34]); const int mode = which == 2 ? 0 : 1; const float sc = which == 0 ? C2_64 : 1.f;
#pragma unroll
            for (int ai = 0; ai < 2; ++ai)
#pragma unroll
                for (int m = 0; m < 4; ++m) {
                    const int r = rbase + ai * 128 + m * 16; const float rs = row_rstd16((const GAS float*)(g.ws + OFF_SSQ), r, 1.0f / 1024.0f);
                    const int t = r & (SEQ - 1), b = r >> 13;
                    f32x4 v[2][2], w[2][2];
#pragma unroll
                    for (int bj = 0; bj < 2; ++bj)
#pragma unroll
                        for (int n = 0; n < 2; ++n) v[bj][n] = acc[ai][bj][m][n] * rs;
                    head_norm_rope(v, w, mode, gain, nullptr, nullptr, t, fq);
                    GAS bf16 *plo, *phi;
                    if (which == 0) { plo = (GAS bf16*)(ws + OFF_QF) + ((size_t)r * 8 + h) * 80 + 8 * fq; phi = plo + 32; }
                    else if (which == 1) { GAS bf16* sl = (GAS bf16*)(ws + OFF_KF) + ((size_t)b * 8 + h) * SEQ * 80; plo = sl + ktile_off<80>(t, fq); phi = sl + ktile_off<80>(t, 4 + fq); }
                    else { GAS bf16* sl = (GAS bf16*)(ws + OFF_VF) + ((size_t)b * 8 + h) * SEQ * 64; plo = sl + vtile_off(t, 8 * fq); phi = sl + vtile_off(t, 32 + 8 * fq); }
                    *(GAS v4u*)(plo) = pack8(v[0][0] * sc, v[0][1] * sc); *(GAS v4u*)(phi) = pack8(v[1][0] * sc, v[1][1] * sc);
                }
        } else {
#pragma unroll
            for (int ai = 0; ai < 2; ++ai)
#pragma unroll
                for (int m = 0; m < 4; ++m) {
                    const int r = rbase + ai * 128 + m * 16; const float rs = row_rstd16((const GAS float*)(g.ws + OFF_SSQ), r, 1.0f / 1024.0f);
                    f32x4 v[2][2];
#pragma unroll
                    for (int bj = 0; bj < 2; ++bj)
#pragma unroll
                        for (int n = 0; n < 2; ++n) v[bj][n] = acc[ai][bj][m][n] * rs;
                    float s0 = 0.f, s1 = 0.f;
#pragma unroll
                    for (int n = 0; n < 2; ++n) { s0 += (v[0][n][0] * v[0][n][0] + v[0][n][1] * v[0][n][1]) + (v[0][n][2] * v[0][n][2] + v[0][n][3] * v[0][n][3]);
                                                  s1 += (v[1][n][0] * v[1][n][0] + v[1][n][1] * v[1][n][1]) + (v[1][n][2] * v[1][n][2] + v[1][n][3] * v[1][n][3]); }
                    if (pn == 6) {
                        GAS bf16* rowp = (GAS bf16*)(ws + OFF_CQ) + (size_t)r * 256 + wc * 32 + 8 * fq;
                        *(GAS v4u*)(rowp) = pack8(v[0][0], v[0][1]); *(GAS v4u*)(rowp + 128) = pack8(v[1][0], v[1][1]);
                        float ss = s0 + s1; ss += __shfl_xor(ss, 16); ss += __shfl_xor(ss, 32);
                        if (fq == 0) ((GAS float*)(ws + OFF_SSQCQ))[(size_t)r * 4 + wc] = ss;
                    } else {
                        GAS bf16* rowp = (GAS bf16*)(ws + OFF_CKV) + (size_t)r * 128 + wc * 32 + 8 * fq;
                        *(GAS v4u*)(rowp) = pack8(v[0][0], v[0][1]);
                        float ss = s0; ss += __shfl_xor(ss, 16); ss += __shfl_xor(ss, 32);
                        if (fq == 0) ((GAS float*)(ws + OFF_SSQCKV))[(size_t)r * 4 + wc] = ss;
                        if (wc == 0) { *(GAS v4u*)((GAS bf16*)(ws + OFF_KR) + (size_t)r * 32 + 8 * fq) = pack8(v[1][0], v[1][1]);
                            float sr = s1; sr += __shfl_xor(sr, 16); sr += __shfl_xor(sr, 32); if (fq == 0) ((GAS float*)(ws + OFF_SSQKR))[r] = sr; }
                        if (wc == 1 && fq == 0) { GAS float* fp = (GAS float*)(ws + OFF_FRAW) + (size_t)(r >> 13) * 8 * SEQ + (r & (SEQ - 1));
#pragma unroll
                            for (int hh2 = 0; hh2 < 4; ++hh2) { fp[(size_t)hh2 * SEQ] = v[1][0][hh2]; fp[(size_t)(4 + hh2) * SEQ] = v[1][1][hh2]; } }
                    }
                }
        }
    } else if constexpr (EPI == EPI_QB) {
        GAS unsigned char* ws = (GAS unsigned char*)g.ws;
#pragma unroll
        for (int ai = 0; ai < 2; ++ai)
#pragma unroll
            for (int m = 0; m < 4; ++m) {
                const int r = rbase + ai * 128 + m * 16; const float rs = row_rstd4((const GAS float*)(ws + OFF_SSQCQ), r, 1.0f / 256.0f);
                GAS bf16* rowp = (GAS bf16*)(ws + OFF_QM) + (size_t)r * 768 + u.pn * 256 + wc * 32 + 8 * fq;
                *(GAS v4u*)(rowp) = pack8(acc[ai][0][m][0] * rs, acc[ai][0][m][1] * rs); *(GAS v4u*)(rowp + 128) = pack8(acc[ai][1][m][0] * rs, acc[ai][1][m][1] * rs);
            }
    } else if constexpr (EPI == EPI_KVB) {
        GAS unsigned char* ws = (GAS unsigned char*)g.ws; const int h = u.pn * 2 + (wc & 1); const bool isv = wc >= 2;
        const GAS float* gk = (const GAS float*)g.in[40]; const GAS float* c32 = (const GAS float*)(ws + OFF_ROPE32C); const GAS float* s32 = (const GAS float*)(ws + OFF_ROPE32S);
#pragma unroll
        for (int ai = 0; ai < 2; ++ai)
#pragma unroll
            for (int m = 0; m < 4; ++m) {
                const int r = rbase + ai * 128 + m * 16; const float rs = row_rstd4((const GAS float*)(ws + OFF_SSQCKV), r, 1.0f / 128.0f);
                const int t = r & (SEQ - 1), b = r >> 13;
                f32x4 v[2][2];
#pragma unroll
                for (int bj = 0; bj < 2; ++bj)
#pragma unroll
                    for (int n = 0; n < 2; ++n) v[bj][n] = acc[ai][bj][m][n] * rs;
                if (isv) {
                    GAS bf16* sl = (GAS bf16*)(ws + OFF_VM) + ((size_t)b * 8 + h) * SEQ * 64;
                    *(GAS v4u*)(sl + vtile_off(t, 8 * fq)) = pack8(v[0][0], v[0][1]); *(GAS v4u*)(sl + vtile_off(t, 32 + 8 * fq)) = pack8(v[1][0], v[1][1]);
                } else {
                    float ss = 0.f;
#pragma unroll
                    for (int bj = 0; bj < 2; ++bj)
#pragma unroll
                        for (int n = 0; n < 2; ++n) ss += (v[bj][n][0] * v[bj][n][0] + v[bj][n][1] * v[bj][n][1]) + (v[bj][n][2] * v[bj][n][2] + v[bj][n][3] * v[bj][n][3]);
                    ss += __shfl_xor(ss, 16); ss += __shfl_xor(ss, 32);
                    const float rn = rsq((ss + ((const GAS float*)(ws + OFF_SSQKR))[r]) * (1.0f / 96.0f) + EPS);
                    GAS bf16* sl = (GAS bf16*)(ws + OFF_KM) + ((size_t)b * 8 + h) * SEQ * 96;
#pragma unroll
                    for (int bj = 0; bj < 2; ++bj) { const f32x4 g0 = *(const GAS f32x4*)(gk + 32 * bj + 8 * fq), g1 = *(const GAS f32x4*)(gk + 32 * bj + 8 * fq + 4);
                        *(GAS v4u*)(sl + ktile_off<96>(t, 4 * bj + fq)) = pack8(v[bj][0] * rn * g0, v[bj][1] * rn * g1); }
                    if (fq < 2) {
                        const GAS bf16* kr = (const GAS bf16*)(ws + OFF_KR) + (size_t)r * 32; const v4u wa = *(const GAS v4u*)(kr + 8 * fq), wb = *(const GAS v4u*)(kr + 16 + 8 * fq);
                        const f32x4 a0 = {bflo(wa.x), bfhi(wa.x), bflo(wa.y), bfhi(wa.y)}, a1 = {bflo(wa.z), bfhi(wa.z), bflo(wa.w), bfhi(wa.w)};
                        const f32x4 b0 = {bflo(wb.x), bfhi(wb.x), bflo(wb.y), bfhi(wb.y)}, b1 = {bflo(wb.z), bfhi(wb.z), bflo(wb.w), bfhi(wb.w)};
                        const f32x4 ga0 = *(const GAS f32x4*)(gk + 64 + 8 * fq), ga1 = *(const GAS f32x4*)(gk + 68 + 8 * fq), gb0 = *(const GAS f32x4*)(gk + 80 + 8 * fq), gb1 = *(const GAS f32x4*)(gk + 84 + 8 * fq);
                        const f32x4 c0 = *(const GAS f32x4*)(c32 + (size_t)t * 16 + 8 * fq), c1 = *(const GAS f32x4*)(c32 + (size_t)t * 16 + 8 * fq + 4), s0 = *(const GAS f32x4*)(s32 + (size_t)t * 16 + 8 * fq), s1 = *(const GAS f32x4*)(s32 + (size_t)t * 16 + 8 * fq + 4);
                        const f32x4 xa0 = a0 * rn * ga0, xa1 = a1 * rn * ga1, xb0 = b0 * rn * gb0, xb1 = b1 * rn * gb1;
                        *(GAS v4u*)(sl + ktile_off<96>(t, 8 + fq)) = pack8(xa0 * c0 - xb0 * s0, xa1 * c1 - xb1 * s1);
                        *(GAS v4u*)(sl + ktile_off<96>(t, 10 + fq)) = pack8(xb0 * c0 + xa0 * s0, xb1 * c1 + xa1 * s1);
                    }
                }
            }
    } else {
        const GAS float* bias = (const GAS float*)(g.ws + OFF_CBIAS) + g.ep * 256; GAS bf16* o0 = (GAS bf16*)(g.ws + OFF_HID) + (size_t)g.ep * 2048 * 256;
#pragma unroll
        for (int bj = 0; bj < 2; ++bj) {
            const int col0 = bj * 128 + wc * 32 + 8 * fq; const f32x4 b0 = *(const GAS f32x4*)(bias + col0), b1 = *(const GAS f32x4*)(bias + col0 + 4);
#pragma unroll
            for (int ai = 0; ai < 2; ++ai)
#pragma unroll
                for (int m = 0; m < 4; ++m) {
                    const int r = rbase + ai * 128 + m * 16; const f32x4 x0 = acc[ai][bj][m][0] + b0, x1 = acc[ai][bj][m][1] + b1;
                    const f32x4 y0 = {silu_f(x0[0]), silu_f(x0[1]), silu_f(x0[2]), silu_f(x0[3])}, y1 = {silu_f(x1[0]), silu_f(x1[1]), silu_f(x1[2]), silu_f(x1[3])};
                    *(GAS v4u*)(o0 + (size_t)r * 256 + col0) = pack8(y0, y1);
                }
        }
    }
}

template <int EPI> __device__ __forceinline__ void gemm_phase(LAS unsigned char* lds, const GemmDesc& g, int G, int cblk) {
    constexpr bool PERM = (EPI != EPI_RESID);
    using namespace pg8;
    int tid = threadIdx.x; asm volatile("" : "+v"(tid));
    const int wid = __builtin_amdgcn_readfirstlane(tid >> 6), lane = tid & 63, wr = wid >> 2, wc = wid & 3, fr = lane & 15, fq = lane >> 4;
    const int K = g.K, nt = K / BK, lda = g.lda;
    StaticOrder S; S.init(g.M, g.N, G, cblk);
    unsigned voffA[2], voffB[2];
#pragma unroll
    for (int i = 0; i < 2; ++i) { int R, C; stage_rc(tid * 16 + i * 8192, R, C); const int Rb = PERM ? ((R & ~31) + perm32(R & 31)) : R;
        voffA[i] = (unsigned)(R * lda + C) * 2u; voffB[i] = (unsigned)(Rb * K + C) * 2u; }
    const size_t kstep = (size_t)(BK * 2);
    const size_t hstepA = (size_t)HALF * lda * 2, hstepB = (size_t)HALF * K * 2;
    const size_t tstepA = 2 * hstepA, tstepB = 2 * hstepB;
    const unsigned ldsw = (unsigned)wid * 1024u;
    const int aoff = lds_byte(wr * 64 + fr, fq * 8), boff = lds_byte(wc * 32 + fr, fq * 8);
#define PG8_SA(b, h) (((b) * 2 + (h)) * HTB)
#define PG8_SB(b, h) ((4 + (b) * 2 + (h)) * HTB)
#define PG8_STAGE(bufoff, gbase, voff) do { _Pragma("unroll") for (int _i = 0; _i < 2; ++_i) \
        __builtin_amdgcn_global_load_lds((const unsigned*)((const char*)(gbase) + (voff)[_i]), (LAS unsigned*)(lds + (bufoff) + ldsw + _i * 8192), 16, 0, 0); } while (0)
#define PG8_LDA(dst, b, h) do { _Pragma("unroll") for (int m = 0; m < 4; ++m) _Pragma("unroll") for (int k = 0; k < 2; ++k) dst[m][k] = *(const LAS bf16x8*)(lds + PG8_SA(b, h) + aoff + m * 2048 + k * 1024); } while (0)
#define PG8_LDB(dst, b, h) do { _Pragma("unroll") for (int n = 0; n < 2; ++n) _Pragma("unroll") for (int k = 0; k < 2; ++k) dst[n][k] = *(const LAS bf16x8*)(lds + PG8_SB(b, h) + boff + n * 2048 + k * 1024); } while (0)
#define PG8_MMA(ai, bj, At, Bt) do { __builtin_amdgcn_s_setprio(1); _Pragma("unroll") for (int m = 0; m < 4; ++m) _Pragma("unroll") for (int n = 0; n < 2; ++n) _Pragma("unroll") for (int k = 0; k < 2; ++k) \
        acc[ai][bj][m][n] = __builtin_amdgcn_mfma_f32_16x16x32_bf16(Bt[n][k], At[m][k], acc[ai][bj][m][n], 0, 0, 0); __builtin_amdgcn_s_setprio(0); } while (0)
#define PG8_WAIT_V(n) asm volatile("s_waitcnt vmcnt(" #n ")" ::: "memory")
#define PG8_WAIT_L(n) asm volatile("s_waitcnt lgkmcnt(" #n ")" ::: "memory")
#define PG8_BAR __builtin_amdgcn_s_barrier()
#define PG8_SCHED __builtin_amdgcn_sched_barrier(0)
    Unit cur, nxt; int ui = 0;
    if (!S.next(0, cur)) return;
    f32x4 acc[2][2][4][2];
#pragma unroll
    for (int a = 0; a < 2; ++a)
#pragma unroll
        for (int b = 0; b < 2; ++b)
#pragma unroll
            for (int m = 0; m < 4; ++m)
#pragma unroll
                for (int n = 0; n < 2; ++n) acc[a][b][m][n] = (f32x4){0.f, 0.f, 0.f, 0.f};
    bf16x8 At[4][2], B0[2][2], B1[2][2];
    const char* cA = (const char*)g.A + (size_t)cur.pm * tstepA; const char* cB = (const char*)g.Bt + (size_t)cur.pn * tstepB;
    PG8_STAGE(PG8_SB(0, 0), cB, voffB); PG8_STAGE(PG8_SB(0, 1), cB + hstepB, voffB); PG8_STAGE(PG8_SA(0, 0), cA, voffA); PG8_STAGE(PG8_SA(0, 1), cA + hstepA, voffA);
    if (wr == 1) PG8_BAR;
    PG8_WAIT_V(2); PG8_BAR;
    PG8_STAGE(PG8_SB(1, 0), cB + kstep, voffB); PG8_STAGE(PG8_SA(1, 0), cA + kstep, voffA); PG8_STAGE(PG8_SB(1, 1), cB + hstepB + kstep, voffB);
    PG8_WAIT_V(6); PG8_BAR;
    for (;;) {
        const bool has_next = S.next(ui + 1, nxt);
        const char* nA = has_next ? (const char*)g.A + (size_t)nxt.pm * tstepA : cA; const char* nB = has_next ? (const char*)g.Bt + (size_t)nxt.pn * tstepB : cB;
        for (int t = 0; t < nt; t += 2) {
            const bool last = (t == nt - 2);
            const char* a1 = cA + (size_t)(t + 1) * kstep;
            const char* a2 = last ? nA : cA + (size_t)(t + 2) * kstep; const char* b2 = last ? nB : cB + (size_t)(t + 2) * kstep;
            const char* a3 = a2 + kstep; const char* b3 = b2 + kstep;
            PG8_LDB(B0, 0, 0); PG8_LDB(B1, 0, 1); PG8_SCHED; PG8_LDA(At, 0, 0); PG8_STAGE(PG8_SA(1, 1), a1 + hstepA, voffA);
            PG8_WAIT_V(8); PG8_WAIT_L(0); PG8_BAR; PG8_MMA(0, 0, At, B0); PG8_MMA(0, 1, At, B1); PG8_BAR; PG8_SCHED;
            PG8_LDA(At, 0, 1); PG8_STAGE(PG8_SB(0, 0), b2, voffB); PG8_STAGE(PG8_SB(0, 1), b2 + hstepB, voffB); PG8_STAGE(PG8_SA(0, 0), a2, voffA);
            PG8_WAIT_V(8); PG8_WAIT_L(0); PG8_BAR; PG8_MMA(1, 0, At, B0); PG8_MMA(1, 1, At, B1); PG8_BAR; PG8_SCHED;
            PG8_LDB(B0, 1, 0); PG8_LDB(B1, 1, 1); PG8_SCHED; PG8_LDA(At, 1, 0); PG8_STAGE(PG8_SA(0, 1), a2 + hstepA, voffA);
            PG8_WAIT_V(8); PG8_WAIT_L(0); PG8_BAR; PG8_MMA(0, 0, At, B0); PG8_MMA(0, 1, At, B1); PG8_BAR; PG8_SCHED;
            PG8_LDA(At, 1, 1); PG8_STAGE(PG8_SB(1, 0), b3, voffB); PG8_STAGE(PG8_SB(1, 1), b3 + hstepB, voffB); PG8_STAGE(PG8_SA(1, 0), a3, voffA);
            PG8_WAIT_V(8); PG8_WAIT_L(0); PG8_BAR; PG8_MMA(1, 0, At, B0); PG8_MMA(1, 1, At, B1); PG8_BAR; PG8_SCHED;
        }
        if (wr == 0) PG8_BAR;
        gemm_epilogue<EPI>(g, acc, cur, wr, wc, fr, fq);
        if (!has_next) break;
#pragma unroll
        for (int a = 0; a < 2; ++a)
#pragma unroll
            for (int b = 0; b < 2; ++b)
#pragma unroll
                for (int m = 0; m < 4; ++m)
#pragma unroll
                    for (int n = 0; n < 2; ++n) acc[a][b][m][n] = (f32x4){0.f, 0.f, 0.f, 0.f};
        cur = nxt; cA = nA; cB = nB; ++ui;
        if (wr == 1) PG8_BAR;
    }
    PG8_WAIT_V(0);
    PG8_BAR;
#undef PG8_SA
#undef PG8_SB
#undef PG8_STAGE
#undef PG8_LDA
#undef PG8_LDB
#undef PG8_MMA
#undef PG8_WAIT_V
#undef PG8_WAIT_L
#undef PG8_BAR
#undef PG8_SCHED
}

#define XB_TMO      128
#define XB_XCNT(j)  (256  + 64 * (j))
#define XB_XSUB(j)  (1280 + 64 * (j))
#define XB_XGEN(j)  (2304 + 64 * (j))
#define XB_TOP      3328
#define XB_TOPGEN   3392
#define XCD_BAR_WORDS 3456
#define XB_SPIN_CAP (1u << 23)
__device__ __forceinline__ unsigned xb_ld(unsigned* p)              { return __hip_atomic_load(p, __ATOMIC_RELAXED, __HIP_MEMORY_SCOPE_AGENT); }
__device__ __forceinline__ unsigned xb_add(unsigned* p, unsigned v) { return __hip_atomic_fetch_add(p, v, __ATOMIC_RELAXED, __HIP_MEMORY_SCOPE_AGENT); }
__device__ __forceinline__ unsigned xb_xcc_id() { return (unsigned)__builtin_amdgcn_s_getreg((3 << 11) | 20) & 0xFu; }
#define XB_SPIN(cond, bar) do { unsigned _sp = 0; while (cond) { __builtin_amdgcn_s_sleep(1); \
    if ((++_sp & 255u) == 0u) { if (xb_ld(&(bar)[XB_TMO])) break; if (_sp > XB_SPIN_CAP) { atomicAdd(&(bar)[XB_TMO], 1u); break; } } } } while (0)
struct XcdBarrier { unsigned* bar; unsigned x; volatile LAS unsigned* st; };
__device__ __forceinline__ XcdBarrier xcd_barrier_post(unsigned* bar, volatile LAS unsigned* st) {
    XcdBarrier b; b.bar = bar; b.x = xb_xcc_id(); b.st = st;
    if (threadIdx.x == 0) st[2] = xb_add(&bar[XB_XCNT(b.x)], 1u);
    return b;
}
__device__ __forceinline__ void xcd_barrier_complete(unsigned* bar, unsigned x, unsigned& nloc, unsigned& nx) {
    const unsigned G = gridDim.x * gridDim.y * gridDim.z;
    unsigned sum, cnt, mine, sp = 0u;
    for (;;) {
        sum = 0u; cnt = 0u; mine = 0u;
#pragma unroll
        for (unsigned j = 0; j < 16; ++j) { const unsigned c = xb_ld(&bar[XB_XCNT(j)]); sum += c; cnt += (c > 0u) ? 1u : 0u; mine = (j == x) ? c : mine; }
        if (sum == G) break;
        __builtin_amdgcn_s_sleep(1);
        if ((++sp & 255u) == 0u) { if (xb_ld(&bar[XB_TMO])) break; if (sp > XB_SPIN_CAP) { atomicAdd(&bar[XB_TMO], 1u); break; } }
    }
    nloc = mine > 0u ? mine : 1u; nx = cnt > 0u ? cnt : 1u;
}
__device__ __forceinline__ void xcd_barrier(const XcdBarrier& b, bool global = true) {
    asm volatile("s_waitcnt vmcnt(0)" ::: "memory");
    __syncthreads();
    if (threadIdx.x == 0) {
        unsigned* bar = b.bar;
        __builtin_amdgcn_s_waitcnt(0);
        unsigned nloc = b.st[0], nx = b.st[1];
        if (nloc == 0u) { xcd_barrier_complete(bar, b.x, nloc, nx); b.st[0] = nloc; b.st[1] = nx; }
        const unsigned old = xb_add(&bar[XB_XSUB(b.x)], 1u);
        const unsigned gen = old / nloc;
        if (!global) {
            if (old + 1u == (gen + 1u) * nloc) xb_add(&bar[XB_XGEN(b.x)], 1u);
            else XB_SPIN(xb_ld(&bar[XB_XGEN(b.x)]) == gen, bar);
            __builtin_amdgcn_fence(__ATOMIC_ACQUIRE, "agent");
            asm volatile("s_waitcnt vmcnt(0)" ::: "memory");
        } else if (old + 1u == (gen + 1u) * nloc) {
            __builtin_amdgcn_fence(__ATOMIC_RELEASE, "agent");
            asm volatile("s_waitcnt vmcnt(0)" ::: "memory");
            const unsigned og = xb_add(&bar[XB_TOP], 1u);
            const unsigned tg = og / nx;
            if (og + 1u == (tg + 1u) * nx) xb_add(&bar[XB_TOPGEN], 1u);
            else XB_SPIN(xb_ld(&bar[XB_TOPGEN]) == tg, bar);
            __builtin_amdgcn_fence(__ATOMIC_ACQUIRE, "agent");
            xb_add(&bar[XB_XGEN(b.x)], 1u);
            asm volatile("s_waitcnt vmcnt(0)" ::: "memory");
        } else {
            XB_SPIN(xb_ld(&bar[XB_XGEN(b.x)]) == gen, bar);
            __builtin_amdgcn_fence(__ATOMIC_ACQUIRE, "agent");
            asm volatile("s_waitcnt vmcnt(0)" ::: "memory");
        }
    }
    __syncthreads();
}

struct Frame {
    LAS unsigned char* lds; int tid, lane, wave, vcu, G;
    InTab in; float* out; unsigned char* ws;
};

__device__ __forceinline__ float wave_sum(float v) {
#pragma unroll
    for (int o = 1; o < 64; o <<= 1) v += __shfl_xor(v, o);
    return v;
}

enum { MAP_IDENT = 0, MAP_L0IN = 1, MAP_L1IN = 2, MAP_GATE0 = 3, MAP_GU = 4, MAP_KVB = 5 };
__device__ __forceinline__ int map_src(int kind, int n, int nsrc) {
    if (kind == MAP_IDENT) return n < nsrc ? n : -1;
    if (kind == MAP_GATE0) return n < 24 ? 1280 + n : -1;
    if (kind == MAP_GU) { const int tile = n >> 8, w = n & 127; return tile * 128 + w; }
    const int pn = n >> 8, slot = n & 255;
    const int hh = (slot >> 5) & 3, d = 32 * (slot >> 7) + (slot & 31), L = pn * 256 + hh * 64 + d;
    if (kind == MAP_KVB) return (2 * pn + (hh & 1)) * 128 + (hh >> 1) * 64 + d;
    if (kind == MAP_L0IN) {
        if (L < 512) return L;
        if (L < 1024) return 1304 + (L - 512);
        if (L < 1792) return 512 + (L - 1024);
        return 1816 + (L - 1792);
    }
    if (pn < 6) return L;
    if (pn == 6) return 1544 + slot;
    if (slot < 128) return 1800 + slot;
    if (slot < 160) return 1928 + (slot - 128);
    if (slot < 168) return 1536 + (slot - 160);
    return -1;
}
struct WDesc { const float* src; const float* src2; int K, nsrc, ndst; bf16* dst; const float* gain; int kind; };
__device__ __forceinline__ void conv_load(const WDesc& w, int item, int lane, f32x4 (&v)[8], float (&g)[8]) {
    const int nblk = w.ndst / 32, kb = item / nblk, nb = item % nblk, k0 = 64 * kb, n0 = 32 * nb;
    const int nq = 4 * (lane & 7), kr = lane >> 3; const int sc = map_src(w.kind, n0 + nq, w.nsrc);
    const float* src = (w.kind == MAP_GU && (n0 & 128)) ? w.src2 : w.src;
#pragma unroll
    for (int i = 0; i < 8; ++i) { const int kk = 8 * i + kr; v[i] = (f32x4){0.f, 0.f, 0.f, 0.f}; if (sc >= 0) v[i] = *(const f32x4*)(src + (size_t)(k0 + kk) * w.nsrc + sc); }
#pragma unroll
    for (int i = 0; i < 8; ++i) { g[i] = 1.f; if (w.gain) g[i] = w.gain[k0 + 8 * i + kr]; }
}
__device__ __forceinline__ void conv_finish(const WDesc& w, LAS float* scr, int item, int lane, const f32x4 (&v)[8], const float (&g)[8]) {
    const int nblk = w.ndst / 32, kb = item / nblk, nb = item % nblk, k0 = 64 * kb, n0 = 32 * nb;
    const int nq = 4 * (lane & 7), kr = lane >> 3;
#pragma unroll
    for (int i = 0; i < 8; ++i) { const int kk = 8 * i + kr; const float gsc = g[i];
        LAS float* d = scr + kk * 33 + nq; d[0] = v[i][0] * gsc; d[1] = v[i][1] * gsc; d[2] = v[i][2] * gsc; d[3] = v[i][3] * gsc; }
    LDS_WAIT(); asm volatile("" ::: "memory");
    const int c = lane & 7;
#pragma unroll
    for (int j = 0; j < 4; ++j) { const int nn = (lane >> 3) + 8 * j; const LAS float* s = scr + (8 * c) * 33 + nn;
        v4u o; o.x = pk2(s[0 * 33], s[1 * 33]); o.y = pk2(s[2 * 33], s[3 * 33]); o.z = pk2(s[4 * 33], s[5 * 33]); o.w = pk2(s[6 * 33], s[7 * 33]);
        *(v4u*)(w.dst + (size_t)(n0 + nn) * w.K + k0 + 8 * c) = o; }
    LDS_WAIT(); asm volatile("" ::: "memory");
}
constexpr int NMAT = 19;
__device__ __forceinline__ WDesc get_wdesc(const Frame& F, int id) {
    WDesc w; w.src2 = nullptr; w.gain = nullptr; w.kind = MAP_IDENT;
    InTab in = F.in; unsigned char* ws = F.ws;
    if (id < 4) { const int nb = id == 0 ? 1 : id == 1 ? 22 : id == 2 ? 26 : 42;
        w.src = in[nb + 1]; w.src2 = in[nb + 2]; w.gain = in[nb]; w.K = 1024; w.nsrc = FF; w.ndst = 2 * FF; w.dst = (bf16*)(ws + OFF_WGU + id * SZ_WGU); w.kind = MAP_GU; }
    else if (id < 8) { const int f = id - 4; const int nb = f == 0 ? 1 : f == 1 ? 22 : f == 2 ? 26 : 42;
        w.src = in[nb + 3]; w.K = FF; w.nsrc = 1024; w.ndst = 1024; w.dst = (bf16*)(ws + OFF_WD + f * SZ_WD); }
    else if (id == 8) { w.src = in[6]; w.gain = in[5]; w.K = 1024; w.nsrc = 2072; w.ndst = 2048; w.dst = (bf16*)(ws + OFF_WIN0); w.kind = MAP_L0IN; }
    else if (id == 9) { w.src = in[6]; w.gain = in[5]; w.K = 1024; w.nsrc = 2072; w.ndst = 32; w.dst = (bf16*)(ws + OFF_WG); w.kind = MAP_GATE0; }
    else if (id == 10) { w.src = in[21]; w.K = 1024; w.nsrc = 1024; w.ndst = 1024; w.dst = (bf16*)(ws + OFF_WOUT0); }
    else if (id == 11) { w.src = in[31]; w.gain = in[30]; w.K = 1024; w.nsrc = 1960; w.ndst = 2048; w.dst = (bf16*)(ws + OFF_WIN1); w.kind = MAP_L1IN; }
    else if (id == 12) { w.src = in[41]; w.K = 1024; w.nsrc = 1024; w.ndst = 1024; w.dst = (bf16*)(ws + OFF_WOUT1); }
    else if (id == 13) { w.src = in[36]; w.gain = in[35]; w.K = 256; w.nsrc = 768; w.ndst = 768; w.dst = (bf16*)(ws + OFF_WQB); }
    else if (id == 14) { w.src = in[38]; w.gain = in[37]; w.K = 128; w.nsrc = 1024; w.ndst = 1024; w.dst = (bf16*)(ws + OFF_WKVB); w.kind = MAP_KVB; }
    else if (id == 15) { w.src = in[14]; w.K = 2048; w.nsrc = 256; w.ndst = 256; w.dst = (bf16*)(ws + OFF_W1K); }
    else if (id == 16) { w.src = in[16]; w.K = 2048; w.nsrc = 256; w.ndst = 256; w.dst = (bf16*)(ws + OFF_W1V); }
    else if (id == 17) { w.src = in[15]; w.K = 256; w.nsrc = 64; w.ndst = 64; w.dst = (bf16*)(ws + OFF_W2K); }
    else { w.src = in[17]; w.K = 256; w.nsrc = 64; w.ndst = 64; w.dst = (bf16*)(ws + OFF_W2V); }
    return w;
}
__device__ __forceinline__ void convert_mats(Frame& F, unsigned mask, int gw, int NGW) {
    LAS float* scr = (LAS float*)(F.lds + F.wave * 16384);
    int base = 0;
    for (int id = 0; id < NMAT; ++id) {
        if (!((mask >> id) & 1u)) continue;
        const WDesc w = get_wdesc(F, id); const int nit = (w.K / 64) * (w.ndst / 32);
        int first = (gw - base) % NGW; if (first < 0) first += NGW;
        if (first < nit) { f32x4 va[8], vb[8]; float ga[8], gb[8]; conv_load(w, first, F.lane, va, ga);
            for (int it = first; it < nit; it += 2 * NGW) {
                if (it + NGW < nit) conv_load(w, it + NGW, F.lane, vb, gb);
                conv_finish(w, scr, it, F.lane, va, ga);
                if (it + NGW < nit) { if (it + 2 * NGW < nit) conv_load(w, it + 2 * NGW, F.lane, va, ga); conv_finish(w, scr, it + NGW, F.lane, vb, gb); }
            } }
        base = (base + nit) % NGW;
    }
}
constexpr unsigned MATS_P0 = (1u << 0) | (1u << 4) | (1u << 8);
constexpr unsigned MATS_P1 = (1u << 9) | (1u << 10) | (1u << 15) | (1u << 16) | (1u << 17) | (1u << 18);
constexpr unsigned MATS_P4 = (1u << 1) | (1u << 5) | (1u << 2) | (1u << 3) | (1u << 6) | (1u << 7) | (1u << 11) | (1u << 12) | (1u << 13) | (1u << 14);
constexpr unsigned MATS_P7 = 0u;
static_assert((MATS_P0 | MATS_P1 | MATS_P4 | MATS_P7) == (1u << NMAT) - 1u && (MATS_P0 & MATS_P1) == 0 && ((MATS_P0 | MATS_P1) & MATS_P4) == 0 && ((MATS_P0 | MATS_P1 | MATS_P4) & MATS_P7) == 0, "every matrix converted exactly once");
__device__ __forceinline__ void p0_prologue(Frame& F) {
    const int gw = F.vcu * NWAVES + F.wave, NGW = F.G * NWAVES;
    convert_mats(F, MATS_P0, gw, NGW);
    { const float* x = F.in[0]; bf16* xb = (bf16*)(F.ws + OFF_XBA); float* ssq = (float*)(F.ws + OFF_SSQ);
      for (int m0 = gw; m0 < NTOK; m0 += 8 * NGW) {
        f32x4 v[8][4];
#pragma unroll
        for (int q = 0; q < 8; ++q) { const int m = m0 + q * NGW; if (m < NTOK) { const f32x4* xr = (const f32x4*)(x + (size_t)m * DM) + F.lane;
#pragma unroll
            for (int j = 0; j < 4; ++j) v[q][j] = xr[64 * j]; } }
#pragma unroll
        for (int q = 0; q < 8; ++q) { const int m = m0 + q * NGW; if (m < NTOK) { float s = 0.f; v2u* o8 = (v2u*)(xb + (size_t)m * DM) + F.lane;
#pragma unroll
            for (int j = 0; j < 4; ++j) { const f32x4 t = v[q][j]; s += (t[0] * t[0] + t[1] * t[1]) + (t[2] * t[2] + t[3] * t[3]); v2u w; w.x = pk2(t[0], t[1]); w.y = pk2(t[2], t[3]); o8[64 * j] = w; }
            s = wave_sum(s);
            if (F.lane < 4) ssq[(size_t)m * 4 + F.lane] = F.lane == 0 ? s : 0.f; } }
      } }
    { float* c64 = (float*)(F.ws + OFF_ROPE64C); float* s64 = (float*)(F.ws + OFF_ROPE64S); float* c32 = (float*)(F.ws + OFF_ROPE32C); float* s32 = (float*)(F.ws + OFF_ROPE32S);
      const int gt = F.vcu * 512 + F.tid, NT = F.G * 512;
      for (int e = gt; e < SEQ * 32; e += NT) { const int t = e >> 5, i = e & 31; const float inv = 1.0f / powf(10000.0f, (float)(2 * i) / 64.0f); const float ang = (float)t * inv; c64[e] = cosf(ang); s64[e] = sinf(ang); }
      for (int e = gt; e < SEQ * 16; e += NT) { const int t = e >> 4, i = e & 15; const float inv = 1.0f / powf(10000.0f, (float)(2 * i) / 32.0f); const float ang = (float)t * inv; c32[e] = cosf(ang); s32[e] = sinf(ang); } }
    if (F.vcu < 256) {
        __syncthreads();
        const int oi = 2 * F.vcu + (F.tid >> 8), kv = oi >> 8, n = oi & 255, kc = F.tid & 255; const float* pos = F.in[kv ? 13 : 12]; const float* w1 = F.in[kv ? 16 : 14];
        float s = 0.f;
#pragma unroll
        for (int k = 0; k < 8; ++k) s += pos[kc * 8 + k] * w1[(size_t)(kc * 8 + k) * 256 + n];
        s = wave_sum(s);
        LAS float* red = (LAS float*)(F.lds);
        if (F.lane == 0) red[F.wave] = s;
        __syncthreads();
        if (F.tid < 2) ((float*)(F.ws + OFF_CBIAS))[2 * F.vcu + F.tid] = (red[4 * F.tid] + red[4 * F.tid + 1]) + (red[4 * F.tid + 2] + red[4 * F.tid + 3]);
        __syncthreads();
    }
}

__device__ __forceinline__ void gates_phase(Frame& F, int gw, int NGW) {
    const int lane = F.lane, fr = lane & 15, fq = lane >> 4;
    const bf16* xb = (const bf16*)(F.ws + OFF_XBA); const bf16* wg = (const bf16*)(F.ws + OFF_WG); const GAS float* ssq = (const GAS float*)(F.ws + OFF_SSQ);
    float* gates = (float*)(F.ws + OFF_GATES); const float* gb = F.in[7];
    for (int task = gw; task < NTOK / 16; task += NGW) {
        const int r0 = task * 16; f32x4 acc0 = {0.f, 0.f, 0.f, 0.f}, acc1 = {0.f, 0.f, 0.f, 0.f};
        const bf16* ap = xb + (size_t)(r0 + fr) * DM + 8 * fq; const bf16* bp0 = wg + (size_t)fr * DM + 8 * fq; const bf16* bp1 = wg + (size_t)(16 + fr) * DM + 8 * fq;
#pragma unroll 8
        for (int k = 0; k < DM; k += 32) {
            const bf16x8 a = *(const bf16x8*)(ap + k), b0 = *(const bf16x8*)(bp0 + k), b1 = *(const bf16x8*)(bp1 + k);
            acc0 = __builtin_amdgcn_mfma_f32_16x16x32_bf16(a, b0, acc0, 0, 0, 0); acc1 = __builtin_amdgcn_mfma_f32_16x16x32_bf16(a, b1, acc1, 0, 0, 0);
        }
#pragma unroll
        for (int j = 0; j < 4; ++j) { const int r = r0 + 4 * fq + j; const float rs = row_rstd16(ssq, r, 1.0f / 1024.0f);
            { const float z = acc0[j] * rs + gb[fr]; gates[(size_t)r * 24 + fr] = __builtin_amdgcn_rcpf(1.0f + ex2(-z * LOG2E)); }
            if (fr < 8) { const float z = acc1[j] * rs + gb[16 + fr]; gates[(size_t)r * 24 + 16 + fr] = __builtin_amdgcn_rcpf(1.0f + ex2(-z * LOG2E)); } }
    }
}
__device__ __forceinline__ void cmp2_tile(Frame& F, int kv, int pm) {
    const int lane = F.lane, fr = lane & 15, fq = lane >> 4;
    const bf16* hid = (const bf16*)(F.ws + OFF_HID) + (size_t)kv * 2048 * 256; const bf16* w2 = (const bf16*)(F.ws + (kv ? OFF_W2V : OFF_W2K));
    bf16* out = (bf16*)(F.ws + (kv ? OFF_VCMP : OFF_KCMP)); const float* gain = F.in[9];
    for (int rt = F.wave; rt < 16; rt += NWAVES) {
        const int r0 = pm * 256 + rt * 16; f32x4 acc[4];
#pragma unroll
        for (int c = 0; c < 4; ++c) acc[c] = (f32x4){0.f, 0.f, 0.f, 0.f};
        const bf16* ap = hid + (size_t)(r0 + fr) * 256 + 8 * fq;
#pragma unroll
        for (int k = 0; k < 256; k += 32) { const bf16x8 a = *(const bf16x8*)(ap + k);
#pragma unroll
            for (int c = 0; c < 4; ++c) { const bf16x8 b = *(const bf16x8*)(w2 + (size_t)(c * 16 + fr) * 256 + 8 * fq + k); acc[c] = __builtin_amdgcn_mfma_f32_16x16x32_bf16(a, b, acc[c], 0, 0, 0); } }
#pragma unroll
        for (int j = 0; j < 4; ++j) {
            float v[4];
#pragma unroll
            for (int c = 0; c < 4; ++c) v[c] = acc[c][j];
            if (kv == 0) { float ss = (v[0] * v[0] + v[1] * v[1]) + (v[2] * v[2] + v[3] * v[3]);
                ss += __shfl_xor(ss, 1); ss += __shfl_xor(ss, 2); ss += __shfl_xor(ss, 4); ss += __shfl_xor(ss, 8);
                const float r = rsq(ss * (1.0f / 64.0f) + EPS);
#pragma unroll
                for (int c = 0; c < 4; ++c) v[c] = v[c] * r * gain[c * 16 + fr]; }
#pragma unroll
            for (int c = 0; c < 4; ++c) { const int rr = r0 + 4 * fq + j, slab = rr >> 9, i = rr & 511, d = c * 16 + fr;
                out[(size_t)slab * 512 * 64 + (kv ? vtile_off(i, d) : ktile_off<64>(i, d >> 3) + (d & 7))] = (bf16)f2bf(v[c]); }
        }
    }
}

__device__ __forceinline__ void fox_scan(Frame& F, int bh) {
    const int b = bh >> 3, h = bh & 7; const float* fraw = (const float*)(F.ws + OFF_FRAW); const float fb = F.in[32][h];
    LAS float* red = (LAS float*)(F.lds);
    float v[16]; float run = 0.f; const int t0 = F.tid * 16;
#pragma unroll
    for (int i = 0; i < 16; ++i) { const float x = fraw[(size_t)bh * SEQ + t0 + i] + fb; const float ls2 = fminf(x, 0.f) * LOG2E - __builtin_amdgcn_logf(1.0f + ex2(-fabsf(x) * LOG2E)); run += ls2; v[i] = run; }
    float inc = run;
#pragma unroll
    for (int off = 1; off < 64; off <<= 1) { const float y = __shfl_up(inc, off); if (F.lane >= off) inc += y; }
    __syncthreads();
    if (F.lane == 63) red[F.wave] = inc;
    __syncthreads();
    float wbase = 0.f;
    for (int w = 0; w < F.wave; ++w) wbase += red[w];
    const float excl = wbase + inc - run;
    float* dc = (float*)(F.ws + OFF_DC2) + (size_t)bh * SEQ;
    bf16* QF = (bf16*)(F.ws + OFF_QF); bf16* KF = (bf16*)(F.ws + OFF_KF);
#pragma unroll
    for (int i = 0; i < 16; ++i) { const float val = excl + v[i]; const int t = t0 + i; dc[t] = val;
        const unsigned h1 = f2bf(val); const float r1 = val - bf2f((bf16)h1); const unsigned h2 = f2bf(r1); const float r2 = r1 - bf2f((bf16)h2); const unsigned h3 = f2bf(r2);
        const unsigned one = 0x3F80u;
        v4u qa; qa.x = one | (one << 16); qa.y = one | (h1 << 16); qa.z = h2 | (h3 << 16); qa.w = 0u;
        v4u ka; ka.x = (h1 ^ 0x8000u) | ((h2 ^ 0x8000u) << 16); ka.y = (h3 ^ 0x8000u) | (one << 16); ka.z = one | (one << 16); ka.w = 0u;
        const v4u z = {0u, 0u, 0u, 0u};
        bf16* qp = (bf16*)(F.ws + OFF_QAUG) + ((size_t)bh * SEQ + t) * 16; *(v4u*)qp = qa; *(v4u*)(qp + 8) = z;
        bf16* ksl = KF + (size_t)bh * SEQ * 80; *(v4u*)(ksl + ktile_off<80>(t, 8)) = ka; *(v4u*)(ksl + ktile_off<80>(t, 9)) = z; }
    __syncthreads();
}

__device__ __forceinline__ int fresh_tid() { int t = threadIdx.x; asm volatile("" : "+v"(t)); return t; }
namespace fa {
typedef float f32x16 __attribute__((ext_vector_type(16)));
typedef short s16x4 __attribute__((ext_vector_type(4)));
typedef short v4i16_t __attribute__((ext_vector_type(4)));
typedef LAS const char* lds_cptr;
constexpr int VSLOT = 8192, NSLOT = 4, IMPS = 129;
template <int DQK> struct Map { static constexpr int KS = DQK <= 64 ? 8192 : 12288, K = 0, V = NSLOT * KS, WS = V + NSLOT * VSLOT, IMP = WS + 8 * 256, SEL = IMP + 64 * IMPS * 4, END = SEL + 64 * 16; };
static_assert(Map<64>::END <= 131072 && Map<96>::IMP <= 131072, "attention LDS map");
__device__ __forceinline__ int crow(int r, int hi) { return (r & 3) + 8 * (r >> 2) + 4 * hi; }
__device__ __forceinline__ void glds16(const void* g, unsigned lds_base) {
    unsigned sv; asm volatile("s_mov_b32 %0, m0\n\ts_mov_b32 m0, %2\n\ts_nop 0\n\tglobal_load_lds_dwordx4 %1, off\n\ts_mov_b32 m0, %0" : "=&s"(sv) : "v"(g), "s"(lds_base) : "memory"); }
__device__ __forceinline__ s16x4 vtr(lds_cptr p) { return __builtin_bit_cast(s16x4, __builtin_amdgcn_ds_read_tr16_b64_v4i16((LAS v4i16_t*)p)); }
#define FA_MX3(a, b, c) __builtin_fmaxf(__builtin_fmaxf((a), (b)), (c))
#define FA_MFMA(a, b, c) __builtin_amdgcn_mfma_f32_32x32x16_bf16(a, b, c, 0, 0, 0)
__device__ __forceinline__ float rowmax(const f32x16& p0, const f32x16& p1) {
    float a = FA_MX3(p0[0], p0[1], p1[0]), b = FA_MX3(p0[2], p0[3], p1[1]); a = FA_MX3(a, p1[2], p1[3]);
#pragma unroll
    for (int r = 4; r < 16; r += 4) { a = FA_MX3(a, p0[r], p0[r + 1]); b = FA_MX3(b, p0[r + 2], p0[r + 3]); a = FA_MX3(a, p1[r], p1[r + 1]); b = FA_MX3(b, p1[r + 2], p1[r + 3]); }
    float m = __builtin_fmaxf(a, b); auto rr = __builtin_amdgcn_permlane32_swap(__float_as_uint(m), __float_as_uint(m), false, false);
    return __builtin_fmaxf(__uint_as_float(rr[0]), __uint_as_float(rr[1])); }
__device__ __forceinline__ float halfsum(float v) { auto rr = __builtin_amdgcn_permlane32_swap(__float_as_uint(v), __float_as_uint(v), false, false); return __uint_as_float(rr[0]) + __uint_as_float(rr[1]); }

struct PassArgs {
    const bf16* K; const bf16* V;
    int t_begin, t_end;
    int lo, hi;
    int lo_max, hi_min;
    int nomax;
};
__device__ __forceinline__ void wait_vm_bar(int n) {
    if (n == 0) asm volatile("s_waitcnt vmcnt(0) lgkmcnt(0)\n\ts_barrier" ::: "memory");
    else if (n == 1) asm volatile("s_waitcnt vmcnt(1) lgkmcnt(0)\n\ts_barrier" ::: "memory");
    else if (n == 2) asm volatile("s_waitcnt vmcnt(2) lgkmcnt(0)\n\ts_barrier" ::: "memory");
    else asm volatile("s_waitcnt vmcnt(3) lgkmcnt(0)\n\ts_barrier" ::: "memory");
}
template <int WSOFF> __device__ __forceinline__ void scale_rows(LAS char* shm, f32x16 (&o)[2], float f, int wid, int r32, int hi) {
    LAS float* wsf = (LAS float*)(shm + WSOFF) + wid * 64;
    if (hi == 0) wsf[r32] = f;
    asm volatile("s_waitcnt lgkmcnt(0)" ::: "memory");
#pragma unroll
    for (int r = 0; r < 16; ++r) { const float fr = wsf[crow(r, hi)]; o[0][r] *= fr; o[1][r] *= fr; }
    asm volatile("s_waitcnt lgkmcnt(0)" ::: "memory");
}
#ifndef FA_SKEW
#define FA_SKEW 0
#endif
constexpr float THR = 8.0f;
template <int DQK, int MODE, bool USE_SEL>
__device__ __forceinline__ void attn_pass(LAS char* shm, const bf16x8 (&qr)[DQK / 16], const PassArgs& pa, const unsigned (&sel)[4], f32x16 (&o)[2], float& m, float& l, float invl, int tok) {
    typedef Map<DQK> MP;
    const int tid = fresh_tid(), lane = tid & 63, r32 = lane & 31, hi = lane >> 5; const int wid = __builtin_amdgcn_readfirstlane(tid >> 6);
    constexpr int NCH = DQK / 8, ND = DQK / 16;
    const int nt = pa.t_end - pa.t_begin;
    const bool two_k = (wid + 8 < NCH);
    const int pt = (MODE == 1 ? 0 : 1) + 1 + (two_k ? 1 : 0);
    const bool skew = FA_SKEW && (MODE == 0) && (wid >= 4);
    const bf16* ksrc = pa.K + wid * 512 + lane * 8;
    const bf16* vsrc = pa.V + wid * 512 + lane * 8;
    const unsigned lds0 = (unsigned)(uintptr_t)shm;
#define FA_ISSUE(t_, slot_) do { const size_t ko_ = (size_t)(t_) * 64 * DQK; \
        glds16(ksrc + ko_, (unsigned)__builtin_amdgcn_readfirstlane(lds0 + MP::K + (slot_) * MP::KS + wid * 1024)); \
        if (two_k) glds16(ksrc + ko_ + 8 * 512, (unsigned)__builtin_amdgcn_readfirstlane(lds0 + MP::K + (slot_) * MP::KS + (wid + 8) * 1024)); \
        if (MODE != 1) glds16(vsrc + (size_t)(t_) * 4096, (unsigned)__builtin_amdgcn_readfirstlane(lds0 + MP::V + (slot_) * VSLOT + wid * 1024)); } while (0)
    if (nt <= 0) return;
    FA_ISSUE(pa.t_begin, 0); if (nt > 1) FA_ISSUE(pa.t_begin + 1, 1);
    const float NEG = -__builtin_inff();
    f32x16 p0, p1; v4u pw[4];
    p0 = f32x16{}; p1 = f32x16{};
    bf16x8 kf[2 * ND]; s16x4 vl[8], vh[8];
#define FA_LOADK(sl, D0A, D0B) do { const lds_cptr kp = (lds_cptr)shm + MP::K + (sl) * MP::KS + hi * 1024 + r32 * 16; \
        _Pragma("unroll") for (int d0 = (D0A); d0 < (D0B); ++d0) { kf[2 * d0] = *(const LAS bf16x8*)(kp + d0 * 2048); kf[2 * d0 + 1] = *(const LAS bf16x8*)(kp + d0 * 2048 + 512); } \
        __builtin_amdgcn_sched_barrier(0); } while (0)
#define FA_LOADV(sl) do { if (MODE != 1) { const lds_cptr vp = (lds_cptr)shm + MP::V + (sl) * VSLOT + ((lane >> 4) & 1) * 32 + (lane & 3) * 8 + (4 * hi + ((lane & 15) >> 2)) * 64; \
        _Pragma("unroll") for (int d0 = 0; d0 < 2; ++d0) _Pragma("unroll") for (int ks = 0; ks < 4; ++ks) { vl[d0 * 4 + ks] = vtr(vp + d0 * 4096 + ks * 1024); vh[d0 * 4 + ks] = vtr(vp + d0 * 4096 + ks * 1024 + 512); } \
        __builtin_amdgcn_sched_barrier(0); } } while (0)
#define FA_SEG_A(t) do { \
        f32x16 cin; float c_ = -m; \
        if (USE_SEL) { const unsigned w_ = (t) < 32 ? sel[0] : (t) < 64 ? sel[1] : (t) < 96 ? sel[2] : sel[3]; c_ = ((w_ >> ((t) & 31)) & 1u) ? -m : NEG; } \
        _Pragma("unroll") for (int r = 0; r < 16; ++r) cin[r] = c_; \
        _Pragma("unroll") for (int d0 = 0; d0 < ND; ++d0) { \
            if (d0 == 0) { p0 = FA_MFMA(kf[0], qr[0], cin); p1 = FA_MFMA(kf[1], qr[0], cin); } \
            else { p0 = FA_MFMA(kf[2 * d0], qr[d0], p0); p1 = FA_MFMA(kf[2 * d0 + 1], qr[d0], p1); } } \
        if (!(64 * (t) >= pa.lo_max && 64 * (t) + 63 <= pa.hi_min)) { \
            const int kb = 64 * (t) + 4 * hi; \
            _Pragma("unroll") for (int r = 0; r < 16; ++r) { const int kv = kb + (r & 3) + 8 * (r >> 2); \
                if (kv < pa.lo || kv > pa.hi) p0[r] = NEG; if (kv + 32 < pa.lo || kv + 32 > pa.hi) p1[r] = NEG; } } \
        __builtin_amdgcn_sched_barrier(0); \
    } while (0)
#define FA_SEG_B(t) do { \
        if (MODE != 2) { \
            float rm = 0.f; if (!pa.nomax) rm = rowmax(p0, p1); \
            if (!pa.nomax && __any(rm > THR)) { \
                const float dl = __builtin_fmaxf(rm, 0.f); m += dl; const float alpha = ex2(-dl); l *= alpha; \
                _Pragma("unroll") for (int r = 0; r < 16; ++r) { p0[r] -= dl; p1[r] -= dl; } \
                if (MODE == 0) scale_rows<MP::WS>(shm, o, alpha, wid, r32, hi); \
            } \
            float ls = 0.f; \
            _Pragma("unroll") for (int r = 0; r < 16; ++r) { p0[r] = ex2(p0[r]); p1[r] = ex2(p1[r]); ls += p0[r] + p1[r]; } \
            l += ls; \
        } else { \
            _Pragma("unroll") for (int r = 0; r < 16; ++r) { p0[r] = ex2(p0[r]) * invl; p1[r] = ex2(p1[r]) * invl; } \
            LAS unsigned* imp = (LAS unsigned*)(shm + MP::IMP) + tok * IMPS; \
            _Pragma("unroll") for (int half = 0; half < 2; ++half) \
            _Pragma("unroll") for (int g = 0; g < 4; ++g) { \
                const float x0 = half ? p1[4 * g] : p0[4 * g], x1 = half ? p1[4 * g + 1] : p0[4 * g + 1], x2 = half ? p1[4 * g + 2] : p0[4 * g + 2], x3 = half ? p1[4 * g + 3] : p0[4 * g + 3]; \
                const int jsel = 16 * (t) + 8 * half + 2 * g + hi; \
                const unsigned a = (unsigned)((32.f * ((x0 + x1) + x2) + 16.f * x3) * 2097152.f + 0.5f), c = (unsigned)(16.f * x3 * 2097152.f + 0.5f); \
                if (jsel < 128) __hip_atomic_fetch_add(imp + jsel, a, __ATOMIC_RELAXED, __HIP_MEMORY_SCOPE_WORKGROUP); \
                if (jsel + 1 < 128) __hip_atomic_fetch_add(imp + jsel + 1, c, __ATOMIC_RELAXED, __HIP_MEMORY_SCOPE_WORKGROUP); } \
        } \
        if (MODE != 1) { \
            pw[0] = (v4u){pk2(p0[0], p0[1]), pk2(p0[2], p0[3]), pk2(p0[4], p0[5]), pk2(p0[6], p0[7])}; \
            pw[1] = (v4u){pk2(p0[8], p0[9]), pk2(p0[10], p0[11]), pk2(p0[12], p0[13]), pk2(p0[14], p0[15])}; \
            pw[2] = (v4u){pk2(p1[0], p1[1]), pk2(p1[2], p1[3]), pk2(p1[4], p1[5]), pk2(p1[6], p1[7])}; \
            pw[3] = (v4u){pk2(p1[8], p1[9]), pk2(p1[10], p1[11]), pk2(p1[12], p1[13]), pk2(p1[14], p1[15])}; } \
        __builtin_amdgcn_sched_barrier(0); \
    } while (0)
#define FA_SEG_C() do { if (MODE != 1) { \
        _Pragma("unroll") for (int d0 = 0; d0 < 2; ++d0) \
        _Pragma("unroll") for (int ks = 0; ks < 4; ++ks) { \
            const s16x4 a_ = vl[d0 * 4 + ks], b_ = vh[d0 * 4 + ks]; \
            const bf16x8 vf = {a_[0], a_[1], a_[2], a_[3], b_[0], b_[1], b_[2], b_[3]}; \
            o[d0] = FA_MFMA(__builtin_bit_cast(bf16x8, pw[ks]), vf, o[d0]); } \
        __builtin_amdgcn_sched_barrier(0); } } while (0)
    int slot = 0, pslot = 0;
    for (int i = 0; i < nt; ++i) {
        const int t = pa.t_begin + i;
        wait_vm_bar((i + 1 < nt) ? pt : 0);
        if (i + 2 < nt) { const int s2 = (slot + 2) & 3; FA_ISSUE(t + 2, s2); }
        if (!skew) { FA_LOADK(slot, 0, ND); FA_SEG_A(t); FA_LOADV(slot); FA_SEG_B(t); FA_SEG_C(); }
        else { if (i > 0) { FA_LOADV(pslot); FA_SEG_B(t - 1); FA_LOADK(slot, 0, ND / 2); FA_SEG_C(); FA_LOADK(slot, ND / 2, ND); } else { FA_LOADK(slot, 0, ND); } FA_SEG_A(t); }
        pslot = slot; slot = (slot + 1) & 3;
    }
    if (skew) { FA_LOADV(pslot); FA_SEG_B(pa.t_end - 1); FA_SEG_C(); }
    asm volatile("s_waitcnt lgkmcnt(0)\n\ts_barrier" ::: "memory");
#undef FA_ISSUE
#undef FA_SEG_A
#undef FA_LOADK
#undef FA_LOADV
#undef FA_SEG_B
#undef FA_SEG_C
}
template <int DQK> __device__ __forceinline__ void write_o(LAS char* shm, const f32x16 (&o)[2], bf16* dst, int pitch, int wid, int lane) {
    typedef Map<DQK> MP;
    const int r32 = lane & 31, hi = lane >> 5;
    LAS bf16* stg = (LAS bf16*)(shm + (wid < 4 ? MP::K + 2 * MP::KS + wid * 4096 : MP::V + 2 * VSLOT + (wid - 4) * 4096));
#pragma unroll
    for (int r = 0; r < 16; ++r) { const int orow = crow(r, hi);
#pragma unroll
        for (int d0 = 0; d0 < 2; ++d0) stg[orow * 64 + d0 * 32 + r32] = (bf16)f2bf(o[d0][r]); }
    asm volatile("s_waitcnt lgkmcnt(0)" ::: "memory");
#pragma unroll
    for (int i = 0; i < 4; ++i) { const int row = i * 8 + (lane >> 3), ch = lane & 7; const v4u v = *(const LAS v4u*)(stg + row * 64 + ch * 8); *(v4u*)(dst + (size_t)row * pitch + ch * 8) = v; }
    asm volatile("s_waitcnt lgkmcnt(0)" ::: "memory");
}
template <int ND> __device__ __forceinline__ void load_q(bf16x8 (&qr)[ND], const bf16* qrow, int hi) {
#pragma unroll
    for (int d0 = 0; d0 < ND; ++d0) qr[d0] = *(const bf16x8*)(qrow + d0 * 16 + hi * 8);
}
template <int ND> __device__ __forceinline__ void mla_q_finish(bf16x8 (&qr)[ND], const float* gq, const float* c32, const float* s32, int t, int hi) {
    if constexpr (ND == 6) {
        float x[6][8]; float ss = 0.f;
#pragma unroll
        for (int d0 = 0; d0 < 6; ++d0) { const v4u w = __builtin_bit_cast(v4u, qr[d0]);
            x[d0][0] = bflo(w.x); x[d0][1] = bfhi(w.x); x[d0][2] = bflo(w.y); x[d0][3] = bfhi(w.y); x[d0][4] = bflo(w.z); x[d0][5] = bfhi(w.z); x[d0][6] = bflo(w.w); x[d0][7] = bfhi(w.w);
#pragma unroll
            for (int j = 0; j < 8; ++j) ss += x[d0][j] * x[d0][j]; }
        ss = halfsum(ss);
        const float rn = rsq(ss * (1.0f / 96.0f) + EPS);
#pragma unroll
        for (int d0 = 0; d0 < 6; ++d0) { const f32x4 g0 = *(const f32x4*)(gq + 16 * d0 + 8 * hi), g1 = *(const f32x4*)(gq + 16 * d0 + 8 * hi + 4);
#pragma unroll
            for (int j = 0; j < 4; ++j) { x[d0][j] *= rn * g0[j]; x[d0][4 + j] *= rn * g1[j]; } }
        const f32x4 c0 = *(const f32x4*)(c32 + (size_t)t * 16 + 8 * hi), c1 = *(const f32x4*)(c32 + (size_t)t * 16 + 8 * hi + 4), s0 = *(const f32x4*)(s32 + (size_t)t * 16 + 8 * hi), s1 = *(const f32x4*)(s32 + (size_t)t * 16 + 8 * hi + 4);
#pragma unroll
        for (int j = 0; j < 8; ++j) { const float c = j < 4 ? c0[j & 3] : c1[j & 3], sn = j < 4 ? s0[j & 3] : s1[j & 3]; const float a = x[4][j], bb = x[5][j]; x[4][j] = a * c - bb * sn; x[5][j] = bb * c + a * sn; }
#pragma unroll
        for (int d0 = 0; d0 < 6; ++d0) { v4u w; w.x = pk2(x[d0][0] * C2_96, x[d0][1] * C2_96); w.y = pk2(x[d0][2] * C2_96, x[d0][3] * C2_96); w.z = pk2(x[d0][4] * C2_96, x[d0][5] * C2_96); w.w = pk2(x[d0][6] * C2_96, x[d0][7] * C2_96); qr[d0] = __builtin_bit_cast(bf16x8, w); }
    }
}
template <int DQK> __device__ __forceinline__ void l1_unit(LAS char* shm, int bh, int qb, int t_first, int nomax, const bf16* Q, const bf16* K, const bf16* V, bf16* O, const float* gq, const float* c32, const float* s32, const bf16* qaug) {
    const int wid = __builtin_amdgcn_readfirstlane(fresh_tid() >> 6);
    const int b = bh >> 3, h = bh & 7, q0 = qb * 256;
    f32x16 o[2]; o[0] = f32x16{}; o[1] = f32x16{}; float m = 0.f, l = 0.f;
    { const int lane = fresh_tid() & 63, r32 = lane & 31, hi = lane >> 5; const int qpos = q0 + 32 * wid + r32; const size_t row = (size_t)b * SEQ + qpos;
      bf16x8 qr[DQK / 16]; load_q<DQK / 16>(qr, Q + (row * 8 + h) * DQK, hi);
      if (DQK == 80) qr[DQK / 16 - 1] = *(const bf16x8*)(qaug + ((size_t)bh * SEQ + qpos) * 16 + hi * 8);
      if (DQK == 96) mla_q_finish(qr, gq, c32, s32, qpos, hi);
      PassArgs pa; pa.K = K + (size_t)bh * SEQ * DQK; pa.V = V + (size_t)bh * SEQ * 64; pa.t_begin = t_first; pa.t_end = (q0 + 256) / 64; pa.nomax = nomax;
      pa.lo = 0; pa.hi = qpos; pa.lo_max = 0; pa.hi_min = q0 + 32 * wid;
      const unsigned sel[4] = {0u, 0u, 0u, 0u};
      attn_pass<DQK, 0, false>(shm, qr, pa, sel, o, m, l, 0.f, 0); }
    { const int lane = fresh_tid() & 63, r32 = lane & 31, hi = lane >> 5;
      const float lt = halfsum(l); scale_rows<Map<DQK>::WS>(shm, o, lt > 0.f ? 1.0f / lt : 0.f, wid, r32, hi);
      write_o<DQK>(shm, o, O + ((size_t)b * SEQ + q0 + 32 * wid) * 1024 + h * 64, 1024, wid, lane); }
}
__device__ __forceinline__ float gain_absmax(const float* g, int n, int lane) {
    float v = 0.f; for (int i = lane; i < n; i += 64) v = __builtin_fmaxf(v, __builtin_fabsf(g[i]));
#pragma unroll
    for (int o = 1; o < 64; o <<= 1) v = __builtin_fmaxf(v, __shfl_xor(v, o));
    return __builtin_bit_cast(float, __builtin_amdgcn_readfirstlane(__builtin_bit_cast(int, v)));
}
constexpr int CW_Q1 = 12288;
__device__ __forceinline__ void att1_phase(Frame& F) {
    LAS char* shm = (LAS char*)F.lds; unsigned char* ws = F.ws; unsigned* ctl = (unsigned*)(ws + OFF_CTL);
    const int lane0 = fresh_tid() & 63;
    const float bq = gain_absmax(F.in[33], 64, lane0), bk = gain_absmax(F.in[34], 64, lane0), mq = gain_absmax(F.in[39], 96, lane0), mk = gain_absmax(F.in[40], 96, lane0);
    const float Bf = C2_64 * 64.f * bq * bk * 1.02f, Bm = C2_96 * 96.f * mq * mk * 1.02f;
    const int nomax_f = Bf <= 40.f, nomax_m = Bm <= 40.f;
    const float thr = 2.f * Bf + 30.f;
    LAS int* slotw = (LAS int*)(shm + 130048);
    const int myq = (F.vcu * 8) / F.G;
    for (;;) {
        __syncthreads();
        if (threadIdx.x == 0) { int got = -1;
            for (int k = 0; k < 8 && got < 0; ++k) { const int q = (myq + k) & 7; const unsigned id = __hip_atomic_fetch_add(ctl + CW_Q1 + 64 * q, 1u, __ATOMIC_RELAXED, __HIP_MEMORY_SCOPE_AGENT); if (id < 128u) got = q * 128 + (int)id; }
            *slotw = got; }
        __syncthreads();
        const int u = *slotw; if (u < 0) break;
        const int q = u >> 7, id = u & 127, fox = id >> 6, bh = 2 * q + ((id >> 5) & 1), qb = 31 - (id & 31);
        if (!fox) l1_unit<96>(shm, bh, qb, 0, nomax_m, (const bf16*)(ws + OFF_QM), (const bf16*)(ws + OFF_KM), (const bf16*)(ws + OFF_VM), (bf16*)(ws + OFF_O1) + 512, F.in[39], (const float*)(ws + OFF_ROPE32C), (const float*)(ws + OFF_ROPE32S), nullptr);
        else {
            const float* dc = (const float*)(ws + OFF_DC2) + (size_t)bh * SEQ; const float lim = dc[qb * 256] + thr;
            int lo = 0, hi = 4 * qb;
            while (lo < hi) { const int mid = (lo + hi) >> 1; if (dc[64 * mid + 63] < lim) hi = mid; else lo = mid + 1; }
            l1_unit<80>(shm, bh, qb, lo, nomax_f, (const bf16*)(ws + OFF_QF), (const bf16*)(ws + OFF_KF), (const bf16*)(ws + OFF_VF), (bf16*)(ws + OFF_O1), nullptr, nullptr, nullptr, (const bf16*)(ws + OFF_QAUG));
        }
    }
}
__device__ __forceinline__ void l0_unit(Frame& F, LAS char* shm, int bhk, int tb, int nomax) {
    const int wid = __builtin_amdgcn_readfirstlane(fresh_tid() >> 6);
    unsigned char* ws = F.ws;
    const int b = bhk >> 1, hk = bhk & 1, g = wid >> 1, th = wid & 1, h = hk * 4 + g, t0 = tb * 64;
    const size_t kvofs = (size_t)bhk * SEQ * 64;
    const bf16* KS = (const bf16*)(ws + OFF_KV8 + 2 * SZ_KV) + kvofs; const bf16* VS = (const bf16*)(ws + OFF_KV8 + 3 * SZ_KV) + kvofs;
    const bf16* KW = (const bf16*)(ws + OFF_KV8 + 4 * SZ_KV) + kvofs; const bf16* VW = (const bf16*)(ws + OFF_KV8 + 5 * SZ_KV) + kvofs;
    const bf16* KB = (const bf16*)(ws + OFF_KV8 + 6 * SZ_KV) + kvofs; const bf16* VB = (const bf16*)(ws + OFF_KV8 + 7 * SZ_KV) + kvofs;
    const bf16* KCM = (const bf16*)(ws + OFF_KCMP) + (size_t)bhk * 512 * 64; const bf16* VCM = (const bf16*)(ws + OFF_VCMP) + (size_t)bhk * 512 * 64;
    bf16* QO = (bf16*)(ws + OFF_QO); const bf16* QC = (const bf16*)(ws + OFF_QC);
    LAS unsigned* IMP = (LAS unsigned*)(shm + Map<64>::IMP); LAS unsigned* SEL = (LAS unsigned*)(shm + Map<64>::SEL);
    const unsigned nosel[4] = {0u, 0u, 0u, 0u};
    f32x16 o[2]; bf16x8 qr[4]; PassArgs pa; float m, l, gate_c = 0.f; pa.nomax = nomax;
#define CTX() const int tid_ = fresh_tid(), lane = tid_ & 63, r32 = lane & 31, hi = lane >> 5; const int tok = 32 * th + r32, tq = t0 + tok; const size_t row = (size_t)b * SEQ + tq; (void)hi; (void)row; (void)tq; (void)tok; (void)lane
#define GATE(i) (((const float*)(ws + OFF_GATES))[row * 24 + h * 3 + (i)])
#define ACCP() f32x4* accp = (f32x4*)(ws + OFF_OACC) + (size_t)F.vcu * 4096 + wid * 512 + lane
#define ACC_AT(d0, g) accp[((d0) * 4 + (g)) * 64]
#define O4(d0, g) (f32x4){o[d0][4 * (g)], o[d0][4 * (g) + 1], o[d0][4 * (g) + 2], o[d0][4 * (g) + 3]}
    { CTX();
      for (int i = tid_; i < 64 * IMPS; i += 512) IMP[i] = 0u;
      load_q<4>(qr, QC + row * 512 + h * 64, hi);
      pa.K = KCM; pa.V = VCM; pa.t_begin = 0; pa.t_end = ((((t0 + 32) >> 4) + 1) + 63) >> 6;
      pa.lo = 0; pa.hi = (tq - 31) >> 4; pa.lo_max = 0; pa.hi_min = (t0 + 32 * th - 31) >> 4;
      o[0] = f32x16{}; o[1] = f32x16{}; m = 0.f; l = 0.f;
      gate_c = GATE(0);
      attn_pass<64, 1, false>(shm, qr, pa, nosel, o, m, l, 0.f, 0);
      const float lt = halfsum(l); const float invl = lt > 0.f ? 1.0f / lt : 0.f;
      attn_pass<64, 2, false>(shm, qr, pa, nosel, o, m, l, invl, tok); }
    { CTX(); ACCP();
      scale_rows<Map<64>::WS>(shm, o, gate_c, wid, r32, hi);
#pragma unroll
      for (int d0 = 0; d0 < 2; ++d0)
#pragma unroll
        for (int g4 = 0; g4 < 4; ++g4) ACC_AT(d0, g4) = O4(d0, g4); }
    { CTX(); const int cur = tb;
      const int j0 = lane, j1 = lane + 64;
      const bool f0 = (j0 == 0) || (j0 == cur) || (j0 == cur - 1), f1 = (j1 == cur) || (j1 == cur - 1);
      const unsigned long long lt_mask = (1ull << lane) - 1ull;
      for (int kg = 0; kg < 8; kg += 4) {
        int k0[4], k1[4]; unsigned T[4];
#pragma unroll
        for (int u = 0; u < 4; ++u) { const int tk = wid * 8 + kg + u;
            k0[u] = f0 ? 0x7fffffff : (j0 <= cur ? (int)IMP[tk * IMPS + j0] : -1); k1[u] = f1 ? 0x7fffffff : (j1 <= cur ? (int)IMP[tk * IMPS + j1] : -1); T[u] = 0u; }
        for (int bit = 28; bit >= 0; --bit) {
#pragma unroll
            for (int u = 0; u < 4; ++u) { const int cand = (int)(T[u] | (1u << bit));
                const int c = __builtin_popcountll(__ballot(k0[u] >= cand)) + __builtin_popcountll(__ballot(k1[u] >= cand));
                T[u] = c >= 16 ? (unsigned)cand : T[u]; }
        }
#pragma unroll
        for (int u = 0; u < 4; ++u) { const int tk = wid * 8 + kg + u;
            const int c0 = __builtin_popcountll(__ballot(k0[u] >= 0)) + __builtin_popcountll(__ballot(k1[u] >= 0));
            const int Tq = c0 >= 16 ? (int)T[u] : -1;
            const unsigned long long gt0 = __ballot(k0[u] > Tq), gt1 = __ballot(k1[u] > Tq), eq0 = __ballot(k0[u] == Tq), eq1 = __ballot(k1[u] == Tq);
            const int need = 16 - (__builtin_popcountll(gt0) + __builtin_popcountll(gt1));
            const int rk0 = __builtin_popcountll(eq0 & lt_mask), rk1 = __builtin_popcountll(eq0) + __builtin_popcountll(eq1 & lt_mask);
            const bool s0 = (k0[u] > Tq || (k0[u] == Tq && rk0 < need)) && j0 <= cur, s1 = (k1[u] > Tq || (k1[u] == Tq && rk1 < need)) && j1 <= cur;
            const unsigned long long b0 = __ballot(s0), b1 = __ballot(s1);
            if (lane == 0) { SEL[tk * 4 + 0] = (unsigned)b0; SEL[tk * 4 + 1] = (unsigned)(b0 >> 32); SEL[tk * 4 + 2] = (unsigned)b1; SEL[tk * 4 + 3] = (unsigned)(b1 >> 32); } }
      } }
    asm volatile("s_waitcnt lgkmcnt(0)\n\ts_barrier" ::: "memory");
    { CTX();
      unsigned sel[4]; sel[0] = SEL[tok * 4 + 0]; sel[1] = SEL[tok * 4 + 1]; sel[2] = SEL[tok * 4 + 2]; sel[3] = SEL[tok * 4 + 3];
      load_q<4>(qr, QO + row * 1024 + h * 64, hi);
      pa.K = KS; pa.V = VS; pa.t_begin = 0; pa.t_end = tb + 1; pa.lo = 0; pa.hi = tq; pa.lo_max = 0; pa.hi_min = t0 + 32 * th;
      o[0] = f32x16{}; o[1] = f32x16{}; m = 0.f; l = 0.f;
      gate_c = GATE(1);
      attn_pass<64, 0, true>(shm, qr, pa, sel, o, m, l, 0.f, 0); }
    { CTX(); ACCP();
      const float lt = halfsum(l); scale_rows<Map<64>::WS>(shm, o, lt > 0.f ? gate_c / lt : 0.f, wid, r32, hi);
#pragma unroll
      for (int d0 = 0; d0 < 2; ++d0)
#pragma unroll
        for (int g4 = 0; g4 < 4; ++g4) { const f32x4 a = ACC_AT(d0, g4); ACC_AT(d0, g4) = a + O4(d0, g4); } }
    { CTX();
      gate_c = GATE(2);
      pa.K = KW; pa.V = VW; pa.t_begin = tb > 8 ? tb - 8 : 0; pa.t_end = tb + 1; pa.lo = tq - 511; pa.hi = tq; pa.lo_max = t0 + 32 * th + 31 - 511; pa.hi_min = t0 + 32 * th;
      o[0] = f32x16{}; o[1] = f32x16{}; m = 0.f; l = 0.f;
      attn_pass<64, 0, false>(shm, qr, pa, nosel, o, m, l, 0.f, 0); }
    { CTX(); ACCP();
      const float lt = halfsum(l); scale_rows<Map<64>::WS>(shm, o, lt > 0.f ? gate_c / lt : 0.f, wid, r32, hi);
#pragma unroll
      for (int d0 = 0; d0 < 2; ++d0)
#pragma unroll
        for (int g4 = 0; g4 < 4; ++g4) { const f32x4 a = ACC_AT(d0, g4); o[d0][4 * g4] += a[0]; o[d0][4 * g4 + 1] += a[1]; o[d0][4 * g4 + 2] += a[2]; o[d0][4 * g4 + 3] += a[3]; }
      write_o<64>(shm, o, QO + ((size_t)b * SEQ + t0 + 32 * th) * 1024 + h * 64, 1024, wid, lane); }
    { CTX();
      load_q<4>(qr, QO + row * 1024 + 512 + h * 64, hi);
      pa.K = KB; pa.V = VB; pa.t_begin = tb > 2 ? tb - 2 : 0; pa.t_end = tb + 1; pa.lo = tq - 127; pa.hi = tq; pa.lo_max = t0 + 32 * th + 31 - 127; pa.hi_min = t0 + 32 * th;
      o[0] = f32x16{}; o[1] = f32x16{}; m = 0.f; l = 0.f;
      attn_pass<64, 0, false>(shm, qr, pa, nosel, o, m, l, 0.f, 0); }
    { CTX();
      const float lt = halfsum(l); const float sk = F.in[20][h] * LOG2E; const float M2 = __builtin_fmaxf(m, sk); const float a = ex2(m - M2); const float den = lt * a + ex2(sk - M2);
      scale_rows<Map<64>::WS>(shm, o, a / den, wid, r32, hi);
      write_o<64>(shm, o, QO + ((size_t)b * SEQ + t0 + 32 * th) * 1024 + 512 + h * 64, 1024, wid, lane); }
#undef CTX
#undef GATE
#undef ACCP
#undef ACC_AT
#undef O4
}
__device__ __forceinline__ void att0_phase(Frame& F) {
    LAS char* shm = (LAS char*)F.lds;
    const int bhk = F.vcu >> 6, s = F.vcu & 63; const int lane0 = fresh_tid() & 63;
    float gq = __builtin_fmaxf(gain_absmax(F.in[8], 64, lane0), gain_absmax(F.in[18], 64, lane0));
    float gk = __builtin_fmaxf(__builtin_fmaxf(gain_absmax(F.in[9], 64, lane0), gain_absmax(F.in[10], 64, lane0)), __builtin_fmaxf(gain_absmax(F.in[11], 64, lane0), gain_absmax(F.in[19], 64, lane0)));
    const int nomax = (C2_64 * 64.f * gq * gk * 1.02f) <= 40.f;
    for (int i = 0; i < 2; ++i) l0_unit(F, shm, bhk, i == 0 ? s : 127 - s, nomax);
}
}

__device__ __forceinline__ void refresh_frame(Frame& F) { const int t = fresh_tid(); F.tid = t; F.lane = t & 63; F.wave = __builtin_amdgcn_readfirstlane(t >> 6); }
constexpr int RING_BYTES = 131072, MISC_OFF = RING_BYTES + 320, INTAB_OFF = RING_BYTES + 1024, LDS_BYTES = 147456;
constexpr int NPHASE = 18;
struct Args { const float* in[46]; float* out; unsigned char* ws; int ph_lo, ph_hi; };

__global__ void __launch_bounds__(NWAVES * 64, 2) mega_fwd(Args args) {
    extern __shared__ __attribute__((aligned(16))) unsigned char lds[];
    Frame F;
    F.lds = (LAS unsigned char*)lds; F.tid = threadIdx.x; F.lane = F.tid & 63; F.wave = __builtin_amdgcn_readfirstlane(F.tid >> 6);
    F.G = gridDim.x; { const int bx = blockIdx.x; F.vcu = (F.G % 8 == 0) ? (bx % 8) * (F.G / 8) + bx / 8 : bx; }
    F.in = (InTab)(F.lds + INTAB_OFF); F.out = args.out; F.ws = args.ws;
    volatile LAS unsigned* MISC = (volatile LAS unsigned*)(F.lds + MISC_OFF);
    for (int u = F.tid; u < (LDS_BYTES - RING_BYTES) / 4; u += NWAVES * 64) ((LAS unsigned*)(F.lds + RING_BYTES))[u] = 0u;
    __syncthreads();
    { const __attribute__((address_space(4))) fptr_t* ka = (const __attribute__((address_space(4))) fptr_t*)__builtin_amdgcn_kernarg_segment_ptr();
      if (F.tid < 46) F.in[F.tid] = ka[F.tid]; }
    __syncthreads();
    unsigned* ctl = (unsigned*)(F.ws + OFF_CTL);
    XcdBarrier bar = xcd_barrier_post(ctl + 4096, MISC + 8);
    const int lo = args.ph_lo, hi = args.ph_hi;
    int vb = (int)blockIdx.x; bool xlocal = false;
#define IN(k) (refresh_frame(F), lo <= (k) && (k) < hi)
#define BOTH(k) (IN(k) && IN((k) + 1))
#define SEAM_G(k) do { if (BOTH(k)) { xcd_barrier(bar, true); } } while (0)
#define SEAM_L(k) do { if (BOTH(k)) xcd_barrier(bar, !xlocal); } while (0)
#define SEAM(k) SEAM_G(k)
#define GD_INIT() GemmDesc gd; gd.in = F.in; gd.ws = F.ws; gd.out = F.out; gd.ep = 0; gd.M = NTOK; gd.K = DM; gd.lda = DM; gd.N = DM; gd.A = nullptr; gd.Bt = nullptr; const int bx = vb; unsigned char* ws = F.ws
#define FFN_PHASES(p0_, fidx_, cfgb_, first_, last_) \
    if (IN(p0_)) { GD_INIT(); gd.A = (const bf16*)(ws + ((cfgb_) ? OFF_XBB : OFF_XBA)); gd.Bt = (const bf16*)(ws + OFF_WGU + (fidx_) * SZ_WGU); gd.N = 2 * FF; gd.ep = (cfgb_) ? 1 : 0; \
        gemm_phase<EPI_GATEUP>(F.lds, gd, F.G, bx); } \
    SEAM_L(p0_); \
    if (IN((p0_) + 1)) { GD_INIT(); gd.A = (const bf16*)(ws + ((cfgb_) ? OFF_ACTB : OFF_ACTA)); gd.Bt = (const bf16*)(ws + OFF_WD + (fidx_) * SZ_WD); gd.K = FF; gd.lda = FF; gd.ep = ((first_) ? 1 : 0) | ((cfgb_) ? 16 : 0) | ((last_) ? 32 : 0); \
        gemm_phase<EPI_RESID>(F.lds, gd, F.G, bx); } \
    SEAM_L((p0_) + 1)

    if (IN(0)) p0_prologue(F);
    SEAM(0);
    if (lo == 0 && hi > 1) {
        unsigned* bw = ctl + 4096; bool ok = (F.G == 256);
#pragma unroll
        for (unsigned j = 0; j < 16; ++j) { const unsigned c = xb_ld(&bw[XB_XCNT(j)]); ok = ok && (c == (j < 8u ? 32u : 0u)); }
        const unsigned rank = MISC[10];
        if (ok && bar.x < 8u && rank < 32u) { vb = (int)(rank * 8u + bar.x); xlocal = true; }
        vb = __builtin_amdgcn_readfirstlane(vb);
        F.vcu = (vb % 8) * (F.G / 8) + vb / 8;
    }
    if (IN(1)) { GD_INIT(); gd.A = (const bf16*)(ws + OFF_XBA); gd.Bt = (const bf16*)(ws + OFF_WGU); gd.N = 2 * FF;
        gemm_phase<EPI_GATEUP>(F.lds, gd, F.G, bx);
        const int nfull = (NTOK / 256) * (2 * FF / 256) - 5 * F.G;
        if (bx >= nfull) { refresh_frame(F); convert_mats(F, MATS_P1, (bx - nfull) * NWAVES + F.wave, (F.G - nfull) * NWAVES); } }
    SEAM_L(1);
    if (IN(2)) { GD_INIT(); gd.A = (const bf16*)(ws + OFF_ACTA); gd.Bt = (const bf16*)(ws + OFF_WD); gd.K = FF; gd.lda = FF; gd.ep = 1;
        gemm_phase<EPI_RESID>(F.lds, gd, F.G, bx); }
    SEAM_L(2);
    if (IN(3)) { GD_INIT(); gd.A = (const bf16*)(ws + OFF_XBA); gd.Bt = (const bf16*)(ws + OFF_WIN0); gd.N = 2048; gemm_phase<EPI_L0IN>(F.lds, gd, F.G, bx); }
    SEAM(3);
    if (IN(4)) {
        GD_INIT();
        for (int gi = 0; gi < 2; ++gi) {
            gd.A = (const bf16*)(ws + OFF_KV8 + gi * SZ_KV); gd.Bt = (const bf16*)(ws + (gi ? OFF_W1V : OFF_W1K)); gd.M = 2048; gd.N = 256; gd.K = 2048; gd.lda = 1024; gd.ep = gi;
            gemm_phase<EPI_CMP1>(F.lds, gd, F.G, (bx + gi * 128) % F.G);
        }
        bool has_unit = false;
        for (int i = 0; i < 2; ++i) { const int cb = (bx + i * 128) % F.G; pg8::StaticOrder S; S.init(2048, 256, F.G, cb); pg8::Unit u;
            for (int k = 0; S.next(k, u); ++k) { cmp2_tile(F, i, u.pm); has_unit = true; } }
        if (!has_unit) {
            const int b2 = bx < 8 ? 0 : (bx < 128 ? bx - 8 : bx - 16);
            refresh_frame(F); __syncthreads(); convert_mats(F, MATS_P4, b2 * NWAVES + F.wave, (F.G - 16) * NWAVES); __syncthreads();
            refresh_frame(F); gates_phase(F, b2 * NWAVES + F.wave, (F.G - 16) * NWAVES); }
    }
    SEAM(4);
    if (IN(5)) fa::att0_phase(F);
    SEAM(5);
    if (IN(6)) { GD_INIT(); gd.A = (const bf16*)(ws + OFF_QO); gd.Bt = (const bf16*)(ws + OFF_WOUT0); gd.ep = 4; gemm_phase<EPI_RESID>(F.lds, gd, F.G, bx); }
    SEAM_L(6);
    if (IN(7)) { GD_INIT(); gd.A = (const bf16*)(ws + OFF_XBA); gd.Bt = (const bf16*)(ws + OFF_WGU + SZ_WGU); gd.N = 2 * FF;
        gemm_phase<EPI_GATEUP>(F.lds, gd, F.G, bx);
        const int nfull = (NTOK / 256) * (2 * FF / 256) - 5 * F.G;
        if (MATS_P7 != 0u && bx >= nfull) { refresh_frame(F); convert_mats(F, MATS_P7, (bx - nfull) * NWAVES + F.wave, (F.G - nfull) * NWAVES); } }
    SEAM_L(7);
    if (IN(8)) { GD_INIT(); gd.A = (const bf16*)(ws + OFF_ACTA); gd.Bt = (const bf16*)(ws + OFF_WD + SZ_WD); gd.K = FF; gd.lda = FF; gd.ep = 8;
        gemm_phase<EPI_RESID>(F.lds, gd, F.G, bx); }
    SEAM_L(8);
    FFN_PHASES(9, 2, false, false, false);
    if (IN(11)) { GD_INIT(); gd.A = (const bf16*)(ws + OFF_XBA); gd.Bt = (const bf16*)(ws + OFF_WIN1); gd.N = 2048; gemm_phase<EPI_L1IN>(F.lds, gd, F.G, bx); }
    SEAM(11);
    if (IN(12)) {
        GD_INIT();
        gd.A = (const bf16*)(ws + OFF_CQ); gd.Bt = (const bf16*)(ws + OFF_WQB); gd.N = 768; gd.K = 256; gd.lda = 256;
        gemm_phase<EPI_QB>(F.lds, gd, F.G, bx);
        gd.A = (const bf16*)(ws + OFF_CKV); gd.Bt = (const bf16*)(ws + OFF_WKVB); gd.N = 1024; gd.K = 128; gd.lda = 128;
        if (bx < F.G - 16) gemm_phase<EPI_KVB>(F.lds, gd, F.G - 16, (bx + 48) % (F.G - 16));
        else { refresh_frame(F); fox_scan(F, bx - (F.G - 16)); }
    }
    SEAM(12);
    if (IN(14)) fa::att1_phase(F);
    SEAM(14);
    if (IN(15)) { GD_INIT(); gd.A = (const bf16*)(ws + OFF_O1); gd.Bt = (const bf16*)(ws + OFF_WOUT1); gd.ep = 2 | 4; gemm_phase<EPI_RESID>(F.lds, gd, F.G, bx); }
    SEAM_L(15);
    FFN_PHASES(16, 3, true, false, true);
#undef IN
#undef BOTH
#undef SEAM
#undef GD_INIT
#undef FFN_PHASES
}

extern "C" void kernel_launch(void* const* d_in, const int* in_sizes, int n_in, void* d_out, int out_size, void* d_ws, size_t ws_size, hipStream_t stream) {
    static int grid = 0;
    if (grid == 0) {
        if (n_in != 46 || in_sizes[0] != NTOK * DM || out_size != NTOK * DM || ws_size < WS_END) { fprintf(stderr, "kernel_launch: unexpected shapes (n_in %d, ws %zu)\n", n_in, ws_size); grid = -1; return; }
        int dev = 0, cus = 0, per_cu = 0;
        hipGetDevice(&dev); hipDeviceGetAttribute(&cus, hipDeviceAttributeMultiprocessorCount, dev);
        hipFuncSetAttribute((const void*)mega_fwd, hipFuncAttributeMaxDynamicSharedMemorySize, LDS_BYTES);
        hipOccupancyMaxActiveBlocksPerMultiprocessor(&per_cu, (const void*)mega_fwd, NWAVES * 64, LDS_BYTES);
        if (per_cu < 1) { fprintf(stderr, "kernel_launch: occupancy query says %d blocks per CU\n", per_cu); per_cu = 1; }
        (void)hipGetLastError();
        grid = cus;
        if (grid > cus * per_cu) grid = cus * per_cu;
    }
    if (grid < 0) return;
    hipMemsetAsync((char*)d_ws + OFF_CTL, 0, CTL_BYTES, stream);
    Args a{};
    for (int i = 0; i < 46; ++i) a.in[i] = (const float*)d_in[i];
    a.out = (float*)d_out; a.ws = (unsigned char*)d_ws; a.ph_lo = 0; a.ph_hi = NPHASE;
    void* kargs[] = {&a};
    hipError_t e = hipLaunchCooperativeKernel((const void*)mega_fwd, dim3(grid), dim3(NWAVES * 64), kargs, LDS_BYTES, stream);
    if (e != hipSuccess) fprintf(stderr, "kernel_launch: cooperative launch failed: %s (grid %d)\n", hipGetErrorString(e), grid);
}
```

```cpp
#include <hip/hip_runtime.h>
#include <hip/hip_cooperative_groups.h>
#include <cstdio>
#include <cstdint>
namespace cg = cooperative_groups;

#define GAS __attribute__((address_space(1)))
#define LAS __attribute__((address_space(3)))
typedef unsigned short bf16;
typedef unsigned v4u __attribute__((ext_vector_type(4)));
typedef unsigned v2u __attribute__((ext_vector_type(2)));
typedef float f32x4 __attribute__((ext_vector_type(4)));
typedef float f32x2 __attribute__((ext_vector_type(2)));
typedef short bf16x8 __attribute__((ext_vector_type(8)));
typedef __bf16 bf16x2_t __attribute__((ext_vector_type(2)));

constexpr int NTOK = 16384, SEQ = 8192, DM = 1024, FF = 2816;
constexpr float EPS = 1e-6f;
constexpr float LOG2E = 1.4426950408889634f;
constexpr float C2_64 = 0.125f * LOG2E;
constexpr float C2_96 = 0.10206207261596575f * LOG2E;
constexpr int NWAVES = 8;

constexpr size_t MiB = 1u << 20, KiB = 1u << 10;
constexpr size_t OFF_CTL = 0, CTL_BYTES = 64 * KiB;
constexpr size_t OFF_SSQ = 1 * MiB;
constexpr size_t OFF_ROPE64C = 2 * MiB, OFF_ROPE64S = 3 * MiB;
constexpr size_t OFF_ROPE32C = 4 * MiB, OFF_ROPE32S = 4 * MiB + 512 * KiB;
constexpr size_t OFF_GATES = 5 * MiB;
constexpr size_t OFF_CBIAS = 6 * MiB + 512 * KiB;
constexpr size_t OFF_SSQCQ = 7 * MiB, OFF_SSQCKV = 7 * MiB + 256 * KiB;
constexpr size_t OFF_SSQKR = 6 * MiB + 768 * KiB;
constexpr size_t OFF_DC2 = 7 * MiB + 512 * KiB;
constexpr size_t OFF_FRAW = 8 * MiB;
constexpr size_t OFF_KR = 8 * MiB + 512 * KiB;
constexpr size_t OFF_WG = 9 * MiB + 512 * KiB;
constexpr size_t OFF_W2K = OFF_WG + 64 * KiB, OFF_W2V = OFF_W2K + 32 * KiB;
constexpr size_t OFF_KCMP = 10 * MiB, OFF_VCMP = 10 * MiB + 256 * KiB;
constexpr size_t OFF_HID = 11 * MiB;
constexpr size_t OFF_WGU = 13 * MiB;
constexpr size_t OFF_WD = 57 * MiB;
constexpr size_t SZ_WGU = 11 * MiB, SZ_WD = 5 * MiB + 512 * KiB;
constexpr size_t OFF_WIN0 = 79 * MiB, OFF_WIN1 = 83 * MiB, OFF_WOUT0 = 87 * MiB, OFF_WOUT1 = 89 * MiB;
constexpr size_t OFF_WQB = 91 * MiB, OFF_WKVB = 91 * MiB + 512 * KiB;
constexpr size_t OFF_W1K = 92 * MiB, OFF_W1V = 93 * MiB;
constexpr size_t OFF_XBA = 94 * MiB, OFF_ACTA = 126 * MiB;
constexpr size_t OFF_XBB = 126 * MiB, OFF_ACTB = 158 * MiB;
constexpr size_t OFF_QO = 126 * MiB;
constexpr size_t OFF_QC = 158 * MiB;
constexpr size_t OFF_OACC = 208 * MiB;
constexpr size_t OFF_KV8 = 174 * MiB;
constexpr size_t SZ_KV = 4 * MiB;
constexpr size_t OFF_QF = 126 * MiB;
constexpr size_t OFF_KF = 146 * MiB;
constexpr size_t OFF_VF = 166 * MiB;
constexpr size_t OFF_QM = 182 * MiB;
constexpr size_t OFF_VM = 206 * MiB;
constexpr size_t OFF_KM = 222 * MiB;
constexpr size_t OFF_CQ = 13 * MiB;
constexpr size_t OFF_CKV = 24 * MiB;
constexpr size_t OFF_O1 = 13 * MiB;
constexpr size_t OFF_QAUG = 246 * MiB;
constexpr size_t WS_END = 256 * MiB;

__device__ __forceinline__ unsigned f2bf(float f) { unsigned u = __builtin_bit_cast(unsigned, f); return (u + 0x7fffu + ((u >> 16) & 1u)) >> 16; }
__device__ __forceinline__ unsigned pk2(float lo, float hi) { f32x2 v = {lo, hi}; bf16x2_t b = __builtin_convertvector(v, bf16x2_t); return __builtin_bit_cast(unsigned, b); }
__device__ __forceinline__ float bflo(unsigned w) { return __builtin_bit_cast(float, w << 16); }
__device__ __forceinline__ float bfhi(unsigned w) { return __builtin_bit_cast(float, w & 0xffff0000u); }
__device__ __forceinline__ float bf2f(bf16 h) { return __builtin_bit_cast(float, (unsigned)h << 16); }
__device__ __forceinline__ float ex2(float x) { return __builtin_amdgcn_exp2f(x); }
__device__ __forceinline__ float rsq(float x) { return __builtin_amdgcn_rsqf(x); }
#define LDS_WAIT() asm volatile("s_waitcnt lgkmcnt(0)" ::: "memory")
#define VM_WAIT() asm volatile("s_waitcnt vmcnt(0)" ::: "memory")

template <int DQK> __device__ __forceinline__ size_t ktile_off(int t, int c) { return (size_t)(t >> 6) * (64 * DQK) + c * 512 + (t & 63) * 8; }
__device__ __forceinline__ size_t vtile_off(int t, int d) { return (size_t)(t >> 6) * 4096 + (d >> 5) * 2048 + (t & 63) * 32 + (d & 31); }
namespace pg8 {
constexpr int BM = 256, BK = 64, HALF = 128, HTB = HALF * BK * 2, STAGE_BYTES = 8 * HTB, NXCD = 8, WGM = 8;
__device__ __forceinline__ int lds_byte(int r, int c) { const int st = (r >> 4) * 2 + (c >> 5), rr = r & 15, cc = c & 31, ob = rr * 64 + cc * 2; return st * 1024 + (ob ^ (((ob >> 9) & 1) << 5)); }
__device__ __forceinline__ void stage_rc(int b, int& R, int& C) { const int st = b / 1024, sb = b % 1024, swz = sb ^ (((sb >> 9) & 1) << 5); R = (st >> 1) * 16 + swz / 64; C = (st & 1) * 32 + (swz % 64) / 2; }
__device__ __forceinline__ int perm32(int rho) { const int n = rho >> 4, i = rho & 15; return 8 * (i >> 2) + 4 * n + (i & 3); }
struct Unit { int pm, pn; };
struct StaticOrder {
    int nM, nN, nwg, G, c;
    __device__ __forceinline__ void init(int M, int N, int G_, int c_) { nM = M / BM; nN = N / BM; nwg = nM * nN; G = G_; c = c_; }
    __device__ __forceinline__ bool next(int i, Unit& u) const {
        const int L = i * G + c; if (L >= nwg) return false;
        int wgid = L; { const int q = nwg / NXCD, r = nwg % NXCD, xcd = wgid % NXCD, off = wgid / NXCD; wgid = (xcd < r ? xcd * (q + 1) : r * (q + 1) + (xcd - r) * q) + off; }
        const int nig = WGM * nN, gid = wgid / nig, fm = gid * WGM, gsz = (nM - fm) < WGM ? (nM - fm) : WGM;
        u.pm = fm + ((wgid % nig) % gsz); u.pn = (wgid % nig) / gsz; return true;
    }
};
}

typedef const float* fptr_t;
typedef LAS fptr_t* InTab;
enum { EPI_GATEUP = 0, EPI_RESID = 1, EPI_L0IN = 2, EPI_L1IN = 3, EPI_QB = 4, EPI_KVB = 5, EPI_CMP1 = 6 };
struct GemmDesc {
    const bf16* A; const bf16* Bt; int M, N, K, lda;
    int ep;
    float* out;
    InTab in;
    unsigned char* ws;
};

__device__ __forceinline__ float row_rstd16(const GAS float* ssq, int r, float inv_n) {
    const f32x4 a = *(const GAS f32x4*)(ssq + (size_t)r * 4);
    return rsq(((a[0] + a[1]) + (a[2] + a[3])) * inv_n + EPS);
}
__device__ __forceinline__ float row_rstd4(const GAS float* ssq, int r, float inv_n) {
    const f32x4 a = *(const GAS f32x4*)(ssq + (size_t)r * 4);
    return rsq(((a[0] + a[1]) + (a[2] + a[3])) * inv_n + EPS);
}
__device__ __forceinline__ float silu_f(float g) { return g * __builtin_amdgcn_rcpf(1.0f + ex2(-g * LOG2E)); }
__device__ __forceinline__ v4u pack8(const f32x4 a, const f32x4 b) { v4u w; w.x = pk2(a[0], a[1]); w.y = pk2(a[2], a[3]); w.z = pk2(b[0], b[1]); w.w = pk2(b[2], b[3]); return w; }

__device__ __forceinline__ void head_norm_rope(f32x4 (&v)[2][2], f32x4 (&w)[2][2], int mode, const f32x4 (&gn)[2][2], const GAS float* cosT, const GAS float* sinT, int t, int fq) {
    if (mode == 0) return;
    float ss = 0.f;
#pragma unroll
    for (int bj = 0; bj < 2; ++bj)
#pragma unroll
        for (int n = 0; n < 2; ++n) ss += (v[bj][n][0] * v[bj][n][0] + v[bj][n][1] * v[bj][n][1]) + (v[bj][n][2] * v[bj][n][2] + v[bj][n][3] * v[bj][n][3]);
    ss += __shfl_xor(ss, 16); ss += __shfl_xor(ss, 32);
    const float r = rsq(ss * (1.0f / 64.0f) + EPS);
#pragma unroll
    for (int bj = 0; bj < 2; ++bj)
#pragma unroll
        for (int n = 0; n < 2; ++n) v[bj][n] = v[bj][n] * r * gn[bj][n];
    if (mode == 2) {
#pragma unroll
        for (int n = 0; n < 2; ++n) {
            const f32x4 c = *(const GAS f32x4*)(cosT + (size_t)t * 32 + 8 * fq + 4 * n), s = *(const GAS f32x4*)(sinT + (size_t)t * 32 + 8 * fq + 4 * n);
            w[0][n] = v[0][n] * c - v[1][n] * s; w[1][n] = v[1][n] * c + v[0][n] * s;
        }
    }
}

template <int EPI> __device__ __forceinline__ void gemm_epilogue(const GemmDesc& g_, const f32x4 (&acc)[2][2][4][2], const pg8::Unit& u, int wr, int wc, int fr, int fq) {
    asm volatile("" : "+v"(fr), "+v"(fq));
    GemmDesc g = g_;
    { unsigned long long w_ = (unsigned long long)g.ws; asm volatile("" : "+s"(w_)); g.ws = (unsigned char*)w_; }
    { unsigned t_ = (unsigned)(uintptr_t)g.in; asm volatile("" : "+s"(t_)); g.in = (InTab)(uintptr_t)t_; }
    const int rbase = u.pm * 256 + wr * 64 + fr;
    if constexpr (EPI == EPI_GATEUP) {
        const int col0 = u.pn * 128 + wc * 32 + 8 * fq;
        float rsv[8];
#pragma unroll
        for (int i = 0; i < 8; ++i) rsv[i] = row_rstd16((const GAS float*)(g.ws + OFF_SSQ), rbase + (i >> 2) * 128 + (i & 3) * 16, 1.0f / 1024.0f);
#pragma unroll
        for (int ai = 0; ai < 2; ++ai)
#pragma unroll
            for (int m = 0; m < 4; ++m) {
                const int r = rbase + ai * 128 + m * 16; const float rs = rsv[ai * 4 + m];
                const float k1 = -rs * LOG2E, rs2 = rs * rs;
                f32x4 a[2];
#pragma unroll
                for (int n = 0; n < 2; ++n) { const f32x4 ga = acc[ai][0][m][n], ua = acc[ai][1][m][n]; const f32x4 x = ga * k1, gu = ga * ua;
                    const f32x4 rc = {__builtin_amdgcn_rcpf(1.0f + ex2(x[0])), __builtin_amdgcn_rcpf(1.0f + ex2(x[1])), __builtin_amdgcn_rcpf(1.0f + ex2(x[2])), __builtin_amdgcn_rcpf(1.0f + ex2(x[3]))};
                    a[n] = gu * (rc * rs2); }
                *(GAS v4u*)((GAS bf16*)(g.ws + ((g.ep & 1) ? OFF_ACTB : OFF_ACTA)) + (size_t)r * FF + col0) = pack8(a[0], a[1]);
            }
    } else if constexpr (EPI == EPI_RESID) {
        const GAS float* xin32 = (const GAS float*)g.in[0]; GAS float* xout = (GAS float*)g.out;
        const GAS bf16* xsrc = (const GAS bf16*)(g.ws + ((g.ep & 16) ? OFF_XBB : OFF_XBA)); GAS bf16* xb = (GAS bf16*)(g.ws + ((g.ep & 2) ? OFF_XBB : OFF_XBA)); GAS float* ssq_out = (GAS float*)(g.ws + OFF_SSQ);
        const float alpha = (g.ep & 4) ? 1.0f : 0.5f; const bool first = (g.ep & 1) != 0, last = (g.ep & 32) != 0;
        LAS float* red = (LAS float*)((LAS unsigned char*)g.in - 1024 + 2048);
#pragma unroll
        for (int ai = 0; ai < 2; ++ai)
#pragma unroll
            for (int m = 0; m < 4; ++m) {
                const int r = rbase + ai * 128 + m * 16; float ss = 0.f;
#pragma unroll
                for (int bj = 0; bj < 2; ++bj) {
                    const size_t off = (size_t)r * DM + u.pn * 256 + bj * 128 + wc * 32 + 8 * fq;
                    f32x4 xo0, xo1;
                    if (first) { xo0 = *(const GAS f32x4*)(xin32 + off); xo1 = *(const GAS f32x4*)(xin32 + off + 4); }
                    else { const v4u w = *(const GAS v4u*)(xsrc + off); xo0 = (f32x4){bflo(w.x), bfhi(w.x), bflo(w.y), bfhi(w.y)}; xo1 = (f32x4){bflo(w.z), bfhi(w.z), bflo(w.w), bfhi(w.w)}; }
                    const f32x4 xn0 = xo0 + acc[ai][bj][m][0] * alpha, xn1 = xo1 + acc[ai][bj][m][1] * alpha;
                    if (last) { *(GAS f32x4*)(xout + off) = xn0; *(GAS f32x4*)(xout + off + 4) = xn1; }
                    else { const v4u w = pack8(xn0, xn1); *(GAS v4u*)(xb + off) = w;
                        const f32x4 q0 = {bflo(w.x), bfhi(w.x), bflo(w.y), bfhi(w.y)}, q1 = {bflo(w.z), bfhi(w.z), bflo(w.w), bfhi(w.w)};
                        ss += ((q0[0] * q0[0] + q0[1] * q0[1]) + (q0[2] * q0[2] + q0[3] * q0[3])) + ((q1[0] * q1[0] + q1[1] * q1[1]) + (q1[2] * q1[2] + q1[3] * q1[3])); }
                }
                ss += __shfl_xor(ss, 16); ss += __shfl_xor(ss, 32);
                if (!last && fq == 0) red[(wr * 128 + ai * 64 + m * 16 + fr) * 4 + wc] = ss;
            }
        if (!last) {
            asm volatile("s_waitcnt lgkmcnt(0)\n\ts_barrier" ::: "memory");
            const int tid_ = wr * 256 + wc * 64 + (fq * 16 + fr);
            if (tid_ < 256) { const int rr = tid_; const int wr2 = rr >> 7, rem = rr & 127, ai2 = rem >> 6, m2 = (rem >> 4) & 3, fr2 = rem & 15;
                const f32x4 p = *(const LAS f32x4*)(red + rr * 4);
                ssq_out[(size_t)(u.pm * 256 + wr2 * 64 + ai2 * 128 + m2 * 16 + fr2) * 4 + u.pn] = (p[0] + p[1]) + (p[2] + p[3]); }
            asm volatile("s_waitcnt lgkmcnt(0)\n\ts_barrier" ::: "memory");
        }
    } else if constexpr (EPI == EPI_L0IN) {
        const int pn = u.pn, hh = wc; int mode; const GAS float* gain = nullptr; GAS bf16* dst; GAS bf16* dst2 = nullptr; int tokmajor, pitch, colofs, isv_ = 0; float sc = 1.f;
        GAS unsigned char* ws = (GAS unsigned char*)g.ws;
        if (pn < 2) { mode = 2; gain = (const GAS float*)g.in[8]; dst = (GAS bf16*)(ws + OFF_QO); dst2 = (GAS bf16*)(ws + OFF_QC); tokmajor = 1; pitch = 1024; colofs = (pn * 4 + hh) * 64; sc = C2_64; }
        else if (pn < 4) { mode = 2; gain = (const GAS float*)g.in[18]; dst = (GAS bf16*)(ws + OFF_QO); tokmajor = 1; pitch = 1024; colofs = 512 + ((pn - 2) * 4 + hh) * 64; sc = C2_64; }
        else { const int isv = hh >> 1, hk = hh & 1; const int tens = (pn - 4) * 2 + isv; isv_ = isv;
            dst = (GAS bf16*)(ws + OFF_KV8 + (size_t)tens * SZ_KV) + (size_t)hk * SEQ * 64; tokmajor = 0; pitch = 64; colofs = 0;
            if (isv || pn == 4) mode = 0; else { mode = 2; gain = (const GAS float*)((pn == 5) ? g.in[10] : (pn == 6) ? g.in[11] : g.in[19]); } }
        const GAS float* cosT = (const GAS float*)(ws + OFF_ROPE64C); const GAS float* sinT = (const GAS float*)(ws + OFF_ROPE64S);
        f32x4 gn[2][2];
#pragma unroll
        for (int bj = 0; bj < 2; ++bj)
#pragma unroll
            for (int n = 0; n < 2; ++n) { gn[bj][n] = (f32x4){1.f, 1.f, 1.f, 1.f}; if (mode != 0) gn[bj][n] = *(const GAS f32x4*)(gain + 32 * bj + 8 * fq + 4 * n); }
#pragma unroll
        for (int ai = 0; ai < 2; ++ai)
#pragma unroll
            for (int m = 0; m < 4; ++m) {
                const int r = rbase + ai * 128 + m * 16; const float rs = row_rstd16((const GAS float*)(g.ws + OFF_SSQ), r, 1.0f / 1024.0f);
                const int t = r & (SEQ - 1), b = r >> 13;
                f32x4 v[2][2], w[2][2];
#pragma unroll
                for (int bj = 0; bj < 2; ++bj)
#pragma unroll
                    for (int n = 0; n < 2; ++n) v[bj][n] = acc[ai][bj][m][n] * rs;
                head_norm_rope(v, w, mode, gn, cosT, sinT, t, fq);
                GAS bf16 *plo, *phi;
                if (tokmajor) { plo = dst + (size_t)r * pitch + colofs + 8 * fq; phi = plo + 32; }
                else if (pn == 4) { plo = dst + ((size_t)b * 2 * SEQ + t) * 64 + 8 * fq; phi = plo + 32; }
                else if (isv_) { GAS bf16* sl = dst + (size_t)b * 2 * SEQ * 64; plo = sl + vtile_off(t, 8 * fq); phi = sl + vtile_off(t, 32 + 8 * fq); }
                else { GAS bf16* sl = dst + (size_t)b * 2 * SEQ * 64; plo = sl + ktile_off<64>(t, fq); phi = sl + ktile_off<64>(t, 4 + fq); }
                if (mode == 2) {
                    *(GAS v4u*)(plo) = pack8(w[0][0] * sc, w[0][1] * sc); *(GAS v4u*)(phi) = pack8(w[1][0] * sc, w[1][1] * sc);
                    if (dst2) { GAS bf16* rp2 = dst2 + (size_t)r * 512 + colofs; *(GAS v4u*)(rp2 + 8 * fq) = pack8(v[0][0] * sc, v[0][1] * sc); *(GAS v4u*)(rp2 + 32 + 8 * fq) = pack8(v[1][0] * sc, v[1][1] * sc); }
                } else {
                    *(GAS v4u*)(plo) = pack8(v[0][0], v[0][1]); *(GAS v4u*)(phi) = pack8(v[1][0], v[1][1]);
                }
            }
    } else if constexpr (EPI == EPI_L1IN) {
        const int pn = u.pn; GAS unsigned char* ws = (GAS unsigned char*)g.ws;
        if (pn < 6) {
            const int hh = wc, h = (pn & 1) * 4 + hh; const int which = pn >> 1;
            const GAS float* gain = (const GAS float*)(which == 0 ? g.in[33] : g.in[34]); const int mode = which == 2 ? 0 : 1; const float sc = which == 0 ? C2_64 : 1.f;
            f32x4 gn[2][2];
#pragma unroll
            for (int bj = 0; bj < 2; ++bj)
#pragma unroll
                for (int n = 0; n < 2; ++n) { gn[bj][n] = (f32x4){1.f, 1.f, 1.f, 1.f}; if (mode != 0) gn[bj][n] = *(const GAS f32x4*)(gain + 32 * bj + 8 * fq + 4 * n); }
#pragma unroll
            for (int ai = 0; ai < 2; ++ai)
#pragma unroll
                for (int m = 0; m < 4; ++m) {
                    const int r = rbase + ai * 128 + m * 16; const float rs = row_rstd16((const GAS float*)(g.ws + OFF_SSQ), r, 1.0f / 1024.0f);
                    const int t = r & (SEQ - 1), b = r >> 13;
                    f32x4 v[2][2], w[2][2];
#pragma unroll
                    for (int bj = 0; bj < 2; ++bj)
#pragma unroll
                        for (int n = 0; n < 2; ++n) v[bj][n] = acc[ai][bj][m][n] * rs;
                    head_norm_rope(v, w, mode, gn, nullptr, nullptr, t, fq);
                    GAS bf16 *plo, *phi;
                    if (which == 0) { plo = (GAS bf16*)(ws + OFF_QF) + ((size_t)r * 8 + h) * 80 + 8 * fq; phi = plo + 32; }
                    else if (which == 1) { GAS bf16* sl = (GAS bf16*)(ws + OFF_KF) + ((size_t)b * 8 + h) * SEQ * 80; plo = sl + ktile_off<80>(t, fq); phi = sl + ktile_off<80>(t, 4 + fq); }
                    else { GAS bf16* sl = (GAS bf16*)(ws + OFF_VF) + ((size_t)b * 8 + h) * SEQ * 64; plo = sl + vtile_off(t, 8 * fq); phi = sl + vtile_off(t, 32 + 8 * fq); }
                    *(GAS v4u*)(plo) = pack8(v[0][0] * sc, v[0][1] * sc); *(GAS v4u*)(phi) = pack8(v[1][0] * sc, v[1][1] * sc);
                }
        } else {
#pragma unroll
            for (int ai = 0; ai < 2; ++ai)
#pragma unroll
                for (int m = 0; m < 4; ++m) {
                    const int r = rbase + ai * 128 + m * 16; const float rs = row_rstd16((const GAS float*)(g.ws + OFF_SSQ), r, 1.0f / 1024.0f);
                    f32x4 v[2][2];
#pragma unroll
                    for (int bj = 0; bj < 2; ++bj)
#pragma unroll
                        for (int n = 0; n < 2; ++n) v[bj][n] = acc[ai][bj][m][n] * rs;
                    float s0 = 0.f, s1 = 0.f;
#pragma unroll
                    for (int n = 0; n < 2; ++n) { s0 += (v[0][n][0] * v[0][n][0] + v[0][n][1] * v[0][n][1]) + (v[0][n][2] * v[0][n][2] + v[0][n][3] * v[0][n][3]);
                                                  s1 += (v[1][n][0] * v[1][n][0] + v[1][n][1] * v[1][n][1]) + (v[1][n][2] * v[1][n][2] + v[1][n][3] * v[1][n][3]); }
                    if (pn == 6) {
                        GAS bf16* rowp = (GAS bf16*)(ws + OFF_CQ) + (size_t)r * 256 + wc * 32 + 8 * fq;
                        *(GAS v4u*)(rowp) = pack8(v[0][0], v[0][1]); *(GAS v4u*)(rowp + 128) = pack8(v[1][0], v[1][1]);
                        float ss = s0 + s1; ss += __shfl_xor(ss, 16); ss += __shfl_xor(ss, 32);
                        if (fq == 0) ((GAS float*)(ws + OFF_SSQCQ))[(size_t)r * 4 + wc] = ss;
                    } else {
                        GAS bf16* rowp = (GAS bf16*)(ws + OFF_CKV) + (size_t)r * 128 + wc * 32 + 8 * fq;
                        *(GAS v4u*)(rowp) = pack8(v[0][0], v[0][1]);
                        float ss = s0; ss += __shfl_xor(ss, 16); ss += __shfl_xor(ss, 32);
                        if (fq == 0) ((GAS float*)(ws + OFF_SSQCKV))[(size_t)r * 4 + wc] = ss;
                        if (wc == 0) { *(GAS v4u*)((GAS bf16*)(ws + OFF_KR) + (size_t)r * 32 + 8 * fq) = pack8(v[1][0], v[1][1]);
                            float sr = s1; sr += __shfl_xor(sr, 16); sr += __shfl_xor(sr, 32); if (fq == 0) ((GAS float*)(ws + OFF_SSQKR))[r] = sr; }
                        if (wc == 1 && fq == 0) { GAS float* fp = (GAS float*)(ws + OFF_FRAW) + (size_t)(r >> 13) * 8 * SEQ + (r & (SEQ - 1));
#pragma unroll
                            for (int hh2 = 0; hh2 < 4; ++hh2) { fp[(size_t)hh2 * SEQ] = v[1][0][hh2]; fp[(size_t)(4 + hh2) * SEQ] = v[1][1][hh2]; } }
                    }
                }
        }
    } else if constexpr (EPI == EPI_QB) {
        GAS unsigned char* ws = (GAS unsigned char*)g.ws;
#pragma unroll
        for (int ai = 0; ai < 2; ++ai)
#pragma unroll
            for (int m = 0; m < 4; ++m) {
                const int r = rbase + ai * 128 + m * 16; const float rs = row_rstd4((const GAS float*)(ws + OFF_SSQCQ), r, 1.0f / 256.0f);
                GAS bf16* rowp = (GAS bf16*)(ws + OFF_QM) + (size_t)r * 768 + u.pn * 256 + wc * 32 + 8 * fq;
                *(GAS v4u*)(rowp) = pack8(acc[ai][0][m][0] * rs, acc[ai][0][m][1] * rs); *(GAS v4u*)(rowp + 128) = pack8(acc[ai][1][m][0] * rs, acc[ai][1][m][1] * rs);
            }
    } else if constexpr (EPI == EPI_KVB) {
        GAS unsigned char* ws = (GAS unsigned char*)g.ws; const int h = u.pn * 2 + (wc & 1); const bool isv = wc >= 2;
        const GAS float* gk = (const GAS float*)g.in[40]; const GAS float* c32 = (const GAS float*)(ws + OFF_ROPE32C); const GAS float* s32 = (const GAS float*)(ws + OFF_ROPE32S);
#pragma unroll
        for (int ai = 0; ai < 2; ++ai)
#pragma unroll
            for (int m = 0; m < 4; ++m) {
                const int r = rbase + ai * 128 + m * 16; const float rs = row_rstd4((const GAS float*)(ws + OFF_SSQCKV), r, 1.0f / 128.0f);
                const int t = r & (SEQ - 1), b = r >> 13;
                f32x4 v[2][2];
#pragma unroll
                for (int bj = 0; bj < 2; ++bj)
#pragma unroll
                    for (int n = 0; n < 2; ++n) v[bj][n] = acc[ai][bj][m][n] * rs;
                if (isv) {
                    GAS bf16* sl = (GAS bf16*)(ws + OFF_VM) + ((size_t)b * 8 + h) * SEQ * 64;
                    *(GAS v4u*)(sl + vtile_off(t, 8 * fq)) = pack8(v[0][0], v[0][1]); *(GAS v4u*)(sl + vtile_off(t, 32 + 8 * fq)) = pack8(v[1][0], v[1][1]);
                } else {
                    float ss = 0.f;
#pragma unroll
                    for (int bj = 0; bj < 2; ++bj)
#pragma unroll
                        for (int n = 0; n < 2; ++n) ss += (v[bj][n][0] * v[bj][n][0] + v[bj][n][1] * v[bj][n][1]) + (v[bj][n][2] * v[bj][n][2] + v[bj][n][3] * v[bj][n][3]);
                    ss += __shfl_xor(ss, 16); ss += __shfl_xor(ss, 32);
                    const float rn = rsq((ss + ((const GAS float*)(ws + OFF_SSQKR))[r]) * (1.0f / 96.0f) + EPS);
                    GAS bf16* sl = (GAS bf16*)(ws + OFF_KM) + ((size_t)b * 8 + h) * SEQ * 96;
#pragma unroll
                    for (int bj = 0; bj < 2; ++bj) { const f32x4 g0 = *(const GAS f32x4*)(gk + 32 * bj + 8 * fq), g1 = *(const GAS f32x4*)(gk + 32 * bj + 8 * fq + 4);
                        *(GAS v4u*)(sl + ktile_off<96>(t, 4 * bj + fq)) = pack8(v[bj][0] * rn * g0, v[bj][1] * rn * g1); }
                    if (fq < 2) {
                        const GAS bf16* kr = (const GAS bf16*)(ws + OFF_KR) + (size_t)r * 32; const v4u wa = *(const GAS v4u*)(kr + 8 * fq), wb = *(const GAS v4u*)(kr + 16 + 8 * fq);
                        const f32x4 a0 = {bflo(wa.x), bfhi(wa.x), bflo(wa.y), bfhi(wa.y)}, a1 = {bflo(wa.z), bfhi(wa.z), bflo(wa.w), bfhi(wa.w)};
                        const f32x4 b0 = {bflo(wb.x), bfhi(wb.x), bflo(wb.y), bfhi(wb.y)}, b1 = {bflo(wb.z), bfhi(wb.z), bflo(wb.w), bfhi(wb.w)};
                        const f32x4 ga0 = *(const GAS f32x4*)(gk + 64 + 8 * fq), ga1 = *(const GAS f32x4*)(gk + 68 + 8 * fq), gb0 = *(const GAS f32x4*)(gk + 80 + 8 * fq), gb1 = *(const GAS f32x4*)(gk + 84 + 8 * fq);
                        const f32x4 c0 = *(const GAS f32x4*)(c32 + (size_t)t * 16 + 8 * fq), c1 = *(const GAS f32x4*)(c32 + (size_t)t * 16 + 8 * fq + 4), s0 = *(const GAS f32x4*)(s32 + (size_t)t * 16 + 8 * fq), s1 = *(const GAS f32x4*)(s32 + (size_t)t * 16 + 8 * fq + 4);
                        const f32x4 xa0 = a0 * rn * ga0, xa1 = a1 * rn * ga1, xb0 = b0 * rn * gb0, xb1 = b1 * rn * gb1;
                        *(GAS v4u*)(sl + ktile_off<96>(t, 8 + fq)) = pack8(xa0 * c0 - xb0 * s0, xa1 * c1 - xb1 * s1);
                        *(GAS v4u*)(sl + ktile_off<96>(t, 10 + fq)) = pack8(xb0 * c0 + xa0 * s0, xb1 * c1 + xa1 * s1);
                    }
                }
            }
    } else {
        const GAS float* bias = (const GAS float*)(g.ws + OFF_CBIAS) + g.ep * 256; GAS bf16* o0 = (GAS bf16*)(g.ws + OFF_HID) + (size_t)g.ep * 2048 * 256;
#pragma unroll
        for (int bj = 0; bj < 2; ++bj) {
            const int col0 = bj * 128 + wc * 32 + 8 * fq; const f32x4 b0 = *(const GAS f32x4*)(bias + col0), b1 = *(const GAS f32x4*)(bias + col0 + 4);
#pragma unroll
            for (int ai = 0; ai < 2; ++ai)
#pragma unroll
                for (int m = 0; m < 4; ++m) {
                    const int r = rbase + ai * 128 + m * 16; const f32x4 x0 = acc[ai][bj][m][0] + b0, x1 = acc[ai][bj][m][1] + b1;
                    const f32x4 y0 = {silu_f(x0[0]), silu_f(x0[1]), silu_f(x0[2]), silu_f(x0[3])}, y1 = {silu_f(x1[0]), silu_f(x1[1]), silu_f(x1[2]), silu_f(x1[3])};
                    *(GAS v4u*)(o0 + (size_t)r * 256 + col0) = pack8(y0, y1);
                }
        }
    }
}

template <int EPI> __device__ __forceinline__ void gemm_phase(LAS unsigned char* lds, const GemmDesc& g, int G, int cblk) {
    constexpr bool PERM = true;
    using namespace pg8;
    int tid = threadIdx.x; asm volatile("" : "+v"(tid));
    const int wid = __builtin_amdgcn_readfirstlane(tid >> 6), lane = tid & 63, wr = wid >> 2, wc = wid & 3, fr = lane & 15, fq = lane >> 4;
    const int K = g.K, nt = K / BK, lda = g.lda;
    StaticOrder S; S.init(g.M, g.N, G, cblk);
    unsigned voffA[2], voffB[2];
#pragma unroll
    for (int i = 0; i < 2; ++i) { int R, C; stage_rc(tid * 16 + i * 8192, R, C); const int Rb = PERM ? ((R & ~31) + perm32(R & 31)) : R;
        voffA[i] = (unsigned)(R * lda + C) * 2u; voffB[i] = (unsigned)(Rb * K + C) * 2u; }
    const size_t kstep = (size_t)(BK * 2);
    const size_t hstepA = (size_t)HALF * lda * 2, hstepB = (size_t)HALF * K * 2;
    const size_t tstepA = 2 * hstepA, tstepB = 2 * hstepB;
    const unsigned ldsw = (unsigned)wid * 1024u;
    const int aoff = lds_byte(wr * 64 + fr, fq * 8), boff = lds_byte(wc * 32 + fr, fq * 8);
#define PG8_SA(b, h) (((b) * 2 + (h)) * HTB)
#define PG8_SB(b, h) ((4 + (b) * 2 + (h)) * HTB)
#define PG8_STAGE(bufoff, gbase, voff) do { _Pragma("unroll") for (int _i = 0; _i < 2; ++_i) \
        __builtin_amdgcn_global_load_lds((const unsigned*)((const char*)(gbase) + (voff)[_i]), (LAS unsigned*)(lds + (bufoff) + ldsw + _i * 8192), 16, 0, 0); } while (0)
#define PG8_LDA(dst, b, h) do { _Pragma("unroll") for (int m = 0; m < 4; ++m) _Pragma("unroll") for (int k = 0; k < 2; ++k) dst[m][k] = *(const LAS bf16x8*)(lds + PG8_SA(b, h) + aoff + m * 2048 + k * 1024); } while (0)
#define PG8_LDB(dst, b, h) do { _Pragma("unroll") for (int n = 0; n < 2; ++n) _Pragma("unroll") for (int k = 0; k < 2; ++k) dst[n][k] = *(const LAS bf16x8*)(lds + PG8_SB(b, h) + boff + n * 2048 + k * 1024); } while (0)
#define PG8_MMA(ai, bj, At, Bt) do { __builtin_amdgcn_s_setprio(1); _Pragma("unroll") for (int m = 0; m < 4; ++m) _Pragma("unroll") for (int n = 0; n < 2; ++n) _Pragma("unroll") for (int k = 0; k < 2; ++k) \
        acc[ai][bj][m][n] = __builtin_amdgcn_mfma_f32_16x16x32_bf16(Bt[n][k], At[m][k], acc[ai][bj][m][n], 0, 0, 0); __builtin_amdgcn_s_setprio(0); } while (0)
#define PG8_WAIT_V(n) asm volatile("s_waitcnt vmcnt(" #n ")" ::: "memory")
#define PG8_WAIT_L(n) asm volatile("s_waitcnt lgkmcnt(" #n ")" ::: "memory")
#define PG8_BAR __builtin_amdgcn_s_barrier()
#define PG8_SCHED __builtin_amdgcn_sched_barrier(0)
    Unit cur, nxt; int ui = 0;
    if (!S.next(0, cur)) return;
    f32x4 acc[2][2][4][2];
#pragma unroll
    for (int a = 0; a < 2; ++a)
#pragma unroll
        for (int b = 0; b < 2; ++b)
#pragma unroll
            for (int m = 0; m < 4; ++m)
#pragma unroll
                for (int n = 0; n < 2; ++n) acc[a][b][m][n] = (f32x4){0.f, 0.f, 0.f, 0.f};
    bf16x8 At[4][2], B0[2][2], B1[2][2];
    const char* cA = (const char*)g.A + (size_t)cur.pm * tstepA; const char* cB = (const char*)g.Bt + (size_t)cur.pn * tstepB;
    PG8_STAGE(PG8_SB(0, 0), cB, voffB); PG8_STAGE(PG8_SB(0, 1), cB + hstepB, voffB); PG8_STAGE(PG8_SA(0, 0), cA, voffA); PG8_STAGE(PG8_SA(0, 1), cA + hstepA, voffA);
    if (wr == 1) PG8_BAR;
    PG8_WAIT_V(2); PG8_BAR;
    PG8_STAGE(PG8_SB(1, 0), cB + kstep, voffB); PG8_STAGE(PG8_SA(1, 0), cA + kstep, voffA); PG8_STAGE(PG8_SB(1, 1), cB + hstepB + kstep, voffB);
    PG8_WAIT_V(6); PG8_BAR;
    for (;;) {
        const bool has_next = S.next(ui + 1, nxt);
        const char* nA = has_next ? (const char*)g.A + (size_t)nxt.pm * tstepA : cA; const char* nB = has_next ? (const char*)g.Bt + (size_t)nxt.pn * tstepB : cB;
        for (int t = 0; t < nt; t += 2) {
            const bool last = (t == nt - 2);
            const char* a1 = cA + (size_t)(t + 1) * kstep;
            const char* a2 = last ? nA : cA + (size_t)(t + 2) * kstep; const char* b2 = last ? nB : cB + (size_t)(t + 2) * kstep;
            const char* a3 = a2 + kstep; const char* b3 = b2 + kstep;
            PG8_LDB(B0, 0, 0); PG8_LDB(B1, 0, 1); PG8_SCHED; PG8_LDA(At, 0, 0); PG8_STAGE(PG8_SA(1, 1), a1 + hstepA, voffA);
            PG8_WAIT_V(8); PG8_WAIT_L(0); PG8_BAR; PG8_MMA(0, 0, At, B0); PG8_MMA(0, 1, At, B1); PG8_BAR; PG8_SCHED;
            PG8_LDA(At, 0, 1); PG8_STAGE(PG8_SB(0, 0), b2, voffB); PG8_STAGE(PG8_SB(0, 1), b2 + hstepB, voffB); PG8_STAGE(PG8_SA(0, 0), a2, voffA);
            PG8_WAIT_V(8); PG8_WAIT_L(0); PG8_BAR; PG8_MMA(1, 0, At, B0); PG8_MMA(1, 1, At, B1); PG8_BAR; PG8_SCHED;
            PG8_LDB(B0, 1, 0); PG8_LDB(B1, 1, 1); PG8_SCHED; PG8_LDA(At, 1, 0); PG8_STAGE(PG8_SA(0, 1), a2 + hstepA, voffA);
            PG8_WAIT_V(8); PG8_WAIT_L(0); PG8_BAR; PG8_MMA(0, 0, At, B0); PG8_MMA(0, 1, At, B1); PG8_BAR; PG8_SCHED;
            PG8_LDA(At, 1, 1); PG8_STAGE(PG8_SB(1, 0), b3, voffB); PG8_STAGE(PG8_SB(1, 1), b3 + hstepB, voffB); PG8_STAGE(PG8_SA(1, 0), a3, voffA);
            PG8_WAIT_V(8); PG8_WAIT_L(0); PG8_BAR; PG8_MMA(1, 0, At, B0); PG8_MMA(1, 1, At, B1); PG8_BAR; PG8_SCHED;
        }
        if (wr == 0) PG8_BAR;
        gemm_epilogue<EPI>(g, acc, cur, wr, wc, fr, fq);
        if (!has_next) break;
#pragma unroll
        for (int a = 0; a < 2; ++a)
#pragma unroll
            for (int b = 0; b < 2; ++b)
#pragma unroll
                for (int m = 0; m < 4; ++m)
#pragma unroll
                    for (int n = 0; n < 2; ++n) acc[a][b][m][n] = (f32x4){0.f, 0.f, 0.f, 0.f};
        cur = nxt; cA = nA; cB = nB; ++ui;
        if (wr == 1) PG8_BAR;
    }
    PG8_WAIT_V(0);
    PG8_BAR;
}

template <int EPI> __device__ __forceinline__ void gemm_half_unit(LAS unsigned char* lds, const GemmDesc& g, int pm, int h, int pn) {
    static_assert(EPI == EPI_GATEUP || EPI == EPI_CMP1, "half units: gate/up and compress layer 1");
    using namespace pg8;
    int tid = threadIdx.x; asm volatile("" : "+v"(tid));
    const int wid = __builtin_amdgcn_readfirstlane(tid >> 6), lane = tid & 63, wr = wid >> 2, wc = wid & 3; int fr = lane & 15, fq = lane >> 4;
    const int K = g.K, nt = K / BK, lda = g.lda;
    unsigned voffA[2], voffB[2];
#pragma unroll
    for (int i = 0; i < 2; ++i) { int R, C; stage_rc(tid * 16 + i * 8192, R, C); const int Rb = (R & ~31) + perm32(R & 31);
        voffA[i] = (unsigned)(R * lda + C) * 2u; voffB[i] = (unsigned)(Rb * K + C) * 2u; }
    const size_t kstep = (size_t)(BK * 2);
    const size_t hstepA = (size_t)HALF * lda * 2, hstepB = (size_t)HALF * K * 2;
    const unsigned ldsw = (unsigned)wid * 1024u;
    const int aoff = lds_byte(wr * 64 + fr, fq * 8), boff = lds_byte(wc * 32 + fr, fq * 8);
    const char* cA = (const char*)g.A + (size_t)pm * 2 * hstepA + (size_t)h * hstepA; const char* cB = (const char*)g.Bt + (size_t)pn * 2 * hstepB;
    f32x4 acc[2][4][2];
#pragma unroll
    for (int b = 0; b < 2; ++b)
#pragma unroll
        for (int m = 0; m < 4; ++m)
#pragma unroll
            for (int n = 0; n < 2; ++n) acc[b][m][n] = (f32x4){0.f, 0.f, 0.f, 0.f};
    bf16x8 At[4][2], B0[2][2], B1[2][2];
#define PG8H_MMA(bj, At, Bt) do { __builtin_amdgcn_s_setprio(1); _Pragma("unroll") for (int m = 0; m < 4; ++m) _Pragma("unroll") for (int n = 0; n < 2; ++n) _Pragma("unroll") for (int k = 0; k < 2; ++k) \
        acc[bj][m][n] = __builtin_amdgcn_mfma_f32_16x16x32_bf16(Bt[n][k], At[m][k], acc[bj][m][n], 0, 0, 0); __builtin_amdgcn_s_setprio(0); } while (0)
#define PG8H_FILL(b, tile) do { const char* b_ = cB + (size_t)(tile) * kstep; const char* a_ = cA + (size_t)(tile) * kstep; \
        PG8_STAGE(PG8_SB(b, 0), b_, voffB); PG8_STAGE(PG8_SB(b, 1), b_ + hstepB, voffB); PG8_STAGE(PG8_SA(b, 0), a_, voffA); } while (0)
#define PG8H_STEP(b, tnext) do { PG8_LDB(B0, b, 0); PG8_LDB(B1, b, 1); PG8_LDA(At, b, 0); PG8_WAIT_L(0); PG8_BAR; PG8_SCHED; \
        if ((tnext) < nt) PG8H_FILL(b, tnext); \
        PG8_SCHED; PG8H_MMA(0, At, B0); PG8H_MMA(1, At, B1); PG8_SCHED; \
        if ((tnext) < nt) PG8_WAIT_V(6); else PG8_WAIT_V(0); \
        PG8_BAR; PG8_SCHED; } while (0)
    PG8H_FILL(0, 0); PG8H_FILL(1, 1);
    PG8_WAIT_V(6); PG8_BAR;
    for (int t = 0; t < nt; t += 2) { PG8H_STEP(0, t + 2); PG8H_STEP(1, t + 3); }
#undef PG8H_STEP
#undef PG8H_FILL
#undef PG8H_MMA
    asm volatile("" : "+v"(fr), "+v"(fq));
    unsigned char* ws = g.ws; { unsigned long long w_ = (unsigned long long)ws; asm volatile("" : "+s"(w_)); ws = (unsigned char*)w_; }
    const int rbase = pm * 256 + h * 128 + wr * 64 + fr;
    if constexpr (EPI == EPI_GATEUP) {
        const int col0 = pn * 128 + wc * 32 + 8 * fq;
#pragma unroll
        for (int m = 0; m < 4; ++m) {
            const int r = rbase + m * 16; const float rs = row_rstd16((const GAS float*)(ws + OFF_SSQ), r, 1.0f / 1024.0f);
            const float k1 = -rs * LOG2E, rs2 = rs * rs;
            f32x4 a[2];
#pragma unroll
            for (int n = 0; n < 2; ++n) { const f32x4 ga = acc[0][m][n], ua = acc[1][m][n]; const f32x4 x = ga * k1, gu = ga * ua;
                const f32x4 rc = {__builtin_amdgcn_rcpf(1.0f + ex2(x[0])), __builtin_amdgcn_rcpf(1.0f + ex2(x[1])), __builtin_amdgcn_rcpf(1.0f + ex2(x[2])), __builtin_amdgcn_rcpf(1.0f + ex2(x[3]))};
                a[n] = gu * (rc * rs2); }
            *(GAS v4u*)((GAS bf16*)(ws + ((g.ep & 1) ? OFF_ACTB : OFF_ACTA)) + (size_t)r * FF + col0) = pack8(a[0], a[1]);
        }
    } else {
        const GAS float* bias = (const GAS float*)(ws + OFF_CBIAS) + g.ep * 256; GAS bf16* o0 = (GAS bf16*)(ws + OFF_HID) + (size_t)g.ep * 2048 * 256;
#pragma unroll
        for (int bj = 0; bj < 2; ++bj) {
            const int col0 = bj * 128 + wc * 32 + 8 * fq; const f32x4 b0 = *(const GAS f32x4*)(bias + col0), b1 = *(const GAS f32x4*)(bias + col0 + 4);
#pragma unroll
            for (int m = 0; m < 4; ++m) {
                const int r = rbase + m * 16; const f32x4 x0 = acc[bj][m][0] + b0, x1 = acc[bj][m][1] + b1;
                const f32x4 y0 = {silu_f(x0[0]), silu_f(x0[1]), silu_f(x0[2]), silu_f(x0[3])}, y1 = {silu_f(x1[0]), silu_f(x1[1]), silu_f(x1[2]), silu_f(x1[3])};
                *(GAS v4u*)(o0 + (size_t)r * 256 + col0) = pack8(y0, y1);
            }
        }
    }
    PG8_WAIT_V(0);
    PG8_BAR;
#undef PG8_SA
#undef PG8_SB
#undef PG8_STAGE
#undef PG8_LDA
#undef PG8_LDB
#undef PG8_MMA
#undef PG8_WAIT_V
#undef PG8_WAIT_L
#undef PG8_BAR
#undef PG8_SCHED
}

#define XB_TMO      128
#define XB_XCNT(j)  (256  + 64 * (j))
#define XB_XSUB(j)  (1280 + 64 * (j))
#define XB_XGEN(j)  (2304 + 64 * (j))
#define XB_TOP      3328
#define XB_TOPGEN   3392
#define XCD_BAR_WORDS 3456
#define XB_TSUB(t)  (3584 + 16 * (t))
#define XB_TGEN(t)  (4608 + 16 * (t))
#define XB_SPIN_CAP (1u << 23)
__device__ __forceinline__ unsigned xb_ld(unsigned* p)              { return __hip_atomic_load(p, __ATOMIC_RELAXED, __HIP_MEMORY_SCOPE_AGENT); }
__device__ __forceinline__ unsigned xb_add(unsigned* p, unsigned v) { return __hip_atomic_fetch_add(p, v, __ATOMIC_RELAXED, __HIP_MEMORY_SCOPE_AGENT); }
__device__ __forceinline__ unsigned xb_xcc_id() { return (unsigned)__builtin_amdgcn_s_getreg((3 << 11) | 20) & 0xFu; }
#define XB_SPIN(cond, bar) do { unsigned _sp = 0; while (cond) { __builtin_amdgcn_s_sleep(1); \
    if ((++_sp & 255u) == 0u) { if (xb_ld(&(bar)[XB_TMO])) break; if (_sp > XB_SPIN_CAP) { atomicAdd(&(bar)[XB_TMO], 1u); break; } } } } while (0)
struct XcdBarrier { unsigned* bar; unsigned x; volatile LAS unsigned* st; };
__device__ __forceinline__ XcdBarrier xcd_barrier_post(unsigned* bar, volatile LAS unsigned* st) {
    XcdBarrier b; b.bar = bar; b.x = xb_xcc_id(); b.st = st;
    if (threadIdx.x == 0) st[2] = xb_add(&bar[XB_XCNT(b.x)], 1u);
    return b;
}
__device__ __forceinline__ void xcd_barrier_complete(unsigned* bar, unsigned x, unsigned& nloc, unsigned& nx) {
    const unsigned G = gridDim.x * gridDim.y * gridDim.z;
    unsigned sum, cnt, mine, sp = 0u;
    for (;;) {
        sum = 0u; cnt = 0u; mine = 0u;
#pragma unroll
        for (unsigned j = 0; j < 16; ++j) { const unsigned c = xb_ld(&bar[XB_XCNT(j)]); sum += c; cnt += (c > 0u) ? 1u : 0u; mine = (j == x) ? c : mine; }
        if (sum == G) break;
        __builtin_amdgcn_s_sleep(1);
        if ((++sp & 255u) == 0u) { if (xb_ld(&bar[XB_TMO])) break; if (sp > XB_SPIN_CAP) { atomicAdd(&bar[XB_TMO], 1u); break; } }
    }
    nloc = mine > 0u ? mine : 1u; nx = cnt > 0u ? cnt : 1u;
}
__device__ __forceinline__ void xcd_barrier(const XcdBarrier& b, bool global = true, int team = -1) {
    asm volatile("s_waitcnt vmcnt(0)" ::: "memory");
    __syncthreads();
    if (threadIdx.x == 0) {
        unsigned* bar = b.bar;
        __builtin_amdgcn_s_waitcnt(0);
        unsigned nloc = b.st[0], nx = b.st[1];
        if (nloc == 0u) { xcd_barrier_complete(bar, b.x, nloc, nx); b.st[0] = nloc; b.st[1] = nx; }
        if (!global && team >= 0) {
            const unsigned old = xb_add(&bar[XB_TSUB(team)], 1u); const unsigned gen = old / 4u;
            if (old + 1u == (gen + 1u) * 4u) xb_add(&bar[XB_TGEN(team)], 1u);
            else XB_SPIN(xb_ld(&bar[XB_TGEN(team)]) == gen, bar);
            asm volatile("buffer_inv sc0" ::: "memory");
            asm volatile("s_waitcnt vmcnt(0)" ::: "memory");
        } else {
        const unsigned old = xb_add(&bar[XB_XSUB(b.x)], 1u);
        const unsigned gen = old / nloc;
        if (!global) {
            if (old + 1u == (gen + 1u) * nloc) xb_add(&bar[XB_XGEN(b.x)], 1u);
            else XB_SPIN(xb_ld(&bar[XB_XGEN(b.x)]) == gen, bar);
            __builtin_amdgcn_fence(__ATOMIC_ACQUIRE, "agent");
            asm volatile("s_waitcnt vmcnt(0)" ::: "memory");
        } else if (old + 1u == (gen + 1u) * nloc) {
            __builtin_amdgcn_fence(__ATOMIC_RELEASE, "agent");
            asm volatile("s_waitcnt vmcnt(0)" ::: "memory");
            const unsigned og = xb_add(&bar[XB_TOP], 1u);
            const unsigned tg = og / nx;
            if (og + 1u == (tg + 1u) * nx) xb_add(&bar[XB_TOPGEN], 1u);
            else XB_SPIN(xb_ld(&bar[XB_TOPGEN]) == tg, bar);
            __builtin_amdgcn_fence(__ATOMIC_ACQUIRE, "agent");
            xb_add(&bar[XB_XGEN(b.x)], 1u);
            asm volatile("s_waitcnt vmcnt(0)" ::: "memory");
        } else {
            XB_SPIN(xb_ld(&bar[XB_XGEN(b.x)]) == gen, bar);
            __builtin_amdgcn_fence(__ATOMIC_ACQUIRE, "agent");
            asm volatile("s_waitcnt vmcnt(0)" ::: "memory");
        }
        }
    }
    __syncthreads();
}

struct Frame {
    LAS unsigned char* lds; int tid, lane, wave, vcu, G;
    InTab in; float* out; unsigned char* ws;
};

__device__ __forceinline__ float wave_sum(float v) {
#pragma unroll
    for (int o = 1; o < 64; o <<= 1) v += __shfl_xor(v, o);
    return v;
}

enum { MAP_IDENT = 0, MAP_L0IN = 1, MAP_L1IN = 2, MAP_GATE0 = 3, MAP_GU = 4, MAP_KVB = 5 };
__device__ __forceinline__ int map_src(int kind, int n, int nsrc) {
    if (kind == MAP_IDENT) return n < nsrc ? n : -1;
    if (kind == MAP_GATE0) return n < 24 ? 1280 + n : -1;
    if (kind == MAP_GU) { const int tile = n >> 8, w = n & 127; return tile * 128 + w; }
    const int pn = n >> 8, slot = n & 255;
    const int hh = (slot >> 5) & 3, d = 32 * (slot >> 7) + (slot & 31), L = pn * 256 + hh * 64 + d;
    if (kind == MAP_KVB) return (2 * pn + (hh & 1)) * 128 + (hh >> 1) * 64 + d;
    if (kind == MAP_L0IN) {
        if (L < 512) return L;
        if (L < 1024) return 1304 + (L - 512);
        if (L < 1792) return 512 + (L - 1024);
        return 1816 + (L - 1792);
    }
    if (pn < 6) return L;
    if (pn == 6) return 1544 + slot;
    if (slot < 128) return 1800 + slot;
    if (slot < 160) return 1928 + (slot - 128);
    if (slot < 168) return 1536 + (slot - 160);
    return -1;
}
struct WDesc { const float* src; const float* src2; int K, nsrc, ndst; bf16* dst; const float* gain; int kind; };
__device__ __forceinline__ void conv_load(const WDesc& w, int item, int lane, f32x4 (&v)[8], float (&g)[8]) {
    const int nblk = w.ndst / 32, kb = item / nblk, nb = item % nblk, k0 = 64 * kb, n0 = 32 * nb;
    const int nq = 4 * (lane & 7), kr = lane >> 3; const int sc = map_src(w.kind, n0 + nq, w.nsrc);
    const float* src = (w.kind == MAP_GU && (n0 & 128)) ? w.src2 : w.src;
#pragma unroll
    for (int i = 0; i < 8; ++i) { const int kk = 8 * i + kr; v[i] = (f32x4){0.f, 0.f, 0.f, 0.f}; if (sc >= 0) v[i] = *(const f32x4*)(src + (size_t)(k0 + kk) * w.nsrc + sc); }
#pragma unroll
    for (int i = 0; i < 8; ++i) { g[i] = 1.f; if (w.gain) g[i] = w.gain[k0 + 8 * i + kr]; }
}
__device__ __forceinline__ void conv_finish(const WDesc& w, LAS float* scr, int item, int lane, const f32x4 (&v)[8], const float (&g)[8]) {
    const int nblk = w.ndst / 32, kb = item / nblk, nb = item % nblk, k0 = 64 * kb, n0 = 32 * nb;
    const int nq = 4 * (lane & 7), kr = lane >> 3;
#pragma unroll
    for (int i = 0; i < 8; ++i) { const int kk = 8 * i + kr; const float gsc = g[i];
        LAS float* d = scr + kk * 33 + nq; d[0] = v[i][0] * gsc; d[1] = v[i][1] * gsc; d[2] = v[i][2] * gsc; d[3] = v[i][3] * gsc; }
    LDS_WAIT(); asm volatile("" ::: "memory");
    const int c = lane & 7;
#pragma unroll
    for (int j = 0; j < 4; ++j) { const int nn = (lane >> 3) + 8 * j; const LAS float* s = scr + (8 * c) * 33 + nn;
        v4u o; o.x = pk2(s[0 * 33], s[1 * 33]); o.y = pk2(s[2 * 33], s[3 * 33]); o.z = pk2(s[4 * 33], s[5 * 33]); o.w = pk2(s[6 * 33], s[7 * 33]);
        *(v4u*)(w.dst + (size_t)(n0 + nn) * w.K + k0 + 8 * c) = o; }
    LDS_WAIT(); asm volatile("" ::: "memory");
}
constexpr int NMAT = 19;
__device__ __forceinline__ WDesc get_wdesc(const Frame& F, int id) {
    WDesc w; w.src2 = nullptr; w.gain = nullptr; w.kind = MAP_IDENT;
    InTab in = F.in; unsigned char* ws = F.ws;
    if (id < 4) { const int nb = id == 0 ? 1 : id == 1 ? 22 : id == 2 ? 26 : 42;
        w.src = in[nb + 1]; w.src2 = in[nb + 2]; w.gain = in[nb]; w.K = 1024; w.nsrc = FF; w.ndst = 2 * FF; w.dst = (bf16*)(ws + OFF_WGU + id * SZ_WGU); w.kind = MAP_GU; }
    else if (id < 8) { const int f = id - 4; const int nb = f == 0 ? 1 : f == 1 ? 22 : f == 2 ? 26 : 42;
        w.src = in[nb + 3]; w.K = FF; w.nsrc = 1024; w.ndst = 1024; w.dst = (bf16*)(ws + OFF_WD + f * SZ_WD); }
    else if (id == 8) { w.src = in[6]; w.gain = in[5]; w.K = 1024; w.nsrc = 2072; w.ndst = 2048; w.dst = (bf16*)(ws + OFF_WIN0); w.kind = MAP_L0IN; }
    else if (id == 9) { w.src = in[6]; w.gain = in[5]; w.K = 1024; w.nsrc = 2072; w.ndst = 32; w.dst = (bf16*)(ws + OFF_WG); w.kind = MAP_GATE0; }
    else if (id == 10) { w.src = in[21]; w.K = 1024; w.nsrc = 1024; w.ndst = 1024; w.dst = (bf16*)(ws + OFF_WOUT0); }
    else if (id == 11) { w.src = in[31]; w.gain = in[30]; w.K = 1024; w.nsrc = 1960; w.ndst = 2048; w.dst = (bf16*)(ws + OFF_WIN1); w.kind = MAP_L1IN; }
    else if (id == 12) { w.src = in[41]; w.K = 1024; w.nsrc = 1024; w.ndst = 1024; w.dst = (bf16*)(ws + OFF_WOUT1); }
    else if (id == 13) { w.src = in[36]; w.gain = in[35]; w.K = 256; w.nsrc = 768; w.ndst = 768; w.dst = (bf16*)(ws + OFF_WQB); }
    else if (id == 14) { w.src = in[38]; w.gain = in[37]; w.K = 128; w.nsrc = 1024; w.ndst = 1024; w.dst = (bf16*)(ws + OFF_WKVB); w.kind = MAP_KVB; }
    else if (id == 15) { w.src = in[14]; w.K = 2048; w.nsrc = 256; w.ndst = 256; w.dst = (bf16*)(ws + OFF_W1K); }
    else if (id == 16) { w.src = in[16]; w.K = 2048; w.nsrc = 256; w.ndst = 256; w.dst = (bf16*)(ws + OFF_W1V); }
    else if (id == 17) { w.src = in[15]; w.K = 256; w.nsrc = 64; w.ndst = 64; w.dst = (bf16*)(ws + OFF_W2K); }
    else { w.src = in[17]; w.K = 256; w.nsrc = 64; w.ndst = 64; w.dst = (bf16*)(ws + OFF_W2V); }
    return w;
}
__device__ __forceinline__ void convert_mats(Frame& F, unsigned mask, int gw, int NGW) {
    LAS float* scr = (LAS float*)(F.lds + F.wave * 16384);
    int base = 0;
    for (int id = 0; id < NMAT; ++id) {
        if (!((mask >> id) & 1u)) continue;
        const WDesc w = get_wdesc(F, id); const int nit = (w.K / 64) * (w.ndst / 32);
        int first = (gw - base) % NGW; if (first < 0) first += NGW;
        if (first < nit) { f32x4 va[8], vb[8]; float ga[8], gb[8]; conv_load(w, first, F.lane, va, ga);
            for (int it = first; it < nit; it += 2 * NGW) {
                if (it + NGW < nit) conv_load(w, it + NGW, F.lane, vb, gb);
                conv_finish(w, scr, it, F.lane, va, ga);
                if (it + NGW < nit) { if (it + 2 * NGW < nit) conv_load(w, it + 2 * NGW, F.lane, va, ga); conv_finish(w, scr, it + NGW, F.lane, vb, gb); }
            } }
        base = (base + nit) % NGW;
    }
}
constexpr unsigned MATS_P0 = (1u << 0) | (1u << 4) | (1u << 8);
constexpr unsigned MATS_P1 = (1u << 9) | (1u << 10) | (1u << 15) | (1u << 16) | (1u << 17) | (1u << 18);
constexpr unsigned MATS_P4 = (1u << 1) | (1u << 5) | (1u << 2) | (1u << 6) | (1u << 11) | (1u << 13) | (1u << 14);
constexpr unsigned MATS_P7 = (1u << 3) | (1u << 7) | (1u << 12);
static_assert((MATS_P0 | MATS_P1 | MATS_P4 | MATS_P7) == (1u << NMAT) - 1u && (MATS_P0 & MATS_P1) == 0 && ((MATS_P0 | MATS_P1) & MATS_P4) == 0 && ((MATS_P0 | MATS_P1 | MATS_P4) & MATS_P7) == 0, "every matrix converted exactly once");
__device__ __forceinline__ void p0_prologue(Frame& F) {
    const int gw = F.vcu * NWAVES + F.wave, NGW = F.G * NWAVES;
    convert_mats(F, MATS_P0, gw, NGW);
    { const float* x = F.in[0]; bf16* xb = (bf16*)(F.ws + OFF_XBA); float* ssq = (float*)(F.ws + OFF_SSQ);
      for (int m0 = gw; m0 < NTOK; m0 += 8 * NGW) {
        f32x4 v[8][4];
#pragma unroll
        for (int q = 0; q < 8; ++q) { const int m = m0 + q * NGW; if (m < NTOK) { const f32x4* xr = (const f32x4*)(x + (size_t)m * DM) + F.lane;
#pragma unroll
            for (int j = 0; j < 4; ++j) v[q][j] = xr[64 * j]; } }
#pragma unroll
        for (int q = 0; q < 8; ++q) { const int m = m0 + q * NGW; if (m < NTOK) { float s = 0.f; v2u* o8 = (v2u*)(xb + (size_t)m * DM) + F.lane;
#pragma unroll
            for (int j = 0; j < 4; ++j) { const f32x4 t = v[q][j]; s += (t[0] * t[0] + t[1] * t[1]) + (t[2] * t[2] + t[3] * t[3]); v2u w; w.x = pk2(t[0], t[1]); w.y = pk2(t[2], t[3]); o8[64 * j] = w; }
            s = wave_sum(s);
            if (F.lane < 4) ssq[(size_t)m * 4 + F.lane] = F.lane == 0 ? s : 0.f; } }
      } }
    { float* c64 = (float*)(F.ws + OFF_ROPE64C); float* s64 = (float*)(F.ws + OFF_ROPE64S); float* c32 = (float*)(F.ws + OFF_ROPE32C); float* s32 = (float*)(F.ws + OFF_ROPE32S);
      const int gt = F.vcu * 512 + F.tid, NT = F.G * 512;
      for (int e = gt; e < SEQ * 32; e += NT) { const int t = e >> 5, i = e & 31; const float inv = 1.0f / powf(10000.0f, (float)(2 * i) / 64.0f); const float ang = (float)t * inv; c64[e] = cosf(ang); s64[e] = sinf(ang); }
      (void)c32; (void)s32; }
}
__device__ __forceinline__ void p1_extras(Frame& F, int idx, int n) {
    { float* c32 = (float*)(F.ws + OFF_ROPE32C); float* s32 = (float*)(F.ws + OFF_ROPE32S);
      const int gt = idx * 512 + F.tid, NT = n * 512;
      for (int e = gt; e < SEQ * 16; e += NT) { const int t = e >> 4, i = e & 15; const float inv = 1.0f / powf(10000.0f, (float)(2 * i) / 32.0f); const float ang = (float)t * inv; c32[e] = cosf(ang); s32[e] = sinf(ang); } }
    for (int v = idx; v < 256; v += n) {
        __syncthreads();
        const int oi = 2 * v + (F.tid >> 8), kv = oi >> 8, nn = oi & 255, kc = F.tid & 255; const float* pos = F.in[kv ? 13 : 12]; const float* w1 = F.in[kv ? 16 : 14];
        float s = 0.f;
#pragma unroll
        for (int k = 0; k < 8; ++k) s += pos[kc * 8 + k] * w1[(size_t)(kc * 8 + k) * 256 + nn];
        s = wave_sum(s);
        LAS float* red = (LAS float*)(F.lds);
        if (F.lane == 0) red[F.wave] = s;
        __syncthreads();
        if (F.tid < 2) ((float*)(F.ws + OFF_CBIAS))[2 * v + F.tid] = (red[4 * F.tid] + red[4 * F.tid + 1]) + (red[4 * F.tid + 2] + red[4 * F.tid + 3]);
        __syncthreads();
    }
}

__device__ __forceinline__ void gates_phase(Frame& F, int gb, int NGB) {
    const int lane = F.lane, fr = lane & 15, fq = lane >> 4;
    const bf16* xb = (const bf16*)(F.ws + OFF_XBA); const bf16* wg = (const bf16*)(F.ws + OFF_WG); const GAS float* ssq = (const GAS float*)(F.ws + OFF_SSQ);
    float* gates = (float*)(F.ws + OFF_GATES); const float* gb_ = F.in[7];
    constexpr int WP = 2064;
    for (int c = F.tid; c < 32 * 128; c += NWAVES * 64) { const int row = c >> 7, ch = c & 127; *(LAS v4u*)(F.lds + row * WP + ch * 16) = *(const v4u*)(wg + (size_t)row * DM + ch * 8); }
    __syncthreads();
    int wofs = fr * WP + fq * 16;
    for (int task = gb * NWAVES + F.wave; task < NTOK / 16; task += NGB * NWAVES) {
        const int r0 = task * 16; f32x4 acc0 = {0.f, 0.f, 0.f, 0.f}, acc1 = {0.f, 0.f, 0.f, 0.f};
        const bf16* ap = xb + (size_t)(r0 + fr) * DM + 8 * fq;
        asm volatile("" : "+v"(wofs));
        const LAS unsigned char* w0 = F.lds + wofs; const LAS unsigned char* w1 = w0 + 16 * WP;
#pragma unroll
        for (int kh = 0; kh < 4; ++kh) {
            bf16x8 a[8];
#pragma unroll
            for (int i = 0; i < 8; ++i) a[i] = *(const bf16x8*)(ap + (kh * 8 + i) * 32);
#pragma unroll
            for (int i = 0; i < 8; ++i) { const int k = (kh * 8 + i) * 32;
                const bf16x8 b0 = *(const LAS bf16x8*)(w0 + k * 2), b1 = *(const LAS bf16x8*)(w1 + k * 2);
                acc0 = __builtin_amdgcn_mfma_f32_16x16x32_bf16(a[i], b0, acc0, 0, 0, 0); acc1 = __builtin_amdgcn_mfma_f32_16x16x32_bf16(a[i], b1, acc1, 0, 0, 0); }
        }
#pragma unroll
        for (int j = 0; j < 4; ++j) { const int r = r0 + 4 * fq + j; const float rs = row_rstd16(ssq, r, 1.0f / 1024.0f);
            { const float z = acc0[j] * rs + gb_[fr]; gates[(size_t)r * 24 + fr] = __builtin_amdgcn_rcpf(1.0f + ex2(-z * LOG2E)); }
            if (fr < 8) { const float z = acc1[j] * rs + gb_[16 + fr]; gates[(size_t)r * 24 + 16 + fr] = __builtin_amdgcn_rcpf(1.0f + ex2(-z * LOG2E)); } }
    }
    __syncthreads();
}
__device__ __forceinline__ void cmp2_tile(Frame& F, int kv, int pm, int h) {
    const int lane = F.lane, fr = lane & 15, fq = lane >> 4;
    const bf16* hid = (const bf16*)(F.ws + OFF_HID) + (size_t)kv * 2048 * 256; const bf16* w2 = (const bf16*)(F.ws + (kv ? OFF_W2V : OFF_W2K));
    bf16* out = (bf16*)(F.ws + (kv ? OFF_VCMP : OFF_KCMP)); const float* gain = F.in[9];
    for (int rt = F.wave; rt < 8; rt += NWAVES) {
        const int r0 = pm * 256 + h * 128 + rt * 16; f32x4 acc[4];
#pragma unroll
        for (int c = 0; c < 4; ++c) acc[c] = (f32x4){0.f, 0.f, 0.f, 0.f};
        const bf16* ap = hid + (size_t)(r0 + fr) * 256 + 8 * fq;
#pragma unroll
        for (int k = 0; k < 256; k += 32) { const bf16x8 a = *(const bf16x8*)(ap + k);
#pragma unroll
            for (int c = 0; c < 4; ++c) { const bf16x8 b = *(const bf16x8*)(w2 + (size_t)(c * 16 + fr) * 256 + 8 * fq + k); acc[c] = __builtin_amdgcn_mfma_f32_16x16x32_bf16(a, b, acc[c], 0, 0, 0); } }
#pragma unroll
        for (int j = 0; j < 4; ++j) {
            float v[4];
#pragma unroll
            for (int c = 0; c < 4; ++c) v[c] = acc[c][j];
            if (kv == 0) { float ss = (v[0] * v[0] + v[1] * v[1]) + (v[2] * v[2] + v[3] * v[3]);
                ss += __shfl_xor(ss, 1); ss += __shfl_xor(ss, 2); ss += __shfl_xor(ss, 4); ss += __shfl_xor(ss, 8);
                const float r = rsq(ss * (1.0f / 64.0f) + EPS);
#pragma unroll
                for (int c = 0; c < 4; ++c) v[c] = v[c] * r * gain[c * 16 + fr]; }
#pragma unroll
            for (int c = 0; c < 4; ++c) { const int rr = r0 + 4 * fq + j, slab = rr >> 9, i = rr & 511, d = c * 16 + fr;
                out[(size_t)slab * 512 * 64 + (kv ? vtile_off(i, d) : ktile_off<64>(i, d >> 3) + (d & 7))] = (bf16)f2bf(v[c]); }
        }
    }
}

__device__ __forceinline__ void fox_scan(Frame& F, int bh) {
    const int b = bh >> 3, h = bh & 7; const float* fraw = (const float*)(F.ws + OFF_FRAW); const float fb = F.in[32][h];
    LAS float* red = (LAS float*)(F.lds);
    float v[16]; float run = 0.f; const int t0 = F.tid * 16;
#pragma unroll
    for (int i = 0; i < 16; ++i) { const float x = fraw[(size_t)bh * SEQ + t0 + i] + fb; const float ls2 = fminf(x, 0.f) * LOG2E - __builtin_amdgcn_logf(1.0f + ex2(-fabsf(x) * LOG2E)); run += ls2; v[i] = run; }
    float inc = run;
#pragma unroll
    for (int off = 1; off < 64; off <<= 1) { const float y = __shfl_up(inc, off); if (F.lane >= off) inc += y; }
    __syncthreads();
    if (F.lane == 63) red[F.wave] = inc;
    __syncthreads();
    float wbase = 0.f;
    for (int w = 0; w < F.wave; ++w) wbase += red[w];
    const float excl = wbase + inc - run;
    float* dc = (float*)(F.ws + OFF_DC2) + (size_t)bh * SEQ;
    bf16* QF = (bf16*)(F.ws + OFF_QF); bf16* KF = (bf16*)(F.ws + OFF_KF);
#pragma unroll
    for (int i = 0; i < 16; ++i) { const float val = excl + v[i]; const int t = t0 + i; dc[t] = val;
        const unsigned h1 = f2bf(val); const float r1 = val - bf2f((bf16)h1); const unsigned h2 = f2bf(r1); const float r2 = r1 - bf2f((bf16)h2); const unsigned h3 = f2bf(r2);
        const unsigned one = 0x3F80u;
        v4u qa; qa.x = one | (one << 16); qa.y = one | (h1 << 16); qa.z = h2 | (h3 << 16); qa.w = 0u;
        v4u ka; ka.x = (h1 ^ 0x8000u) | ((h2 ^ 0x8000u) << 16); ka.y = (h3 ^ 0x8000u) | (one << 16); ka.z = one | (one << 16); ka.w = 0u;
        const v4u z = {0u, 0u, 0u, 0u};
        bf16* qp = (bf16*)(F.ws + OFF_QAUG) + ((size_t)bh * SEQ + t) * 16; *(v4u*)qp = qa; *(v4u*)(qp + 8) = z;
        bf16* ksl = KF + (size_t)bh * SEQ * 80; *(v4u*)(ksl + ktile_off<80>(t, 8)) = ka; *(v4u*)(ksl + ktile_off<80>(t, 9)) = z; }
    __syncthreads();
}

__device__ __forceinline__ int fresh_tid() { int t = threadIdx.x; asm volatile("" : "+v"(t)); return t; }
namespace fa {
typedef float f32x16 __attribute__((ext_vector_type(16)));
typedef short s16x4 __attribute__((ext_vector_type(4)));
typedef short v4i16_t __attribute__((ext_vector_type(4)));
typedef LAS const char* lds_cptr;
constexpr int VSLOT = 8192, NSLOT = 4, IMPS = 129;
template <int DQK> struct Map { static constexpr int KS = DQK <= 64 ? 8192 : 12288, K = 0, V = NSLOT * KS, WS = V + NSLOT * VSLOT, IMP = WS + 8 * 256, SEL = IMP + 64 * IMPS * 4, END = SEL + 64 * 16; };
static_assert(Map<64>::END <= 131072 && Map<96>::IMP <= 131072, "attention LDS map");
__device__ __forceinline__ int crow(int r, int hi) { return (r & 3) + 8 * (r >> 2) + 4 * hi; }
__device__ __forceinline__ void glds16(const void* g, unsigned lds_base) {
    unsigned sv; asm volatile("s_mov_b32 %0, m0\n\ts_mov_b32 m0, %2\n\ts_nop 0\n\tglobal_load_lds_dwordx4 %1, off\n\ts_mov_b32 m0, %0" : "=&s"(sv) : "v"(g), "s"(lds_base) : "memory"); }
__device__ __forceinline__ s16x4 vtr(lds_cptr p) { return __builtin_bit_cast(s16x4, __builtin_amdgcn_ds_read_tr16_b64_v4i16((LAS v4i16_t*)p)); }
#define FA_MX3(a, b, c) __builtin_fmaxf(__builtin_fmaxf((a), (b)), (c))
#define FA_MFMA(a, b, c) __builtin_amdgcn_mfma_f32_32x32x16_bf16(a, b, c, 0, 0, 0)
__device__ __forceinline__ float rowmax(const f32x16& p0, const f32x16& p1) {
    float a = FA_MX3(p0[0], p0[1], p1[0]), b = FA_MX3(p0[2], p0[3], p1[1]); a = FA_MX3(a, p1[2], p1[3]);
#pragma unroll
    for (int r = 4; r < 16; r += 4) { a = FA_MX3(a, p0[r], p0[r + 1]); b = FA_MX3(b, p0[r + 2], p0[r + 3]); a = FA_MX3(a, p1[r], p1[r + 1]); b = FA_MX3(b, p1[r + 2], p1[r + 3]); }
    float m = __builtin_fmaxf(a, b); auto rr = __builtin_amdgcn_permlane32_swap(__float_as_uint(m), __float_as_uint(m), false, false);
    return __builtin_fmaxf(__uint_as_float(rr[0]), __uint_as_float(rr[1])); }
__device__ __forceinline__ float halfsum(float v) { auto rr = __builtin_amdgcn_permlane32_swap(__float_as_uint(v), __float_as_uint(v), false, false); return __uint_as_float(rr[0]) + __uint_as_float(rr[1]); }

struct PassArgs {
    const bf16* K; const bf16* V;
    int t_begin, t_end;
    int lo, hi;
    int lo_max, hi_min;
    int nomax;
};
__device__ __forceinline__ void wait_vm_bar(int n) {
    if (n == 0) asm volatile("s_waitcnt vmcnt(0) lgkmcnt(0)\n\ts_barrier" ::: "memory");
    else if (n == 1) asm volatile("s_waitcnt vmcnt(1) lgkmcnt(0)\n\ts_barrier" ::: "memory");
    else if (n == 2) asm volatile("s_waitcnt vmcnt(2) lgkmcnt(0)\n\ts_barrier" ::: "memory");
    else asm volatile("s_waitcnt vmcnt(3) lgkmcnt(0)\n\ts_barrier" ::: "memory");
}
template <int WSOFF> __device__ __forceinline__ void scale_rows(LAS char* shm, f32x16 (&o)[2], float f, int wid, int r32, int hi) {
    LAS float* wsf = (LAS float*)(shm + WSOFF) + wid * 64;
    if (hi == 0) wsf[r32] = f;
    asm volatile("s_waitcnt lgkmcnt(0)" ::: "memory");
#pragma unroll
    for (int r = 0; r < 16; ++r) { const float fr = wsf[crow(r, hi)]; o[0][r] *= fr; o[1][r] *= fr; }
    asm volatile("s_waitcnt lgkmcnt(0)" ::: "memory");
}
#ifndef FA_SKEW
#define FA_SKEW 0
#endif
constexpr float THR = 8.0f;
template <int DQK, int MODE, bool USE_SEL>
__device__ __forceinline__ void attn_pass(LAS char* shm, const bf16x8 (&qr)[DQK / 16], const PassArgs& pa, const unsigned (&sel)[4], f32x16 (&o)[2], float& m, float& l, float invl, int tok) {
    typedef Map<DQK> MP;
    const int tid = fresh_tid(), lane = tid & 63, r32 = lane & 31, hi = lane >> 5; const int wid = __builtin_amdgcn_readfirstlane(tid >> 6);
    constexpr int NCH = DQK / 8, ND = DQK / 16;
    const int nt = pa.t_end - pa.t_begin;
    const bool two_k = (wid + 8 < NCH);
    const int pt = (MODE == 1 ? 0 : 1) + 1 + (two_k ? 1 : 0);
    const bool skew = FA_SKEW && (MODE == 0) && (wid >= 4);
    const bf16* ksrc = pa.K + wid * 512 + lane * 8;
    const bf16* vsrc = pa.V + wid * 512 + lane * 8;
    const unsigned lds0 = (unsigned)(uintptr_t)shm;
#define FA_ISSUE(t_, slot_) do { const size_t ko_ = (size_t)(t_) * 64 * DQK; \
        glds16(ksrc + ko_, (unsigned)__builtin_amdgcn_readfirstlane(lds0 + MP::K + (slot_) * MP::KS + wid * 1024)); \
        if (two_k) glds16(ksrc + ko_ + 8 * 512, (unsigned)__builtin_amdgcn_readfirstlane(lds0 + MP::K + (slot_) * MP::KS + (wid + 8) * 1024)); \
        if (MODE != 1) glds16(vsrc + (size_t)(t_) * 4096, (unsigned)__builtin_amdgcn_readfirstlane(lds0 + MP::V + (slot_) * VSLOT + wid * 1024)); } while (0)
    if (nt <= 0) return;
    FA_ISSUE(pa.t_begin, 0); if (nt > 1) FA_ISSUE(pa.t_begin + 1, 1);
    const float NEG = -__builtin_inff();
    f32x16 p0, p1; v4u pw[4];
    p0 = f32x16{}; p1 = f32x16{};
    bf16x8 kf[2 * ND]; s16x4 vl[8], vh[8];
#define FA_LOADK(sl, D0A, D0B) do { const lds_cptr kp = (lds_cptr)shm + MP::K + (sl) * MP::KS + hi * 1024 + r32 * 16; \
        _Pragma("unroll") for (int d0 = (D0A); d0 < (D0B); ++d0) { kf[2 * d0] = *(const LAS bf16x8*)(kp + d0 * 2048); kf[2 * d0 + 1] = *(const LAS bf16x8*)(kp + d0 * 2048 + 512); } \
        __builtin_amdgcn_sched_barrier(0); } while (0)
#define FA_LOADV(sl) do { if (MODE != 1) { const lds_cptr vp = (lds_cptr)shm + MP::V + (sl) * VSLOT + ((lane >> 4) & 1) * 32 + (lane & 3) * 8 + (4 * hi + ((lane & 15) >> 2)) * 64; \
        _Pragma("unroll") for (int d0 = 0; d0 < 2; ++d0) _Pragma("unroll") for (int ks = 0; ks < 4; ++ks) { vl[d0 * 4 + ks] = vtr(vp + d0 * 4096 + ks * 1024); vh[d0 * 4 + ks] = vtr(vp + d0 * 4096 + ks * 1024 + 512); } \
        __builtin_amdgcn_sched_barrier(0); } } while (0)
#define FA_SEG_A(t) do { \
        f32x16 cin; float c_ = -m; \
        if (USE_SEL) { const unsigned w_ = (t) < 32 ? sel[0] : (t) < 64 ? sel[1] : (t) < 96 ? sel[2] : sel[3]; c_ = ((w_ >> ((t) & 31)) & 1u) ? -m : NEG; } \
        if (!USE_SEL && pa.nomax) {     \
            const f32x16 zc = {0.f, 0.f, 0.f, 0.f, 0.f, 0.f, 0.f, 0.f, 0.f, 0.f, 0.f, 0.f, 0.f, 0.f, 0.f, 0.f}; \
            p0 = FA_MFMA(kf[0], qr[0], zc); p1 = FA_MFMA(kf[1], qr[0], zc); \
        } else { \
            _Pragma("unroll") for (int r = 0; r < 16; ++r) cin[r] = c_; \
            p0 = FA_MFMA(kf[0], qr[0], cin); p1 = FA_MFMA(kf[1], qr[0], cin); } \
        _Pragma("unroll") for (int d0 = 1; d0 < ND; ++d0) { p0 = FA_MFMA(kf[2 * d0], qr[d0], p0); p1 = FA_MFMA(kf[2 * d0 + 1], qr[d0], p1); } \
        if (!(64 * (t) >= pa.lo_max && 64 * (t) + 63 <= pa.hi_min)) { \
            const int kb = 64 * (t) + 4 * hi; \
            _Pragma("unroll") for (int r = 0; r < 16; ++r) { const int kv = kb + (r & 3) + 8 * (r >> 2); \
                if (kv < pa.lo || kv > pa.hi) p0[r] = NEG; if (kv + 32 < pa.lo || kv + 32 > pa.hi) p1[r] = NEG; } } \
        __builtin_amdgcn_sched_barrier(0); \
    } while (0)
#define FA_SEG_B(t) do { \
        if (MODE != 2) { \
            float rm = 0.f; if (!pa.nomax) rm = rowmax(p0, p1); \
            if (!pa.nomax && __any(rm > THR)) { \
                const float dl = __builtin_fmaxf(rm, 0.f); m += dl; const float alpha = ex2(-dl); l *= alpha; \
                _Pragma("unroll") for (int r = 0; r < 16; ++r) { p0[r] -= dl; p1[r] -= dl; } \
                if (MODE == 0) scale_rows<MP::WS>(shm, o, alpha, wid, r32, hi); \
            } \
            float ls = 0.f; \
            _Pragma("unroll") for (int r = 0; r < 16; ++r) { p0[r] = ex2(p0[r]); p1[r] = ex2(p1[r]); ls += p0[r] + p1[r]; } \
            l += ls; \
        } else { \
            _Pragma("unroll") for (int r = 0; r < 16; ++r) { p0[r] = ex2(p0[r]) * invl; p1[r] = ex2(p1[r]) * invl; } \
            LAS unsigned* imp = (LAS unsigned*)(shm + MP::IMP) + tok * IMPS; \
            _Pragma("unroll") for (int half = 0; half < 2; ++half) \
            _Pragma("unroll") for (int g = 0; g < 4; ++g) { \
                const float x0 = half ? p1[4 * g] : p0[4 * g], x1 = half ? p1[4 * g + 1] : p0[4 * g + 1], x2 = half ? p1[4 * g + 2] : p0[4 * g + 2], x3 = half ? p1[4 * g + 3] : p0[4 * g + 3]; \
                const int jsel = 16 * (t) + 8 * half + 2 * g + hi; \
                const unsigned a = (unsigned)((32.f * ((x0 + x1) + x2) + 16.f * x3) * 2097152.f + 0.5f), c = (unsigned)(16.f * x3 * 2097152.f + 0.5f); \
                if (jsel < 128) __hip_atomic_fetch_add(imp + jsel, a, __ATOMIC_RELAXED, __HIP_MEMORY_SCOPE_WORKGROUP); \
                if (jsel + 1 < 128) __hip_atomic_fetch_add(imp + jsel + 1, c, __ATOMIC_RELAXED, __HIP_MEMORY_SCOPE_WORKGROUP); } \
        } \
        if (MODE != 1) { \
            pw[0] = (v4u){pk2(p0[0], p0[1]), pk2(p0[2], p0[3]), pk2(p0[4], p0[5]), pk2(p0[6], p0[7])}; \
            pw[1] = (v4u){pk2(p0[8], p0[9]), pk2(p0[10], p0[11]), pk2(p0[12], p0[13]), pk2(p0[14], p0[15])}; \
            pw[2] = (v4u){pk2(p1[0], p1[1]), pk2(p1[2], p1[3]), pk2(p1[4], p1[5]), pk2(p1[6], p1[7])}; \
            pw[3] = (v4u){pk2(p1[8], p1[9]), pk2(p1[10], p1[11]), pk2(p1[12], p1[13]), pk2(p1[14], p1[15])}; } \
        __builtin_amdgcn_sched_barrier(0); \
    } while (0)
#define FA_SEG_C() do { if (MODE != 1) { \
        _Pragma("unroll") for (int d0 = 0; d0 < 2; ++d0) \
        _Pragma("unroll") for (int ks = 0; ks < 4; ++ks) { \
            const s16x4 a_ = vl[d0 * 4 + ks], b_ = vh[d0 * 4 + ks]; \
            const bf16x8 vf = {a_[0], a_[1], a_[2], a_[3], b_[0], b_[1], b_[2], b_[3]}; \
            o[d0] = FA_MFMA(__builtin_bit_cast(bf16x8, pw[ks]), vf, o[d0]); } \
        __builtin_amdgcn_sched_barrier(0); } } while (0)
    int slot = 0, pslot = 0;
    for (int i = 0; i < nt; ++i) {
        const int t = pa.t_begin + i;
        wait_vm_bar((i + 1 < nt) ? pt : 0);
        if (i + 2 < nt) { const int s2 = (slot + 2) & 3; FA_ISSUE(t + 2, s2); }
        if (!skew) { FA_LOADK(slot, 0, ND); FA_SEG_A(t); FA_LOADV(slot); FA_SEG_B(t); FA_SEG_C(); }
        else { if (i > 0) { FA_LOADV(pslot); FA_SEG_B(t - 1); FA_LOADK(slot, 0, ND / 2); FA_SEG_C(); FA_LOADK(slot, ND / 2, ND); } else { FA_LOADK(slot, 0, ND); } FA_SEG_A(t); }
        pslot = slot; slot = (slot + 1) & 3;
    }
    if (skew) { FA_LOADV(pslot); FA_SEG_B(pa.t_end - 1); FA_SEG_C(); }
    asm volatile("s_waitcnt lgkmcnt(0)\n\ts_barrier" ::: "memory");
#undef FA_ISSUE
#undef FA_SEG_A
#undef FA_LOADK
#undef FA_LOADV
#undef FA_SEG_B
#undef FA_SEG_C
}
template <int DQK> __device__ __forceinline__ void write_o(LAS char* shm, const f32x16 (&o)[2], bf16* dst, int pitch, int wid, int lane) {
    typedef Map<DQK> MP;
    const int r32 = lane & 31, hi = lane >> 5;
    LAS bf16* stg = (LAS bf16*)(shm + (wid < 4 ? MP::K + 2 * MP::KS + wid * 4096 : MP::V + 2 * VSLOT + (wid - 4) * 4096));
#pragma unroll
    for (int r = 0; r < 16; ++r) { const int orow = crow(r, hi);
#pragma unroll
        for (int d0 = 0; d0 < 2; ++d0) stg[orow * 64 + d0 * 32 + r32] = (bf16)f2bf(o[d0][r]); }
    asm volatile("s_waitcnt lgkmcnt(0)" ::: "memory");
#pragma unroll
    for (int i = 0; i < 4; ++i) { const int row = i * 8 + (lane >> 3), ch = lane & 7; const v4u v = *(const LAS v4u*)(stg + row * 64 + ch * 8); *(v4u*)(dst + (size_t)row * pitch + ch * 8) = v; }
    asm volatile("s_waitcnt lgkmcnt(0)" ::: "memory");
}
template <int ND> __device__ __forceinline__ void load_q(bf16x8 (&qr)[ND], const bf16* qrow, int hi) {
#pragma unroll
    for (int d0 = 0; d0 < ND; ++d0) qr[d0] = *(const bf16x8*)(qrow + d0 * 16 + hi * 8);
}
template <int ND> __device__ __forceinline__ void mla_q_finish(bf16x8 (&qr)[ND], const float* gq, const float* c32, const float* s32, int t, int hi) {
    if constexpr (ND == 6) {
        float x[6][8]; float ss = 0.f;
#pragma unroll
        for (int d0 = 0; d0 < 6; ++d0) { const v4u w = __builtin_bit_cast(v4u, qr[d0]);
            x[d0][0] = bflo(w.x); x[d0][1] = bfhi(w.x); x[d0][2] = bflo(w.y); x[d0][3] = bfhi(w.y); x[d0][4] = bflo(w.z); x[d0][5] = bfhi(w.z); x[d0][6] = bflo(w.w); x[d0][7] = bfhi(w.w);
#pragma unroll
            for (int j = 0; j < 8; ++j) ss += x[d0][j] * x[d0][j]; }
        ss = halfsum(ss);
        const float rn = rsq(ss * (1.0f / 96.0f) + EPS);
#pragma unroll
        for (int d0 = 0; d0 < 6; ++d0) { const f32x4 g0 = *(const f32x4*)(gq + 16 * d0 + 8 * hi), g1 = *(const f32x4*)(gq + 16 * d0 + 8 * hi + 4);
#pragma unroll
            for (int j = 0; j < 4; ++j) { x[d0][j] *= rn * g0[j]; x[d0][4 + j] *= rn * g1[j]; } }
        const f32x4 c0 = *(const f32x4*)(c32 + (size_t)t * 16 + 8 * hi), c1 = *(const f32x4*)(c32 + (size_t)t * 16 + 8 * hi + 4), s0 = *(const f32x4*)(s32 + (size_t)t * 16 + 8 * hi), s1 = *(const f32x4*)(s32 + (size_t)t * 16 + 8 * hi + 4);
#pragma unroll
        for (int j = 0; j < 8; ++j) { const float c = j < 4 ? c0[j & 3] : c1[j & 3], sn = j < 4 ? s0[j & 3] : s1[j & 3]; const float a = x[4][j], bb = x[5][j]; x[4][j] = a * c - bb * sn; x[5][j] = bb * c + a * sn; }
#pragma unroll
        for (int d0 = 0; d0 < 6; ++d0) { v4u w; w.x = pk2(x[d0][0] * C2_96, x[d0][1] * C2_96); w.y = pk2(x[d0][2] * C2_96, x[d0][3] * C2_96); w.z = pk2(x[d0][4] * C2_96, x[d0][5] * C2_96); w.w = pk2(x[d0][6] * C2_96, x[d0][7] * C2_96); qr[d0] = __builtin_bit_cast(bf16x8, w); }
    }
}
template <int DQK> __device__ __forceinline__ void l1_unit(LAS char* shm, int bh, int qb, int t_first, int nomax, const bf16* Q, const bf16* K, const bf16* V, bf16* O, const float* gq, const float* c32, const float* s32, const bf16* qaug) {
    const int wid = __builtin_amdgcn_readfirstlane(fresh_tid() >> 6);
    const int b = bh >> 3, h = bh & 7, q0 = qb * 256;
    f32x16 o[2]; o[0] = f32x16{}; o[1] = f32x16{}; float m = 0.f, l = 0.f;
    { const int lane = fresh_tid() & 63, r32 = lane & 31, hi = lane >> 5; const int qpos = q0 + 32 * wid + r32; const size_t row = (size_t)b * SEQ + qpos;
      bf16x8 qr[DQK / 16]; load_q<DQK / 16>(qr, Q + (row * 8 + h) * DQK, hi);
      if (DQK == 80) qr[DQK / 16 - 1] = *(const bf16x8*)(qaug + ((size_t)bh * SEQ + qpos) * 16 + hi * 8);
      if (DQK == 96) mla_q_finish(qr, gq, c32, s32, qpos, hi);
      PassArgs pa; pa.K = K + (size_t)bh * SEQ * DQK; pa.V = V + (size_t)bh * SEQ * 64; pa.t_begin = t_first; pa.t_end = (q0 + 256) / 64; pa.nomax = nomax;
      pa.lo = 0; pa.hi = qpos; pa.lo_max = 0; pa.hi_min = q0 + 32 * wid;
      const unsigned sel[4] = {0u, 0u, 0u, 0u};
      attn_pass<DQK, 0, false>(shm, qr, pa, sel, o, m, l, 0.f, 0); }
    { const int lane = fresh_tid() & 63, r32 = lane & 31, hi = lane >> 5;
      const float lt = halfsum(l); scale_rows<Map<DQK>::WS>(shm, o, lt > 0.f ? 1.0f / lt : 0.f, wid, r32, hi);
      write_o<DQK>(shm, o, O + ((size_t)b * SEQ + q0 + 32 * wid) * 1024 + h * 64, 1024, wid, lane); }
}
__device__ __forceinline__ float gain_absmax(const float* g, int n, int lane) {
    float v = 0.f; for (int i = lane; i < n; i += 64) v = __builtin_fmaxf(v, __builtin_fabsf(g[i]));
#pragma unroll
    for (int o = 1; o < 64; o <<= 1) v = __builtin_fmaxf(v, __shfl_xor(v, o));
    return __builtin_bit_cast(float, __builtin_amdgcn_readfirstlane(__builtin_bit_cast(int, v)));
}
constexpr int CW_Q1 = 12288;
__device__ __forceinline__ void att1_phase(Frame& F) {
    LAS char* shm = (LAS char*)F.lds; unsigned char* ws = F.ws; unsigned* ctl = (unsigned*)(ws + OFF_CTL);
    const int lane0 = fresh_tid() & 63;
    const float bq = gain_absmax(F.in[33], 64, lane0), bk = gain_absmax(F.in[34], 64, lane0), mq = gain_absmax(F.in[39], 96, lane0), mk = gain_absmax(F.in[40], 96, lane0);
    const float Bf = C2_64 * 64.f * bq * bk * 1.02f, Bm = C2_96 * 96.f * mq * mk * 1.02f;
    const int nomax_f = Bf <= 40.f, nomax_m = Bm <= 40.f;
    const float thr = 2.f * Bf + 30.f;
    LAS int* slotw = (LAS int*)(shm + 130048);
    const int myq = (F.vcu * 8) / F.G;
    for (;;) {
        __syncthreads();
        if (threadIdx.x == 0) { int got = -1;
            { const unsigned id = __hip_atomic_fetch_add(ctl + CW_Q1 + 64 * myq, 1u, __ATOMIC_RELAXED, __HIP_MEMORY_SCOPE_AGENT); if (id < 128u) got = myq * 128 + (int)id; }
            if (got < 0) {
                unsigned hd[7];
#pragma unroll
                for (int k = 0; k < 7; ++k) hd[k] = xb_ld(ctl + CW_Q1 + 64 * ((myq + 1 + k) & 7));
#pragma unroll
                for (int k = 0; k < 7; ++k) if (got < 0 && hd[k] < 128u) { const int q = (myq + 1 + k) & 7; const unsigned id = __hip_atomic_fetch_add(ctl + CW_Q1 + 64 * q, 1u, __ATOMIC_RELAXED, __HIP_MEMORY_SCOPE_AGENT); if (id < 128u) got = q * 128 + (int)id; }
            }
            *slotw = got; }
        __syncthreads();
        const int u = *slotw; if (u < 0) break;
        const int q = u >> 7, id = u & 127, fox = id >> 6, bh = 2 * q + ((id >> 5) & 1), qb = 31 - (id & 31);
        if (!fox) l1_unit<96>(shm, bh, qb, 0, nomax_m, (const bf16*)(ws + OFF_QM), (const bf16*)(ws + OFF_KM), (const bf16*)(ws + OFF_VM), (bf16*)(ws + OFF_O1) + 512, F.in[39], (const float*)(ws + OFF_ROPE32C), (const float*)(ws + OFF_ROPE32S), nullptr);
        else {
            const float* dc = (const float*)(ws + OFF_DC2) + (size_t)bh * SEQ; const float lim = dc[qb * 256] + thr;
            int lo = 0, hi = 4 * qb;
            while (lo < hi) { const int mid = (lo + hi) >> 1; if (dc[64 * mid + 63] < lim) hi = mid; else lo = mid + 1; }
            l1_unit<80>(shm, bh, qb, lo, nomax_f, (const bf16*)(ws + OFF_QF), (const bf16*)(ws + OFF_KF), (const bf16*)(ws + OFF_VF), (bf16*)(ws + OFF_O1), nullptr, nullptr, nullptr, (const bf16*)(ws + OFF_QAUG));
        }
    }
}
__device__ __forceinline__ void l0_unit(Frame& F, LAS char* shm, int bhk, int tb, int nomax) {
    const int wid = __builtin_amdgcn_readfirstlane(fresh_tid() >> 6);
    unsigned char* ws = F.ws;
    const int b = bhk >> 1, hk = bhk & 1, g = wid >> 1, th = wid & 1, h = hk * 4 + g, t0 = tb * 64;
    const size_t kvofs = (size_t)bhk * SEQ * 64;
    const bf16* KS = (const bf16*)(ws + OFF_KV8 + 2 * SZ_KV) + kvofs; const bf16* VS = (const bf16*)(ws + OFF_KV8 + 3 * SZ_KV) + kvofs;
    const bf16* KW = (const bf16*)(ws + OFF_KV8 + 4 * SZ_KV) + kvofs; const bf16* VW = (const bf16*)(ws + OFF_KV8 + 5 * SZ_KV) + kvofs;
    const bf16* KB = (const bf16*)(ws + OFF_KV8 + 6 * SZ_KV) + kvofs; const bf16* VB = (const bf16*)(ws + OFF_KV8 + 7 * SZ_KV) + kvofs;
    const bf16* KCM = (const bf16*)(ws + OFF_KCMP) + (size_t)bhk * 512 * 64; const bf16* VCM = (const bf16*)(ws + OFF_VCMP) + (size_t)bhk * 512 * 64;
    bf16* QO = (bf16*)(ws + OFF_QO); const bf16* QC = (const bf16*)(ws + OFF_QC);
    LAS unsigned* IMP = (LAS unsigned*)(shm + Map<64>::IMP); LAS unsigned* SEL = (LAS unsigned*)(shm + Map<64>::SEL);
    const unsigned nosel[4] = {0u, 0u, 0u, 0u};
    f32x16 o[2]; bf16x8 qr[4]; PassArgs pa; float m, l, gate_c = 0.f; pa.nomax = nomax;
#define CTX() const int tid_ = fresh_tid(), lane = tid_ & 63, r32 = lane & 31, hi = lane >> 5; const int tok = 32 * th + r32, tq = t0 + tok; const size_t row = (size_t)b * SEQ + tq; (void)hi; (void)row; (void)tq; (void)tok; (void)lane
#define GATE(i) (((const float*)(ws + OFF_GATES))[row * 24 + h * 3 + (i)])
#define ACCP() f32x4* accp = (f32x4*)(ws + OFF_OACC) + (size_t)F.vcu * 4096 + wid * 512 + lane
#define ACC_AT(d0, g) accp[((d0) * 4 + (g)) * 64]
#define O4(d0, g) (f32x4){o[d0][4 * (g)], o[d0][4 * (g) + 1], o[d0][4 * (g) + 2], o[d0][4 * (g) + 3]}
    { CTX();
      for (int i = tid_; i < 64 * IMPS; i += 512) IMP[i] = 0u;
      load_q<4>(qr, QC + row * 512 + h * 64, hi);
      pa.K = KCM; pa.V = VCM; pa.t_begin = 0; pa.t_end = ((((t0 + 32) >> 4) + 1) + 63) >> 6;
      pa.lo = 0; pa.hi = (tq - 31) >> 4; pa.lo_max = 0; pa.hi_min = (t0 + 32 * th - 31) >> 4;
      o[0] = f32x16{}; o[1] = f32x16{}; m = 0.f; l = 0.f;
      gate_c = GATE(0);
      attn_pass<64, 1, false>(shm, qr, pa, nosel, o, m, l, 0.f, 0);
      const float lt = halfsum(l); const float invl = lt > 0.f ? 1.0f / lt : 0.f;
      attn_pass<64, 2, false>(shm, qr, pa, nosel, o, m, l, invl, tok); }
    { CTX(); ACCP();
      scale_rows<Map<64>::WS>(shm, o, gate_c, wid, r32, hi);
#pragma unroll
      for (int d0 = 0; d0 < 2; ++d0)
#pragma unroll
        for (int g4 = 0; g4 < 4; ++g4) ACC_AT(d0, g4) = O4(d0, g4); }
    { CTX(); const int cur = tb;
      const int j0 = lane, j1 = lane + 64;
      const bool f0 = (j0 == 0) || (j0 == cur) || (j0 == cur - 1), f1 = (j1 == cur) || (j1 == cur - 1);
      const unsigned long long lt_mask = (1ull << lane) - 1ull;
      for (int kg = 0; kg < 8; kg += 4) {
        int k0[4], k1[4]; unsigned T[4];
#pragma unroll
        for (int u = 0; u < 4; ++u) { const int tk = wid * 8 + kg + u;
            k0[u] = f0 ? 0x7fffffff : (j0 <= cur ? (int)IMP[tk * IMPS + j0] : -1); k1[u] = f1 ? 0x7fffffff : (j1 <= cur ? (int)IMP[tk * IMPS + j1] : -1); T[u] = 0u; }
        for (int bit = 28; bit >= 0; --bit) {
#pragma unroll
            for (int u = 0; u < 4; ++u) { const int cand = (int)(T[u] | (1u << bit));
                const int c = __builtin_popcountll(__ballot(k0[u] >= cand)) + __builtin_popcountll(__ballot(k1[u] >= cand));
                T[u] = c >= 16 ? (unsigned)cand : T[u]; }
        }
#pragma unroll
        for (int u = 0; u < 4; ++u) { const int tk = wid * 8 + kg + u;
            const int c0 = __builtin_popcountll(__ballot(k0[u] >= 0)) + __builtin_popcountll(__ballot(k1[u] >= 0));
            const int Tq = c0 >= 16 ? (int)T[u] : -1;
            const unsigned long long gt0 = __ballot(k0[u] > Tq), gt1 = __ballot(k1[u] > Tq), eq0 = __ballot(k0[u] == Tq), eq1 = __ballot(k1[u] == Tq);
            const int need = 16 - (__builtin_popcountll(gt0) + __builtin_popcountll(gt1));
            const int rk0 = __builtin_popcountll(eq0 & lt_mask), rk1 = __builtin_popcountll(eq0) + __builtin_popcountll(eq1 & lt_mask);
            const bool s0 = (k0[u] > Tq || (k0[u] == Tq && rk0 < need)) && j0 <= cur, s1 = (k1[u] > Tq || (k1[u] == Tq && rk1 < need)) && j1 <= cur;
            const unsigned long long b0 = __ballot(s0), b1 = __ballot(s1);
            if (lane == 0) { SEL[tk * 4 + 0] = (unsigned)b0; SEL[tk * 4 + 1] = (unsigned)(b0 >> 32); SEL[tk * 4 + 2] = (unsigned)b1; SEL[tk * 4 + 3] = (unsigned)(b1 >> 32); } }
      } }
    asm volatile("s_waitcnt lgkmcnt(0)\n\ts_barrier" ::: "memory");
    { CTX();
      unsigned sel[4]; sel[0] = SEL[tok * 4 + 0]; sel[1] = SEL[tok * 4 + 1]; sel[2] = SEL[tok * 4 + 2]; sel[3] = SEL[tok * 4 + 3];
      load_q<4>(qr, QO + row * 1024 + h * 64, hi);
      pa.K = KS; pa.V = VS; pa.t_begin = 0; pa.t_end = tb + 1; pa.lo = 0; pa.hi = tq; pa.lo_max = 0; pa.hi_min = t0 + 32 * th;
      o[0] = f32x16{}; o[1] = f32x16{}; m = 0.f; l = 0.f;
      gate_c = GATE(1);
      attn_pass<64, 0, true>(shm, qr, pa, sel, o, m, l, 0.f, 0); }
    { CTX(); ACCP();
      const float lt = halfsum(l); scale_rows<Map<64>::WS>(shm, o, lt > 0.f ? gate_c / lt : 0.f, wid, r32, hi);
#pragma unroll
      for (int d0 = 0; d0 < 2; ++d0)
#pragma unroll
        for (int g4 = 0; g4 < 4; ++g4) { const f32x4 a = ACC_AT(d0, g4); ACC_AT(d0, g4) = a + O4(d0, g4); } }
    { CTX();
      gate_c = GATE(2);
      pa.K = KW; pa.V = VW; pa.t_begin = tb > 8 ? tb - 8 : 0; pa.t_end = tb + 1; pa.lo = tq - 511; pa.hi = tq; pa.lo_max = t0 + 32 * th + 31 - 511; pa.hi_min = t0 + 32 * th;
      o[0] = f32x16{}; o[1] = f32x16{}; m = 0.f; l = 0.f;
      attn_pass<64, 0, false>(shm, qr, pa, nosel, o, m, l, 0.f, 0); }
    { CTX(); ACCP();
      const float lt = halfsum(l); scale_rows<Map<64>::WS>(shm, o, lt > 0.f ? gate_c / lt : 0.f, wid, r32, hi);
#pragma unroll
      for (int d0 = 0; d0 < 2; ++d0)
#pragma unroll
        for (int g4 = 0; g4 < 4; ++g4) { const f32x4 a = ACC_AT(d0, g4); o[d0][4 * g4] += a[0]; o[d0][4 * g4 + 1] += a[1]; o[d0][4 * g4 + 2] += a[2]; o[d0][4 * g4 + 3] += a[3]; }
      write_o<64>(shm, o, QO + ((size_t)b * SEQ + t0 + 32 * th) * 1024 + h * 64, 1024, wid, lane); }
    { CTX();
      load_q<4>(qr, QO + row * 1024 + 512 + h * 64, hi);
      pa.K = KB; pa.V = VB; pa.t_begin = tb > 2 ? tb - 2 : 0; pa.t_end = tb + 1; pa.lo = tq - 127; pa.hi = tq; pa.lo_max = t0 + 32 * th + 31 - 127; pa.hi_min = t0 + 32 * th;
      o[0] = f32x16{}; o[1] = f32x16{}; m = 0.f; l = 0.f;
      attn_pass<64, 0, false>(shm, qr, pa, nosel, o, m, l, 0.f, 0); }
    { CTX();
      const float lt = halfsum(l); const float sk = F.in[20][h] * LOG2E; const float M2 = __builtin_fmaxf(m, sk); const float a = ex2(m - M2); const float den = lt * a + ex2(sk - M2);
      scale_rows<Map<64>::WS>(shm, o, a / den, wid, r32, hi);
      write_o<64>(shm, o, QO + ((size_t)b * SEQ + t0 + 32 * th) * 1024 + 512 + h * 64, 1024, wid, lane); }
#undef CTX
#undef GATE
#undef ACCP
#undef ACC_AT
#undef O4
}
__device__ __forceinline__ void att0_phase(Frame& F) {
    LAS char* shm = (LAS char*)F.lds;
    const int bhk = F.vcu >> 6, s = F.vcu & 63; const int lane0 = fresh_tid() & 63;
    float gq = __builtin_fmaxf(gain_absmax(F.in[8], 64, lane0), gain_absmax(F.in[18], 64, lane0));
    float gk = __builtin_fmaxf(__builtin_fmaxf(gain_absmax(F.in[9], 64, lane0), gain_absmax(F.in[10], 64, lane0)), __builtin_fmaxf(gain_absmax(F.in[11], 64, lane0), gain_absmax(F.in[19], 64, lane0)));
    const int nomax = (C2_64 * 64.f * gq * gk * 1.02f) <= 40.f;
    for (int i = 0; i < 2; ++i) l0_unit(F, shm, bhk, i == 0 ? s : 127 - s, nomax);
}
}

__device__ __forceinline__ void refresh_frame(Frame& F) { const int t = fresh_tid(); F.tid = t; F.lane = t & 63; F.wave = __builtin_amdgcn_readfirstlane(t >> 6); }
constexpr int RING_BYTES = 131072, MISC_OFF = RING_BYTES + 320, INTAB_OFF = RING_BYTES + 1024, LDS_BYTES = 147456;
constexpr int NPHASE = 18;
struct Args { const float* in[46]; float* out; unsigned char* ws; int ph_lo, ph_hi; };

__global__ void __launch_bounds__(NWAVES * 64, 2) mega_fwd(Args args) {
    extern __shared__ __attribute__((aligned(16))) unsigned char lds[];
    Frame F;
    F.lds = (LAS unsigned char*)lds; F.tid = threadIdx.x; F.lane = F.tid & 63; F.wave = __builtin_amdgcn_readfirstlane(F.tid >> 6);
    F.G = gridDim.x; { const int bx = blockIdx.x; F.vcu = (F.G % 8 == 0) ? (bx % 8) * (F.G / 8) + bx / 8 : bx; }
    F.in = (InTab)(F.lds + INTAB_OFF); F.out = args.out; F.ws = args.ws;
    volatile LAS unsigned* MISC = (volatile LAS unsigned*)(F.lds + MISC_OFF);
    for (int u = F.tid; u < (LDS_BYTES - RING_BYTES) / 4; u += NWAVES * 64) ((LAS unsigned*)(F.lds + RING_BYTES))[u] = 0u;
    __syncthreads();
    { const __attribute__((address_space(4))) fptr_t* ka = (const __attribute__((address_space(4))) fptr_t*)__builtin_amdgcn_kernarg_segment_ptr();
      if (F.tid < 46) F.in[F.tid] = ka[F.tid]; }
    __syncthreads();
    unsigned* ctl = (unsigned*)(F.ws + OFF_CTL);
    XcdBarrier bar = xcd_barrier_post(ctl + 4096, MISC + 8);
    const int lo = args.ph_lo, hi = args.ph_hi;
    int vb = (int)blockIdx.x; bool xlocal = false; int team = -1;
#define IN(k) (refresh_frame(F), lo <= (k) && (k) < hi)
#define BOTH(k) (IN(k) && IN((k) + 1))
#define SEAM_G(k) do { if (BOTH(k)) { xcd_barrier(bar, true); } } while (0)
#define SEAM_L(k) do { if (BOTH(k)) xcd_barrier(bar, !xlocal, team); } while (0)
#define SEAM(k) SEAM_G(k)
#define GD_INIT() GemmDesc gd; gd.in = F.in; gd.ws = F.ws; gd.out = F.out; gd.ep = 0; gd.M = NTOK; gd.K = DM; gd.lda = DM; gd.N = DM; gd.A = nullptr; gd.Bt = nullptr; const int bx = vb; unsigned char* ws = F.ws
#define FFN_PHASES(p0_, fidx_, cfgb_, first_, last_) \
    if (IN(p0_)) { GD_INIT(); gd.A = (const bf16*)(ws + ((cfgb_) ? OFF_XBB : OFF_XBA)); gd.Bt = (const bf16*)(ws + OFF_WGU + (fidx_) * SZ_WGU); gd.N = 2 * FF; gd.ep = (cfgb_) ? 1 : 0; \
        gemm_phase<EPI_GATEUP>(F.lds, gd, F.G, bx); } \
    SEAM_L(p0_); \
    if (IN((p0_) + 1)) { GD_INIT(); gd.A = (const bf16*)(ws + ((cfgb_) ? OFF_ACTB : OFF_ACTA)); gd.Bt = (const bf16*)(ws + OFF_WD + (fidx_) * SZ_WD); gd.K = FF; gd.lda = FF; gd.ep = ((first_) ? 1 : 0) | ((cfgb_) ? 16 : 0) | ((last_) ? 32 : 0); \
        gemm_phase<EPI_RESID>(F.lds, gd, F.G, bx); } \
    SEAM_L((p0_) + 1)

    if (IN(0)) p0_prologue(F);
    SEAM(0);
    if (lo == 0 && hi > 1) {
        unsigned* bw = ctl + 4096; bool ok = (F.G == 256);
#pragma unroll
        for (unsigned j = 0; j < 16; ++j) { const unsigned c = xb_ld(&bw[XB_XCNT(j)]); ok = ok && (c == (j < 8u ? 32u : 0u)); }
        const unsigned rank = MISC[10];
        if (ok && bar.x < 8u && rank < 32u) { vb = (int)(rank * 8u + bar.x); xlocal = true; team = (int)(bar.x * 8u + (rank & 7u)); }
        vb = __builtin_amdgcn_readfirstlane(vb);
        F.vcu = (vb % 8) * (F.G / 8) + vb / 8;
    }
    if (IN(1)) { GD_INIT(); gd.A = (const bf16*)(ws + OFF_XBA); gd.Bt = (const bf16*)(ws + OFF_WGU); gd.N = 2 * FF;
        gemm_phase<EPI_GATEUP>(F.lds, gd, F.G, bx);
        const int nfull = (NTOK / 256) * (2 * FF / 256) - 5 * F.G;
        if (bx >= nfull) { refresh_frame(F); convert_mats(F, MATS_P1, (bx - nfull) * NWAVES + F.wave, (F.G - nfull) * NWAVES); refresh_frame(F); p1_extras(F, bx - nfull, F.G - nfull); } }
    SEAM_L(1);
    if (IN(2)) { GD_INIT(); gd.A = (const bf16*)(ws + OFF_ACTA); gd.Bt = (const bf16*)(ws + OFF_WD); gd.K = FF; gd.lda = FF; gd.ep = 1;
        gemm_phase<EPI_RESID>(F.lds, gd, F.G, bx); }
    SEAM_L(2);
    if (IN(3)) { GD_INIT(); gd.A = (const bf16*)(ws + OFF_XBA); gd.Bt = (const bf16*)(ws + OFF_WIN0); gd.N = 2048; gemm_phase<EPI_L0IN>(F.lds, gd, F.G, bx); }
    SEAM(3);
    if (IN(4)) {
        GD_INIT();
        const int gi = bx >> 7, lb = bx & 127;
        if (lb < 16) {
            gd.A = (const bf16*)(ws + OFF_KV8 + gi * SZ_KV); gd.Bt = (const bf16*)(ws + (gi ? OFF_W1V : OFF_W1K)); gd.M = 2048; gd.N = 256; gd.K = 2048; gd.lda = 1024; gd.ep = gi;
            gemm_half_unit<EPI_CMP1>(F.lds, gd, lb & 7, lb >> 3, 0);
            refresh_frame(F); cmp2_tile(F, gi, lb & 7, lb >> 3);
        } else {
            const int b2 = (lb - 16) + gi * 112;
            refresh_frame(F); __syncthreads(); convert_mats(F, MATS_P4, b2 * NWAVES + F.wave, 224 * NWAVES); __syncthreads();
            refresh_frame(F); gates_phase(F, b2, 224); }
    }
    SEAM(4);
    if (IN(5)) fa::att0_phase(F);
    SEAM(5);
    if (IN(6)) { GD_INIT(); gd.A = (const bf16*)(ws + OFF_QO); gd.Bt = (const bf16*)(ws + OFF_WOUT0); gd.ep = 4; gemm_phase<EPI_RESID>(F.lds, gd, F.G, bx); }
    SEAM_L(6);
    if (IN(7)) { GD_INIT(); gd.A = (const bf16*)(ws + OFF_XBA); gd.Bt = (const bf16*)(ws + OFF_WGU + SZ_WGU); gd.N = 2 * FF;
        gemm_phase<EPI_GATEUP>(F.lds, gd, F.G, bx);
        const int nfull = (NTOK / 256) * (2 * FF / 256) - 5 * F.G;
        if (MATS_P7 != 0u && bx >= nfull) { refresh_frame(F); convert_mats(F, MATS_P7, (bx - nfull) * NWAVES + F.wave, (F.G - nfull) * NWAVES); } }
    SEAM_L(7);
    if (IN(8)) { GD_INIT(); gd.A = (const bf16*)(ws + OFF_ACTA); gd.Bt = (const bf16*)(ws + OFF_WD + SZ_WD); gd.K = FF; gd.lda = FF; gd.ep = 8;
        gemm_phase<EPI_RESID>(F.lds, gd, F.G, bx); }
    SEAM_L(8);
    FFN_PHASES(9, 2, false, false, false);
    if (IN(11)) { GD_INIT(); gd.A = (const bf16*)(ws + OFF_XBA); gd.Bt = (const bf16*)(ws + OFF_WIN1); gd.N = 2048; gemm_phase<EPI_L1IN>(F.lds, gd, F.G, bx); }
    SEAM(11);
    if (IN(12)) {
        GD_INIT();
        gd.A = (const bf16*)(ws + OFF_CQ); gd.Bt = (const bf16*)(ws + OFF_WQB); gd.N = 768; gd.K = 256; gd.lda = 256;
        gemm_phase<EPI_QB>(F.lds, gd, F.G, bx);
        gd.A = (const bf16*)(ws + OFF_CKV); gd.Bt = (const bf16*)(ws + OFF_WKVB); gd.N = 1024; gd.K = 128; gd.lda = 128;
        if (bx < F.G - 16) gemm_phase<EPI_KVB>(F.lds, gd, F.G - 16, (bx + 48) % (F.G - 16));
        else { refresh_frame(F); fox_scan(F, bx - (F.G - 16)); }
    }
    SEAM(12);
    if (IN(14)) fa::att1_phase(F);
    SEAM(14);
    if (IN(15)) { GD_INIT(); gd.A = (const bf16*)(ws + OFF_O1); gd.Bt = (const bf16*)(ws + OFF_WOUT1); gd.ep = 2 | 4; gemm_phase<EPI_RESID>(F.lds, gd, F.G, bx); }
    SEAM_L(15);
    FFN_PHASES(16, 3, true, false, true);
#undef IN
#undef BOTH
#undef SEAM
#undef GD_INIT
#undef FFN_PHASES
}

extern "C" void kernel_launch(void* const* d_in, const int* in_sizes, int n_in, void* d_out, int out_size, void* d_ws, size_t ws_size, hipStream_t stream) {
    static int grid = 0;
    if (grid == 0) {
        if (n_in != 46 || in_sizes[0] != NTOK * DM || out_size != NTOK * DM || ws_size < WS_END) { fprintf(stderr, "kernel_launch: unexpected shapes (n_in %d, ws %zu)\n", n_in, ws_size); grid = -1; return; }
        int dev = 0, cus = 0, per_cu = 0;
        hipGetDevice(&dev); hipDeviceGetAttribute(&cus, hipDeviceAttributeMultiprocessorCount, dev);
        hipFuncSetAttribute((const void*)mega_fwd, hipFuncAttributeMaxDynamicSharedMemorySize, LDS_BYTES);
        hipOccupancyMaxActiveBlocksPerMultiprocessor(&per_cu, (const void*)mega_fwd, NWAVES * 64, LDS_BYTES);
        if (per_cu < 1) { fprintf(stderr, "kernel_launch: occupancy query says %d blocks per CU\n", per_cu); per_cu = 1; }
        (void)hipGetLastError();
        grid = cus;
        if (grid > cus * per_cu) grid = cus * per_cu;
    }
    if (grid < 0) return;
    hipMemsetAsync((char*)d_ws + OFF_CTL, 0, CTL_BYTES, stream);
    Args a{};
    for (int i = 0; i < 46; ++i) a.in[i] = (const float*)d_in[i];
    a.out = (float*)d_out; a.ws = (unsigned char*)d_ws; a.ph_lo = 0; a.ph_hi = NPHASE;
    void* kargs[] = {&a};
    hipError_t e = hipLaunchCooperativeKernel((const void*)mega_fwd, dim3(grid), dim3(NWAVES * 64), kargs, LDS_BYTES, stream);
    if (e != hipSuccess) fprintf(stderr, "kernel_launch: cooperative launch failed: %s (grid %d)\n", hipGetErrorString(e), grid);
}
```
